# Optimizing an MI355X kernel written in HIP

```python
import jax, jax.numpy as jnp
from jax import lax
import numpy as np

D_MODEL = 1024
BATCH = 16
SEQ = 256
DEPTH = 4
DEC_BATCH = 2
DEC_SEQ = 2048
PAST_LEN = 256

GRID_W = 64
EPS = 1e-6
NEG_INF = -1e30
NA_HEADS = 8
NA_HEAD_DIM = 64
NA_WIDTH = NA_HEADS * NA_HEAD_DIM
NA_WIN_H = 8
NA_WIN_W = 16
NA_BAND_W = 2 * NA_WIN_W
LRU_WIDTH = 512
LRU_BLOCKS = 8
LRU_BLOCK = LRU_WIDTH // LRU_BLOCKS
LRU_CONV = 4
LRU_C = 8.0
CONV_WIDTH = 512
CONV_K = 3
SPLIT_SIZES = (NA_WIDTH,) * 4 + (LRU_WIDTH,) * 2 + (CONV_WIDTH,) * 4 + (D_MODEL,) * 3
IN_COLS = sum(SPLIT_SIZES)
SPLIT_IDX = tuple(np.cumsum(SPLIT_SIZES)[:-1].tolist())

kernel_name = 'hybrid_dit_natten_rglru_shortconv_step'


def _rmsnorm(x, g):
    x32 = x.astype(jnp.float32)
    y = x32 * lax.rsqrt(jnp.mean(x32 * x32, axis=-1, keepdims=True) + EPS)
    return y.astype(x.dtype) * g


def _dwconv(x, w, left, right):
    K = w.shape[0]
    L = x.shape[1]
    xp = jnp.pad(x, ((0, 0), (left, right), (0, 0)))
    y = w[0] * xp[:, 0:L]
    for j in range(1, K):
        y = y + w[j] * xp[:, j:j + L]
    return y


def _lin_combine(e1, e2):
    a1, b1 = e1
    a2, b2 = e2
    return a1 * a2, a2 * b1 + b2


def _rglru(u, wa, ba, wx, bx, lam, h0, reverse):
    bsz, L, W = u.shape
    ub = u.reshape(bsz, L, LRU_BLOCKS, LRU_BLOCK)
    r = jax.nn.sigmoid(jnp.einsum('blnj,njk->blnk', ub, wa).reshape(bsz, L, W) + ba)
    i = jax.nn.sigmoid(jnp.einsum('blnj,njk->blnk', ub, wx).reshape(bsz, L, W) + bx)
    log_a = (-LRU_C * r.astype(jnp.float32)) * jax.nn.softplus(-lam.astype(jnp.float32))
    a = jnp.exp(log_a)
    b = jnp.sqrt(-jnp.expm1(2.0 * log_a)) * (i * u).astype(jnp.float32)
    a_cum, h = lax.associative_scan(_lin_combine, (a, b), axis=1, reverse=reverse)
    if h0 is not None:
        h = h + a_cum * h0.astype(jnp.float32)[:, None, :]
    h_last = h[:, 0] if reverse else h[:, -1]
    return h.astype(u.dtype), h_last.astype(u.dtype)


def _context_attention(q, k, v):
    s = jnp.einsum('bqhd,bkhd->bhqk', q, k).astype(jnp.float32) * (NA_HEAD_DIM ** -0.5)
    p = jax.nn.softmax(s, axis=-1).astype(v.dtype)
    o = jnp.einsum('bhqk,bkhd->bqhd', p, v)
    return o.reshape(q.shape[0], q.shape[1], NA_WIDTH)


def _neighbourhood_attention(q, k, v, ctx_k, ctx_v, rpb):
    bsz, L, H, Dh = q.shape
    rows = L // GRID_W
    kh = min(NA_WIN_H, rows)
    kw, kb = NA_WIN_W, NA_BAND_W
    ncb = GRID_W // kw
    r = np.arange(rows)
    row_idx = np.clip(r - kh // 2, 0, rows - kh)[:, None] + np.arange(kh)[None, :]
    win_start = np.clip(np.arange(GRID_W) - kw // 2, 0, GRID_W - kw)
    q_col = (np.arange(ncb) * kw)[:, None] + np.arange(kw)[None, :]
    band_idx = np.clip(np.arange(ncb) * kw - kw // 2, 0, GRID_W - kb)[:, None] + np.arange(kb)[None, :]
    qs = win_start[q_col][:, :, None]
    col_valid = (band_idx[:, None, :] >= qs) & (band_idx[:, None, :] < qs + kw)
    row_off = row_idx - r[:, None] + NA_WIN_H - 1
    col_off = np.clip(band_idx[:, None, :] - q_col[:, :, None], 1 - kw, kw - 1) + kw - 1
    bias = rpb[:, row_off[:, None, None, :, None], col_off[None, :, :, None, :]].astype(jnp.float32)
    bias = jnp.where(col_valid[None, None, :, :, None, :], bias, NEG_INF)
    bias = jnp.transpose(bias, (1, 2, 0, 3, 4, 5)).reshape(rows, ncb, H, kw, kh * kb)
    ri = row_idx[:, None, :, None]
    ci = band_idx[None, :, None, :]
    k_band = k.reshape(bsz, rows, GRID_W, H, Dh)[:, ri, ci]
    v_band = v.reshape(bsz, rows, GRID_W, H, Dh)[:, ri, ci]
    q_blk = q.reshape(bsz, rows, ncb, kw, H, Dh)
    scale = Dh ** -0.5
    s_loc = jnp.einsum('brnqhd,brnikhd->brnhqik', q_blk, k_band).reshape(bsz, rows, ncb, H, kw, kh * kb)
    s_ctx = jnp.einsum('brnqhd,bchd->brnhqc', q_blk, ctx_k)
    s = jnp.concatenate([s_loc.astype(jnp.float32) * scale + bias,
                         s_ctx.astype(jnp.float32) * scale], axis=-1)
    p = jax.nn.softmax(s, axis=-1).astype(v.dtype)
    p_loc = p[..., :kh * kb].reshape(bsz, rows, ncb, H, kw, kh, kb)
    p_ctx = p[..., kh * kb:]
    o = (jnp.einsum('brnhqik,brnikhd->brnqhd', p_loc, v_band)
         + jnp.einsum('brnhqc,bchd->brnqhd', p_ctx, ctx_v))
    return o.reshape(bsz, L, H * Dh)


def _layer(x, cond, norm_g, w_mod, b_mod, w_in, na_rpb, lru_conv_w, lru_conv_b,
           lru_wa, lru_ba, lru_wx, lru_bx, lru_lam, conv_w, w_br_na, w_br_lru,
           w_br_conv, w_out, ctx_k=None, ctx_v=None, ctx_h=None):
    bsz, L, _ = x.shape
    shift, scale, gate = jnp.split(jax.nn.silu(cond) @ w_mod + b_mod, 3, axis=-1)
    xm = _rmsnorm(x, norm_g) * (1.0 + scale[:, None]) + shift[:, None]
    (q, k, v, g_na, u, g_lru, c_b, c_c, c_h, g_conv,
     m_na, m_lru, m_conv) = jnp.split(xm @ w_in, SPLIT_IDX, axis=-1)
    heads = (bsz, L, NA_HEADS, NA_HEAD_DIM)
    q, k, v = q.reshape(heads), k.reshape(heads), v.reshape(heads)
    is_ctx = ctx_k is None
    if is_ctx:
        o_na = _context_attention(q, k, v)
        h0_f, h0_b = None, None
    else:
        o_na = _neighbourhood_attention(q, k, v, ctx_k, ctx_v, na_rpb)
        h0_f, h0_b = ctx_h[:, 0], ctx_h[:, 1]
    u_f = _dwconv(u, lru_conv_w[0], LRU_CONV - 1, 0) + lru_conv_b[0]
    u_b = _dwconv(u, lru_conv_w[1], 0, LRU_CONV - 1) + lru_conv_b[1]
    h_f, hT_f = _rglru(u_f, lru_wa[0], lru_ba[0], lru_wx[0], lru_bx[0], lru_lam[0], h0_f, False)
    h_b, hT_b = _rglru(u_b, lru_wa[1], lru_ba[1], lru_wx[1], lru_bx[1], lru_lam[1], h0_b, True)
    o_conv = c_b * _dwconv(c_c * c_h, conv_w, CONV_K // 2, CONV_K - 1 - CONV_K // 2)
    merged = (jax.nn.sigmoid(m_na) * ((o_na * jax.nn.silu(g_na)) @ w_br_na)
              + jax.nn.sigmoid(m_lru) * (((h_f + h_b) * jax.nn.silu(g_lru)) @ w_br_lru)
              + jax.nn.sigmoid(m_conv) * ((o_conv * jax.nn.silu(g_conv)) @ w_br_conv))
    x = x + gate[:, None] * (merged @ w_out)
    if is_ctx:
        return x, k, v, jnp.stack([hT_f, hT_b], axis=1)
    return x


def setup_inputs(seed: int = 0) -> dict:
    key = jax.random.key(seed)
    ks = jax.random.split(key, 26)

    def nrm(i, shape, s):
        return jax.random.normal(ks[i], shape, jnp.float32) * s

    d = D_MODEL
    u = jax.random.uniform(ks[25], (DEPTH, 2, LRU_WIDTH), jnp.float32, 0.9, 0.999)
    a0 = u ** (1.0 / LRU_C)
    return {
        'x_prompt': nrm(0, (BATCH, SEQ, d), 1.0),
        'x_sample': nrm(1, (DEC_BATCH, DEC_SEQ, d), 1.0),
        'cache_k': nrm(2, (DEC_BATCH, DEPTH, PAST_LEN, NA_HEADS, NA_HEAD_DIM), 1.0),
        'cache_v': nrm(3, (DEC_BATCH, DEPTH, PAST_LEN, NA_HEADS, NA_HEAD_DIM), 1.0),
        'state_lru': nrm(4, (DEC_BATCH, DEPTH, 2, LRU_WIDTH), 0.5),
        'c': nrm(5, (DEC_BATCH, d), 1.0),
        'c_ctx': nrm(6, (d,), 1.0),
        'norm_g': 1.0 + nrm(7, (DEPTH, d), 0.02),
        'w_mod': nrm(8, (DEPTH, d, 3 * d), 0.5 * d ** -0.5),
        'b_mod': nrm(9, (DEPTH, 3 * d), 0.01),
        'w_in': nrm(10, (DEPTH, d, IN_COLS), d ** -0.5),
        'na_rpb': nrm(11, (DEPTH, NA_HEADS, 2 * NA_WIN_H - 1, 2 * NA_WIN_W - 1), 0.1),
        'lru_conv_w': nrm(12, (DEPTH, 2, LRU_CONV, LRU_WIDTH), LRU_CONV ** -0.5),
        'lru_conv_b': nrm(13, (DEPTH, 2, LRU_WIDTH), 0.01),
        'lru_wa': nrm(14, (DEPTH, 2, LRU_BLOCKS, LRU_BLOCK, LRU_BLOCK), LRU_BLOCK ** -0.5),
        'lru_ba': nrm(15, (DEPTH, 2, LRU_WIDTH), 0.01),
        'lru_wx': nrm(16, (DEPTH, 2, LRU_BLOCKS, LRU_BLOCK, LRU_BLOCK), LRU_BLOCK ** -0.5),
        'lru_bx': nrm(17, (DEPTH, 2, LRU_WIDTH), 0.01),
        'lru_lam': jnp.log(a0) - jnp.log1p(-a0),
        'conv_w': nrm(18, (DEPTH, CONV_K, CONV_WIDTH), CONV_K ** -0.5),
        'w_br_na': nrm(19, (DEPTH, NA_WIDTH, d), NA_WIDTH ** -0.5),
        'w_br_lru': nrm(20, (DEPTH, LRU_WIDTH, d), LRU_WIDTH ** -0.5),
        'w_br_conv': nrm(21, (DEPTH, CONV_WIDTH, d), CONV_WIDTH ** -0.5),
        'w_out': nrm(22, (DEPTH, d, d), d ** -0.5),
        'final_g': 1.0 + nrm(23, (d,), 0.02),
    }


def reference(x_prompt, x_sample, cache_k, cache_v, state_lru, c, c_ctx, norm_g, w_mod, b_mod,
              w_in, na_rpb, lru_conv_w, lru_conv_b, lru_wa, lru_ba, lru_wx, lru_bx, lru_lam,
              conv_w, w_br_na, w_br_lru, w_br_conv, w_out, final_g):
    xp, xs = x_prompt, x_sample
    cond_ctx = c_ctx[None, :]
    new_k, new_v, new_h = [], [], []
    for l in range(DEPTH):
        lw = (norm_g[l], w_mod[l], b_mod[l], w_in[l], na_rpb[l], lru_conv_w[l], lru_conv_b[l],
              lru_wa[l], lru_ba[l], lru_wx[l], lru_bx[l], lru_lam[l], conv_w[l],
              w_br_na[l], w_br_lru[l], w_br_conv[l], w_out[l])
        xp, k_l, v_l, h_l = _layer(xp, cond_ctx, *lw)
        new_k.append(k_l)
        new_v.append(v_l)
        new_h.append(h_l)
        xs = _layer(xs, c, *lw, cache_k[:, l], cache_v[:, l], state_lru[:, l])
    y_prompt = _rmsnorm(xp, final_g)
    y_sample = _rmsnorm(xs, final_g)
    new_cache_k = jnp.stack(new_k, axis=1)
    new_cache_v = jnp.stack(new_v, axis=1)
    new_state_lru = jnp.stack(new_h, axis=1)
    return (y_prompt, y_sample, new_cache_k, new_cache_v, new_state_lru)
```

```cpp
#include <hip/hip_runtime.h>
#include <hip/hip_cooperative_groups.h>
#include <cstdio>
#include <cstring>
namespace cg = cooperative_groups;

typedef unsigned short u16;
using bf16x8 = __attribute__((ext_vector_type(8))) short;
using f32x4 = __attribute__((ext_vector_type(4))) float;
using u32x4 = __attribute__((ext_vector_type(4))) unsigned;

#define NTHREADS 256
#define SMEM_BYTES 65536

struct Params {
  const float *x_prompt, *x_sample, *cache_k, *cache_v, *state_lru, *c, *c_ctx, *norm_g, *w_mod, *b_mod,
      *w_in, *na_rpb, *lru_conv_w, *lru_conv_b, *lru_wa, *lru_ba, *lru_wx, *lru_bx, *lru_lam, *conv_w,
      *w_br_na, *w_br_lru, *w_br_conv, *w_out, *final_g;
  float* out;
  u16 *wt_in, *wt_br, *wt_out, *wgT, *ckb, *cvT, *xm, *P, *Vt, *Ana, *Alru, *Aconv, *merged, *hloc, *acum;
  float *mod, *xbuf, *Atot, *Htot;
  int phase_lo, phase_hi;
};

__device__ __forceinline__ int otid() { int t = threadIdx.x; asm volatile("" : "+v"(t)); return t; }
__device__ __forceinline__ unsigned f2bf(float f) {
  unsigned u = __float_as_uint(f);
  u += 0x7fffu + ((u >> 16) & 1u);
  return u >> 16;
}
__device__ __forceinline__ float bf2f(unsigned h) { return __uint_as_float(h << 16); }
__device__ __forceinline__ unsigned pack2(float a, float b) { return f2bf(a) | (f2bf(b) << 16); }
__device__ __forceinline__ float sigm(float x) { return 1.f / (1.f + __expf(-x)); }
__device__ __forceinline__ float silu(float x) { return x / (1.f + __expf(-x)); }
__device__ __forceinline__ float lo16(unsigned w) { return __uint_as_float(w << 16); }
__device__ __forceinline__ float hi16(unsigned w) { return __uint_as_float(w & 0xffff0000u); }

__device__ void transpose_unit(const float* __restrict__ src, int N, u16* __restrict__ dst, int K, int k0, int n0,
                               float* sm) {
  const int tid = otid();
#pragma unroll
  for (int i = 0; i < 4; ++i) {
    int r = (tid >> 4) + i * 16, c4 = (tid & 15) * 4;
    float4 v = *(const float4*)(src + (size_t)(k0 + r) * N + n0 + c4);
    sm[r * 65 + c4 + 0] = v.x; sm[r * 65 + c4 + 1] = v.y; sm[r * 65 + c4 + 2] = v.z; sm[r * 65 + c4 + 3] = v.w;
  }
  __syncthreads();
  const int n = tid >> 2, kq = (tid & 3) * 16;
  unsigned w[8];
#pragma unroll
  for (int kk = 0; kk < 8; ++kk) w[kk] = pack2(sm[(kq + 2 * kk) * 65 + n], sm[(kq + 2 * kk + 1) * 65 + n]);
  uint4* d = (uint4*)(dst + (size_t)(n0 + n) * K + k0 + kq);
  d[0] = make_uint4(w[0], w[1], w[2], w[3]);
  d[1] = make_uint4(w[4], w[5], w[6], w[7]);
  __syncthreads();
}

__device__ void phase0(const Params& p, char* smem) {
  float* sm = (float*)smem;
  const int tid = otid();
  const int NU = 384 + 8192 + 1536 + 1024 + 512 + 512 + 128 + 2048;
  for (int u = blockIdx.x; u < NU; u += gridDim.x) {
    int v = u;
    if (v < 384) {
      int l = v / 96, cgp = v % 96;
      int c = cgp * 32 + (tid & 31), kg = tid >> 5;
      float a0 = 0.f, a1 = 0.f, a2 = 0.f;
      const float* w = p.w_mod + (size_t)l * 1024 * 3072 + c;
      for (int k = kg * 128; k < kg * 128 + 128; ++k) {
        float wv = w[(size_t)k * 3072];
        a0 += silu(p.c_ctx[k]) * wv; a1 += silu(p.c[k]) * wv; a2 += silu(p.c[1024 + k]) * wv;
      }
      sm[(kg * 3 + 0) * 32 + (tid & 31)] = a0;
      sm[(kg * 3 + 1) * 32 + (tid & 31)] = a1;
      sm[(kg * 3 + 2) * 32 + (tid & 31)] = a2;
      __syncthreads();
      if (tid < 96) {
        int cond = tid >> 5, cc = tid & 31;
        float s = p.b_mod[l * 3072 + cgp * 32 + cc];
#pragma unroll
        for (int g = 0; g < 8; ++g) s += sm[(g * 3 + cond) * 32 + cc];
        p.mod[(size_t)(l * 3 + cond) * 3072 + cgp * 32 + cc] = s;
      }
      __syncthreads();
      continue;
    }
    v -= 384;
    if (v < 8192) {
      int l = v >> 11, r = v & 2047, kt = r >> 7, nt = r & 127;
      transpose_unit(p.w_in + (size_t)l * 1024 * 8192, 8192, p.wt_in + (size_t)l * 8192 * 1024, 1024, kt * 64, nt * 64, sm);
      continue;
    }
    v -= 8192;
    if (v < 1536) {
      int l = v / 384, r = v % 384, br = r >> 7, q = r & 127, kt = q >> 4, nt = q & 15;
      u16* dst = p.wt_br + (size_t)(l * 3 + br) * 1024 * 512;
      if (br == 0) transpose_unit(p.w_br_na + (size_t)l * 512 * 1024, 1024, dst, 512, kt * 64, nt * 64, sm);
      else if (br == 1) transpose_unit(p.w_br_lru + (size_t)l * 512 * 1024, 1024, dst, 512, kt * 64, nt * 64, sm);
      else transpose_unit(p.w_br_conv + (size_t)l * 512 * 1024, 1024, dst, 512, kt * 64, nt * 64, sm);
      continue;
    }
    v -= 1536;
    if (v < 1024) {
      int l = v >> 8, r = v & 255, kt = r >> 4, nt = r & 15;
      transpose_unit(p.w_out + (size_t)l * 1024 * 1024, 1024, p.wt_out + (size_t)l * 1024 * 1024, 1024, kt * 64, nt * 64, sm);
      continue;
    }
    v -= 1024;
    if (v < 512) {
      size_t idx = ((size_t)v * 256 + tid) * 8;
      float4 a = *(const float4*)(p.cache_k + idx), b = *(const float4*)(p.cache_k + idx + 4);
      *(uint4*)(p.ckb + idx) = make_uint4(pack2(a.x, a.y), pack2(a.z, a.w), pack2(b.x, b.y), pack2(b.z, b.w));
      continue;
    }
    v -= 512;
    if (v < 512) {
      int g = v * 256 + tid;
      int d = g & 63, h = (g >> 6) & 7, kg = (g >> 9) & 31, bl = g >> 14;
      float f[8];
#pragma unroll
      for (int j = 0; j < 8; ++j) f[j] = p.cache_v[((size_t)(bl * 256 + kg * 8 + j) * 8 + h) * 64 + d];
      *(uint4*)(p.cvT + ((size_t)(bl * 8 + h) * 64 + d) * 256 + kg * 8) =
          make_uint4(pack2(f[0], f[1]), pack2(f[2], f[3]), pack2(f[4], f[5]), pack2(f[6], f[7]));
      continue;
    }
    v -= 512;
    if (v >= 128) {
      v -= 128;
      const size_t o = ((size_t)(v & 1023) * 256 + tid) * 16;
      if (v < 1024) {
#pragma unroll
        for (int i = 0; i < 4; ++i) *(float4*)(p.xbuf + o + i * 4) = *(const float4*)(p.x_prompt + o + i * 4);
      } else {
#pragma unroll
        for (int i = 0; i < 4; ++i) *(float4*)(p.xbuf + 4194304 + o + i * 4) = *(const float4*)(p.x_sample + o + i * 4);
      }
      continue;
    }
    {
      int blk = v & 7, gate = (v >> 3) & 1, dir = (v >> 4) & 1, l = v >> 5;
      const size_t so = (size_t)((l * 2 + dir) * 8 + blk) * 4096;
      u16* dst = p.wgT + (size_t)v * 4096;
      for (int idx = tid; idx < 4096; idx += 256) {
        int k = idx >> 6, j = idx & 63;
        float wv;
        if (gate) wv = p.lru_wx[so + j * 64 + k]; else wv = p.lru_wa[so + j * 64 + k];
        dst[idx] = (u16)f2bf(wv);
      }
    }
  }
}

__device__ __forceinline__ const float* xrow(const Params& p, int l, int t) {
  return p.xbuf + (size_t)t * 1024;
}
__device__ __forceinline__ float wave_sum(float v) {
#pragma unroll
  for (int o = 32; o >= 1; o >>= 1) v += __shfl_xor(v, o);
  return v;
}

__device__ void phaseN(const Params& p, int l) {
  const int lane = otid() & 63, wave = otid() >> 6;
  const float* g = p.norm_g + l * 1024;
  for (int t = blockIdx.x * 4 + wave; t < 8192; t += gridDim.x * 4) {
    const float* x = xrow(p, l, t);
    float4 v[4];
    float ss = 0.f;
#pragma unroll
    for (int i = 0; i < 4; ++i) {
      v[i] = *(const float4*)(x + i * 256 + lane * 4);
      ss += v[i].x * v[i].x + v[i].y * v[i].y + v[i].z * v[i].z + v[i].w * v[i].w;
    }
    ss = wave_sum(ss);
    float rstd = rsqrtf(ss * (1.f / 1024.f) + 1e-6f);
    int cid = t < 4096 ? 0 : 1 + ((t - 4096) >> 11);
    const float* md = p.mod + (size_t)(l * 3 + cid) * 3072;
#pragma unroll
    for (int i = 0; i < 4; ++i) {
      int c = i * 256 + lane * 4;
      float4 gg = *(const float4*)(g + c), sh = *(const float4*)(md + c), sc = *(const float4*)(md + 1024 + c);
      float y0 = v[i].x * rstd * gg.x * (1.f + sc.x) + sh.x;
      float y1 = v[i].y * rstd * gg.y * (1.f + sc.y) + sh.y;
      float y2 = v[i].z * rstd * gg.z * (1.f + sc.z) + sh.z;
      float y3 = v[i].w * rstd * gg.w * (1.f + sc.w) + sh.w;
      *(uint2*)(p.xm + (size_t)t * 1024 + c) = make_uint2(pack2(y0, y1), pack2(y2, y3));
    }
  }
}

__device__ void phaseF(const Params& p) {
  const int lane = otid() & 63, wave = otid() >> 6;
  for (int t = blockIdx.x * 4 + wave; t < 8192; t += gridDim.x * 4) {
    const float* x = p.xbuf + (size_t)t * 1024;
    float4 v[4];
    float ss = 0.f;
#pragma unroll
    for (int i = 0; i < 4; ++i) {
      v[i] = *(const float4*)(x + i * 256 + lane * 4);
      ss += v[i].x * v[i].x + v[i].y * v[i].y + v[i].z * v[i].z + v[i].w * v[i].w;
    }
    ss = wave_sum(ss);
    float rstd = rsqrtf(ss * (1.f / 1024.f) + 1e-6f);
#pragma unroll
    for (int i = 0; i < 4; ++i) {
      int c = i * 256 + lane * 4;
      float4 gg = *(const float4*)(p.final_g + c);
      *(float4*)(p.out + (size_t)t * 1024 + c) =
          make_float4(v[i].x * rstd * gg.x, v[i].y * rstd * gg.y, v[i].z * rstd * gg.z, v[i].w * rstd * gg.w);
    }
  }
}

template <bool SWAP>
__device__ __forceinline__ void gemm_mainloop(const u16* __restrict__ A, int lda, const u16* __restrict__ B, int ldb,
                                              int K, f32x4 (&acc)[4][4], char* smem) {
  const int tid = otid(), lane = tid & 63, wave = tid >> 6;
  const int wm = wave >> 1, wn = wave & 1, fr = lane & 15, fq = lane >> 4;
  const int lr = tid >> 3, lc = tid & 7;
  const u16* ag = A + (size_t)lr * lda + lc * 8;
  const u16* bg = B + (size_t)lr * ldb + lc * 8;
  const int woff = lr * 128 + ((lc ^ ((lr >> 1) & 7)) << 4);
  char* sA = smem;
  char* sB = smem + 32768;
  uint4 ra[4], rb[4];
#pragma unroll
  for (int i = 0; i < 4; ++i) {
    ra[i] = *(const uint4*)(ag + (size_t)i * 32 * lda);
    rb[i] = *(const uint4*)(bg + (size_t)i * 32 * ldb);
  }
#pragma unroll
  for (int i = 0; i < 4; ++i) {
    *(uint4*)(sA + woff + i * 4096) = ra[i];
    *(uint4*)(sB + woff + i * 4096) = rb[i];
  }
  __syncthreads();
  const int swz_r = (fr >> 1) & 7;
  const int aoff = (wm * 64 + fr) * 128, boff = (wn * 64 + fr) * 128;
  const int nk = K >> 6;
  for (int kt = 0; kt < nk; ++kt) {
    const int cur = kt & 1;
    if (kt + 1 < nk) {
#pragma unroll
      for (int i = 0; i < 4; ++i) {
        ra[i] = *(const uint4*)(ag + (size_t)i * 32 * lda + (kt + 1) * 64);
        rb[i] = *(const uint4*)(bg + (size_t)i * 32 * ldb + (kt + 1) * 64);
      }
    }
    const char* cA = sA + cur * 16384 + aoff;
    const char* cB = sB + cur * 16384 + boff;
#pragma unroll
    for (int ks = 0; ks < 2; ++ks) {
      bf16x8 af[4], bfr[4];
      const int ch = ((ks * 4 + fq) ^ swz_r) << 4;
#pragma unroll
      for (int i = 0; i < 4; ++i) {
        af[i] = *(const bf16x8*)(cA + i * 2048 + ch);
        bfr[i] = *(const bf16x8*)(cB + i * 2048 + ch);
      }
#pragma unroll
      for (int i = 0; i < 4; ++i)
#pragma unroll
        for (int j = 0; j < 4; ++j) {
          if (SWAP) acc[i][j] = __builtin_amdgcn_mfma_f32_16x16x32_bf16(bfr[j], af[i], acc[i][j], 0, 0, 0);
          else acc[i][j] = __builtin_amdgcn_mfma_f32_16x16x32_bf16(af[i], bfr[j], acc[i][j], 0, 0, 0);
        }
    }
    if (kt + 1 < nk) {
      char* nA = sA + (cur ^ 1) * 16384 + woff;
      char* nB = sB + (cur ^ 1) * 16384 + woff;
#pragma unroll
      for (int i = 0; i < 4; ++i) {
        *(uint4*)(nA + i * 4096) = ra[i];
        *(uint4*)(nB + i * 4096) = rb[i];
      }
    }
    __syncthreads();
  }
}

__device__ __forceinline__ void zero_acc(f32x4 (&acc)[4][4]) {
#pragma unroll
  for (int i = 0; i < 4; ++i)
#pragma unroll
    for (int j = 0; j < 4; ++j) acc[i][j] = f32x4{0.f, 0.f, 0.f, 0.f};
}

__device__ void phaseA(const Params& p, int l, char* smem) {
  const int tid = otid(), lane = tid & 63, wave = tid >> 6;
  const int wm = wave >> 1, wn = wave & 1, fr = lane & 15, fq = lane >> 4;
  const u16* W = p.wt_in + (size_t)l * 8192 * 1024;
  float* newk = p.out + 8388608;
  float* newv = p.out + 16777216;
  for (int id = blockIdx.x; id < 4096; id += gridDim.x) {
    int xcd = id & 7, j_ = id >> 3;
    int grp = xcd * 8 + (j_ >> 6), within = j_ & 63;
    int mt = (grp >> 3) * 8 + (within >> 3), nt = (grp & 7) * 8 + (within & 7);
    int m0 = mt * 128, n0 = nt * 128;
    f32x4 acc[4][4];
    zero_acc(acc);
    const u16* A = p.xm + (size_t)m0 * 1024;
    const u16* B = W + (size_t)n0 * 1024;
    if (n0 >= 1024 && n0 < 1536) {
      gemm_mainloop<false>(A, 1024, B, 1024, 1024, acc, smem);
#pragma unroll
      for (int i = 0; i < 4; ++i)
#pragma unroll
        for (int j = 0; j < 4; ++j) {
          int tok0 = m0 + wm * 64 + i * 16 + fq * 4;
          int vc = n0 + wn * 64 + j * 16 + fr - 1024;
          f32x4 v = acc[i][j];
          *(uint2*)(p.Vt + (size_t)vc * 8192 + tok0) = make_uint2(pack2(v[0], v[1]), pack2(v[2], v[3]));
          if (tok0 < 4096) {
#pragma unroll
            for (int jj = 0; jj < 4; ++jj) {
              int t = tok0 + jj;
              newv[((size_t)((t >> 8) * 4 + l) * 256 + (t & 255)) * 512 + vc] = v[jj];
            }
          }
        }
    } else {
      gemm_mainloop<true>(A, 1024, B, 1024, 1024, acc, smem);
      const bool isK = (n0 >= 512 && n0 < 1024);
#pragma unroll
      for (int i = 0; i < 4; ++i)
#pragma unroll
        for (int j = 0; j < 4; ++j) {
          int t = m0 + wm * 64 + i * 16 + fr;
          int col = n0 + wn * 64 + j * 16 + fq * 4;
          f32x4 v = acc[i][j];
          *(uint2*)(p.P + (size_t)t * 8192 + col) = make_uint2(pack2(v[0], v[1]), pack2(v[2], v[3]));
          if (isK && t < 4096)
            *(float4*)(newk + ((size_t)((t >> 8) * 4 + l) * 256 + (t & 255)) * 512 + (col - 512)) =
                make_float4(v[0], v[1], v[2], v[3]);
        }
    }
  }
}

__device__ __forceinline__ bf16x8 ld16(const u16* ptr) { return *(const bf16x8*)ptr; }

__device__ void attn_unit(const Params& p, int l, int unit) {
  const int lane = otid() & 63, fr = lane & 15, fq = lane >> 4;
  const bool lat = unit >= 2048;
  int b, h, qtok0, r = 0, n = 0, row0 = 0, band0 = 0;
  if (!lat) {
    b = unit >> 7; h = (unit >> 4) & 7;
    qtok0 = b * 256 + (unit & 15) * 16;
  } else {
    int u = unit - 2048;
    b = u >> 10; r = (u >> 5) & 31; n = (u >> 3) & 3; h = u & 7;
    qtok0 = 4096 + b * 2048 + r * 64 + n * 16;
    row0 = min(max(r - 4, 0), 24);
    band0 = min(max(16 * n - 8, 0), 32);
  }
  const u16* qp = p.P + (size_t)(qtok0 + fr) * 8192 + h * 64 + fq * 8;
  const bf16x8 q0 = ld16(qp), q1 = ld16(qp + 32);
  f32x4 o[4];
#pragma unroll
  for (int dt = 0; dt < 4; ++dt) o[dt] = f32x4{0.f, 0.f, 0.f, 0.f};
  float m = -1e30f, lsum = 0.f;
  const float* rpb = p.na_rpb + (size_t)(l * 8 + h) * 15 * 31;
  const int qc = 16 * n + fr;
  const int wst = min(max(qc - 8, 0), 48);
  const int nchunks = lat ? 8 : 4;
#pragma unroll 1
  for (int c = 0; c < nchunks; ++c) {
    const bool local = lat && c < 4;
    const u16 *kb, *vb;
    size_t kstride, kslab, vstride, vslab;
    if (!lat) {
      size_t key0 = (size_t)b * 256 + c * 64;
      kb = p.P + key0 * 8192 + 512 + h * 64; kstride = 8192; kslab = (size_t)32 * 8192;
      vb = p.Vt + (size_t)(h * 64) * 8192 + key0; vstride = 8192; vslab = 32;
    } else if (local) {
      size_t tok = 4096 + (size_t)b * 2048 + (row0 + c * 2) * 64 + band0;
      kb = p.P + tok * 8192 + 512 + h * 64; kstride = 8192; kslab = (size_t)64 * 8192;
      vb = p.Vt + (size_t)(h * 64) * 8192 + tok; vstride = 8192; vslab = 64;
    } else {
      int cc = c - 4;
      kb = p.ckb + ((size_t)(b * 4 + l) * 256 + cc * 64) * 512 + h * 64; kstride = 512; kslab = (size_t)32 * 512;
      vb = p.cvT + (size_t)((b * 4 + l) * 8 + h) * 64 * 256 + cc * 64; vstride = 256; vslab = 32;
    }
    f32x4 s[4];
#pragma unroll
    for (int mt = 0; mt < 4; ++mt) {
      const u16* kp = kb + (mt >> 1) * kslab + (size_t)((mt & 1) * 16 + fr) * kstride + fq * 8;
      bf16x8 a0 = ld16(kp), a1 = ld16(kp + 32);
      f32x4 z = f32x4{0.f, 0.f, 0.f, 0.f};
      z = __builtin_amdgcn_mfma_f32_16x16x32_bf16(a0, q0, z, 0, 0, 0);
      s[mt] = __builtin_amdgcn_mfma_f32_16x16x32_bf16(a1, q1, z, 0, 0, 0);
    }
    float cmax = -1e30f;
#pragma unroll
    for (int mt = 0; mt < 4; ++mt) {
      const int row_off = row0 + c * 2 + (mt >> 1) - r + 7;
#pragma unroll
      for (int jj = 0; jj < 4; ++jj) {
        float v = s[mt][jj] * 0.125f;
        if (local) {
          int kc = band0 + (mt & 1) * 16 + fq * 4 + jj;
          bool valid = (kc >= wst) && (kc < wst + 16);
          int col_off = min(max(kc - qc, -15), 15) + 15;
          float bias = rpb[row_off * 31 + col_off];
          v = valid ? v + bias : -1e30f;
        }
        s[mt][jj] = v;
        cmax = fmaxf(cmax, v);
      }
    }
    cmax = fmaxf(cmax, __shfl_xor(cmax, 16));
    cmax = fmaxf(cmax, __shfl_xor(cmax, 32));
    const float mnew = fmaxf(m, cmax);
    const float alpha = __expf(m - mnew);
    m = mnew;
    lsum *= alpha;
#pragma unroll
    for (int dt = 0; dt < 4; ++dt) o[dt] *= alpha;
#pragma unroll
    for (int mt = 0; mt < 4; ++mt)
#pragma unroll
      for (int jj = 0; jj < 4; ++jj) {
        float pv = __expf(s[mt][jj] - m);
        lsum += pv;
        s[mt][jj] = pv;
      }
#pragma unroll
    for (int sl = 0; sl < 2; ++sl) {
      u32x4 pw = {pack2(s[2 * sl][0], s[2 * sl][1]), pack2(s[2 * sl][2], s[2 * sl][3]),
                  pack2(s[2 * sl + 1][0], s[2 * sl + 1][1]), pack2(s[2 * sl + 1][2], s[2 * sl + 1][3])};
      bf16x8 pb = __builtin_bit_cast(bf16x8, pw);
#pragma unroll
      for (int dt = 0; dt < 4; ++dt) {
        const u16* vp = vb + sl * vslab + (size_t)(dt * 16 + fr) * vstride + fq * 4;
        uint2 v0 = *(const uint2*)vp, v1 = *(const uint2*)(vp + 16);
        u32x4 vw = {v0.x, v0.y, v1.x, v1.y};
        o[dt] = __builtin_amdgcn_mfma_f32_16x16x32_bf16(__builtin_bit_cast(bf16x8, vw), pb, o[dt], 0, 0, 0);
      }
    }
  }
  lsum += __shfl_xor(lsum, 16);
  lsum += __shfl_xor(lsum, 32);
  const float inv = 1.f / lsum;
  const size_t t = qtok0 + fr;
#pragma unroll
  for (int dt = 0; dt < 4; ++dt) {
    int d0 = h * 64 + dt * 16 + fq * 4;
    uint2 g = *(const uint2*)(p.P + t * 8192 + 1536 + d0);
    float y0 = o[dt][0] * inv * silu(lo16(g.x)), y1 = o[dt][1] * inv * silu(hi16(g.x));
    float y2 = o[dt][2] * inv * silu(lo16(g.y)), y3 = o[dt][3] * inv * silu(hi16(g.y));
    *(uint2*)(p.Ana + t * 512 + d0) = make_uint2(pack2(y0, y1), pack2(y2, y3));
  }
}

__device__ void lru_unit(const Params& p, int l, int unit, char* smem) {
  const int tid = otid(), lane = tid & 63, wave = tid >> 6, fr = lane & 15, fq = lane >> 4;
  const int blk = unit & 7, dir = (unit >> 3) & 1, cs = unit >> 4;
  const int t0 = cs * 64;
  int seq_lo, seq_hi;
  if (cs < 64) { seq_lo = (cs >> 2) * 256; seq_hi = seq_lo + 256; }
  else { seq_lo = 4096 + ((cs - 64) >> 5) * 2048; seq_hi = seq_lo + 2048; }
  u16* uraw = (u16*)smem;
  u16* udb = (u16*)(smem + 8704);
  float* sa = (float*)(smem + 8704 + 9216);
  float* sb = sa + 4096;
  float* stot = sb + 4096;
  const int wbase = dir ? t0 : t0 - 3;
#pragma unroll
  for (int i = 0; i < 3; ++i) {
    int row = (tid >> 3) + i * 32, ch8 = tid & 7;
    if (row < 67) {
      int t = wbase + row;
      uint4 v = make_uint4(0, 0, 0, 0);
      if (t >= seq_lo && t < seq_hi) v = *(const uint4*)(p.P + (size_t)t * 8192 + 2048 + blk * 64 + ch8 * 8);
      *(uint4*)(uraw + row * 64 + ch8 * 8) = v;
    }
  }
  __syncthreads();
  {
    const int ch = tid & 63, tg = tid >> 6;
    const int cw = blk * 64 + ch;
    const float* cwp = p.lru_conv_w + (size_t)((l * 2 + dir) * 4) * 512 + cw;
    const float w0 = cwp[0], w1 = cwp[512], w2 = cwp[1024], w3 = cwp[1536];
    const float cb = p.lru_conv_b[(l * 2 + dir) * 512 + cw];
    for (int t = tg * 16; t < tg * 16 + 16; ++t) {
      float ud = cb + w0 * bf2f(uraw[t * 64 + ch]) + w1 * bf2f(uraw[(t + 1) * 64 + ch]) +
                 w2 * bf2f(uraw[(t + 2) * 64 + ch]) + w3 * bf2f(uraw[(t + 3) * 64 + ch]);
      sb[t * 64 + ch] = ud;
      udb[t * 72 + ch] = (u16)f2bf(ud);
    }
  }
  __syncthreads();
  {
    f32x4 ar[4], ai[4];
#pragma unroll
    for (int nt = 0; nt < 4; ++nt) { ar[nt] = f32x4{0.f, 0.f, 0.f, 0.f}; ai[nt] = f32x4{0.f, 0.f, 0.f, 0.f}; }
    const u16* wr = p.wgT + (size_t)(((l * 2 + dir) * 2 + 0) * 8 + blk) * 4096;
    const u16* wi = p.wgT + (size_t)(((l * 2 + dir) * 2 + 1) * 8 + blk) * 4096;
#pragma unroll
    for (int ks = 0; ks < 2; ++ks) {
      bf16x8 af = *(const bf16x8*)(udb + (wave * 16 + fr) * 72 + ks * 32 + fq * 8);
#pragma unroll
      for (int nt = 0; nt < 4; ++nt) {
        bf16x8 br = ld16(wr + (nt * 16 + fr) * 64 + ks * 32 + fq * 8);
        bf16x8 bi = ld16(wi + (nt * 16 + fr) * 64 + ks * 32 + fq * 8);
        ar[nt] = __builtin_amdgcn_mfma_f32_16x16x32_bf16(af, br, ar[nt], 0, 0, 0);
        ai[nt] = __builtin_amdgcn_mfma_f32_16x16x32_bf16(af, bi, ai[nt], 0, 0, 0);
      }
    }
#pragma unroll
    for (int nt = 0; nt < 4; ++nt) {
      const int k = nt * 16 + fr, cw = blk * 64 + k;
      const int pi = (l * 2 + dir) * 512 + cw;
      const float ba = p.lru_ba[pi], bx = p.lru_bx[pi], lam = p.lru_lam[pi];
      const float sp = log1pf(__expf(-lam));
#pragma unroll
      for (int jj = 0; jj < 4; ++jj) {
        const int t = wave * 16 + fq * 4 + jj;
        float rg = sigm(ar[nt][jj] + ba), ig = sigm(ai[nt][jj] + bx);
        float la = -8.f * rg * sp;
        float a = __expf(la);
        float ud = sb[t * 64 + k];
        float bb = sqrtf(-expm1f(2.f * la)) * (ig * ud);
        sa[t * 64 + k] = a;
        sb[t * 64 + k] = bb;
      }
    }
  }
  __syncthreads();
  {
    const int ch = tid & 63, sub = tid >> 6;
    float h = 0.f, ac = 1.f;
    for (int q = 0; q < 16; ++q) {
      int pos = sub * 16 + q;
      int t = dir ? 63 - pos : pos;
      float a = sa[t * 64 + ch], bb = sb[t * 64 + ch];
      h = a * h + bb;
      ac *= a;
      sa[t * 64 + ch] = ac;
      sb[t * 64 + ch] = h;
    }
    stot[(sub * 64 + ch) * 2] = ac;
    stot[(sub * 64 + ch) * 2 + 1] = h;
    __syncthreads();
    float cA = 1.f, cH = 0.f;
    for (int s2 = 0; s2 < sub; ++s2) {
      float A2 = stot[(s2 * 64 + ch) * 2], H2 = stot[(s2 * 64 + ch) * 2 + 1];
      cH = A2 * cH + H2;
      cA *= A2;
    }
    u16* hl = p.hloc + ((size_t)dir * 8192 + t0) * 512 + blk * 64 + ch;
    u16* acp = p.acum + ((size_t)dir * 8192 + t0) * 512 + blk * 64 + ch;
    float hf = 0.f, af = 1.f;
    for (int q = 0; q < 16; ++q) {
      int pos = sub * 16 + q;
      int t = dir ? 63 - pos : pos;
      hf = sb[t * 64 + ch] + sa[t * 64 + ch] * cH;
      af = sa[t * 64 + ch] * cA;
      hl[(size_t)t * 512] = (u16)f2bf(hf);
      acp[(size_t)t * 512] = (u16)f2bf(af);
    }
    if (sub == 3) {
      p.Atot[(size_t)(cs * 2 + dir) * 512 + blk * 64 + ch] = af;
      p.Htot[(size_t)(cs * 2 + dir) * 512 + blk * 64 + ch] = hf;
    }
  }
  __syncthreads();
}

__device__ void phaseB(const Params& p, int l, char* smem) {
  const int wave = __builtin_amdgcn_readfirstlane(otid() >> 6);
  for (int it = blockIdx.x; it < 3072; it += gridDim.x) {
    if (it < 1024) attn_unit(p, l, it * 4 + wave);
    else lru_unit(p, l, it - 1024, smem);
  }
}

__device__ void phaseB2(const Params& p, int l) {
  const int tid = otid();
  float* new_state = p.out + 25165824;
  for (int u = blockIdx.x; u < 512; u += gridDim.x) {
    const int cs = u >> 2, quarter = u & 3;
    const int ch = quarter * 128 + (tid & 127), half = tid >> 7;
    int first, c, nch, b, seq_lo, seq_hi;
    const bool lat = cs >= 64;
    if (!lat) { b = cs >> 2; c = cs & 3; nch = 4; first = b * 4; seq_lo = b * 256; seq_hi = seq_lo + 256; }
    else { b = (cs - 64) >> 5; c = (cs - 64) & 31; nch = 32; first = 64 + b * 32; seq_lo = 4096 + b * 2048; seq_hi = seq_lo + 2048; }
    float cf = lat ? p.state_lru[(size_t)((b * 4 + l) * 2 + 0) * 512 + ch] : 0.f;
    float cbk = lat ? p.state_lru[(size_t)((b * 4 + l) * 2 + 1) * 512 + ch] : 0.f;
    for (int c2 = 0; c2 < c; ++c2) {
      size_t ix = (size_t)((first + c2) * 2 + 0) * 512 + ch;
      cf = p.Atot[ix] * cf + p.Htot[ix];
    }
    for (int c2 = nch - 1; c2 > c; --c2) {
      size_t ix = (size_t)((first + c2) * 2 + 1) * 512 + ch;
      cbk = p.Atot[ix] * cbk + p.Htot[ix];
    }
    if (!lat && half == 0) {
      if (c == 3) {
        size_t ix = (size_t)(cs * 2 + 0) * 512 + ch;
        new_state[(size_t)((b * 4 + l) * 2 + 0) * 512 + ch] = p.Atot[ix] * cf + p.Htot[ix];
      }
      if (c == 0) {
        size_t ix = (size_t)(cs * 2 + 1) * 512 + ch;
        new_state[(size_t)((b * 4 + l) * 2 + 1) * 512 + ch] = p.Atot[ix] * cbk + p.Htot[ix];
      }
    }
    const float cw0 = p.conv_w[(l * 3 + 0) * 512 + ch], cw1 = p.conv_w[(l * 3 + 1) * 512 + ch],
                cw2 = p.conv_w[(l * 3 + 2) * 512 + ch];
    const int tb = cs * 64 + half * 32;
    float prev = 0.f, cur = 0.f;
    if (tb - 1 >= seq_lo) {
      const u16* pr = p.P + (size_t)(tb - 1) * 8192;
      prev = bf2f(pr[3584 + ch]) * bf2f(pr[4096 + ch]);
    }
    {
      const u16* pr = p.P + (size_t)tb * 8192;
      cur = bf2f(pr[3584 + ch]) * bf2f(pr[4096 + ch]);
    }
    for (int tt = 0; tt < 32; ++tt) {
      const int t = tb + tt;
      const u16* pr = p.P + (size_t)t * 8192;
      float nxt = 0.f;
      if (t + 1 < seq_hi) {
        const u16* pn = pr + 8192;
        nxt = bf2f(pn[3584 + ch]) * bf2f(pn[4096 + ch]);
      }
      float hf = bf2f(p.hloc[(size_t)t * 512 + ch]) + bf2f(p.acum[(size_t)t * 512 + ch]) * cf;
      float hb = bf2f(p.hloc[((size_t)8192 + t) * 512 + ch]) + bf2f(p.acum[((size_t)8192 + t) * 512 + ch]) * cbk;
      float gl = bf2f(pr[2560 + ch]);
      p.Alru[(size_t)t * 512 + ch] = (u16)f2bf((hf + hb) * silu(gl));
      float conv = cw0 * prev + cw1 * cur + cw2 * nxt;
      float cbv = bf2f(pr[3072 + ch]), gc = bf2f(pr[4608 + ch]);
      p.Aconv[(size_t)t * 512 + ch] = (u16)f2bf(cbv * conv * silu(gc));
      prev = cur; cur = nxt;
    }
  }
}

__device__ void phaseC1(const Params& p, int l, char* smem) {
  const int tid = otid(), lane = tid & 63, wave = tid >> 6;
  const int wm = wave >> 1, wn = wave & 1, fr = lane & 15, fq = lane >> 4;
  for (int id = blockIdx.x; id < 512; id += gridDim.x) {
    int xcd = id & 7, j_ = id >> 3;
    int mt = xcd * 8 + (j_ >> 3), nt = j_ & 7;
    int m0 = mt * 128, n0 = nt * 128;
    f32x4 tot[4][4];
    zero_acc(tot);
#pragma unroll 1
    for (int br = 0; br < 3; ++br) {
      f32x4 acc[4][4];
      zero_acc(acc);
      const u16* A = p.Ana + (size_t)br * 8192 * 512 + (size_t)m0 * 512;
      const u16* B = p.wt_br + (size_t)(l * 3 + br) * 1024 * 512 + (size_t)n0 * 512;
      gemm_mainloop<true>(A, 512, B, 512, 512, acc, smem);
#pragma unroll
      for (int i = 0; i < 4; ++i)
#pragma unroll
        for (int j = 0; j < 4; ++j) {
          int t = m0 + wm * 64 + i * 16 + fr;
          int col = n0 + wn * 64 + j * 16 + fq * 4;
          uint2 g = *(const uint2*)(p.P + (size_t)t * 8192 + 5120 + br * 1024 + col);
          tot[i][j][0] += sigm(lo16(g.x)) * acc[i][j][0];
          tot[i][j][1] += sigm(hi16(g.x)) * acc[i][j][1];
          tot[i][j][2] += sigm(lo16(g.y)) * acc[i][j][2];
          tot[i][j][3] += sigm(hi16(g.y)) * acc[i][j][3];
        }
    }
#pragma unroll
    for (int i = 0; i < 4; ++i)
#pragma unroll
      for (int j = 0; j < 4; ++j) {
        int t = m0 + wm * 64 + i * 16 + fr;
        int col = n0 + wn * 64 + j * 16 + fq * 4;
        *(uint2*)(p.merged + (size_t)t * 1024 + col) =
            make_uint2(pack2(tot[i][j][0], tot[i][j][1]), pack2(tot[i][j][2], tot[i][j][3]));
      }
  }
}

__device__ void phaseC2(const Params& p, int l, char* smem) {
  const int tid = otid(), lane = tid & 63, wave = tid >> 6;
  const int wm = wave >> 1, wn = wave & 1, fr = lane & 15, fq = lane >> 4;
  for (int id = blockIdx.x; id < 512; id += gridDim.x) {
    int xcd = id & 7, j_ = id >> 3;
    int mt = xcd * 8 + (j_ >> 3), nt = j_ & 7;
    int m0 = mt * 128, n0 = nt * 128;
    f32x4 acc[4][4];
    zero_acc(acc);
    gemm_mainloop<true>(p.merged + (size_t)m0 * 1024, 1024, p.wt_out + (size_t)l * 1024 * 1024 + (size_t)n0 * 1024, 1024,
                        1024, acc, smem);
#pragma unroll
    for (int i = 0; i < 4; ++i)
#pragma unroll
      for (int j = 0; j < 4; ++j) {
        int t = m0 + wm * 64 + i * 16 + fr;
        int col = n0 + wn * 64 + j * 16 + fq * 4;
        int cid = t < 4096 ? 0 : 1 + ((t - 4096) >> 11);
        float4 gt = *(const float4*)(p.mod + (size_t)(l * 3 + cid) * 3072 + 2048 + col);
        float4 xo = *(const float4*)(xrow(p, l, t) + col);
        *(float4*)(p.xbuf + (size_t)t * 1024 + col) =
            make_float4(xo.x + gt.x * acc[i][j][0], xo.y + gt.y * acc[i][j][1], xo.z + gt.z * acc[i][j][2],
                        xo.w + gt.w * acc[i][j][3]);
      }
  }
}

__global__ void __launch_bounds__(NTHREADS, 2) mega(Params p) {
  __shared__ __attribute__((aligned(16))) char smem[SMEM_BYTES];
  cg::grid_group grid = cg::this_grid();
  const int lo = p.phase_lo, hi = p.phase_hi;
#define RUN_PHASE(PH, CALL) { const int ph_ = (PH); if (ph_ >= lo && ph_ < hi) { CALL; if (ph_ + 1 < hi) grid.sync(); } }
  RUN_PHASE(0, phase0(p, smem));
#pragma unroll 1
  for (int l = 0; l < 4; ++l) {
    RUN_PHASE(1 + l * 6, phaseN(p, l));
    RUN_PHASE(2 + l * 6, phaseA(p, l, smem));
    RUN_PHASE(3 + l * 6, phaseB(p, l, smem));
    RUN_PHASE(4 + l * 6, phaseB2(p, l));
    RUN_PHASE(5 + l * 6, phaseC1(p, l, smem));
    RUN_PHASE(6 + l * 6, phaseC2(p, l, smem));
  }
  RUN_PHASE(25, phaseF(p));
}

extern "C" void kernel_launch(void* const* d_in, const int* in_sizes, int n_in, void* d_out, int out_size, void* d_ws,
                              size_t ws_size, hipStream_t stream) {
  static int grid_blocks = 0;
  if (!grid_blocks) {
    int dev = 0, cus = 0, per_cu = 0;
    hipGetDevice(&dev);
    hipDeviceGetAttribute(&cus, hipDeviceAttributeMultiprocessorCount, dev);
    hipOccupancyMaxActiveBlocksPerMultiprocessor(&per_cu, mega, NTHREADS, 0);
    if (per_cu > 2) per_cu = 2;
    if (per_cu < 1) per_cu = 1;
    grid_blocks = cus * per_cu;
  }
  Params p;
  memset(&p, 0, sizeof(p));
  const float** fp = (const float**)&p;
  for (int i = 0; i < 25; ++i) fp[i] = (const float*)d_in[i];
  p.out = (float*)d_out;
  char* w = (char*)d_ws;
  size_t off = 0;
  auto take = [&](size_t bytes) { char* r = w + off; off += (bytes + 255) & ~(size_t)255; return r; };
  p.wt_in = (u16*)take((size_t)4 * 8192 * 1024 * 2);
  p.wt_br = (u16*)take((size_t)4 * 3 * 1024 * 512 * 2);
  p.wt_out = (u16*)take((size_t)4 * 1024 * 1024 * 2);
  p.wgT = (u16*)take((size_t)128 * 4096 * 2);
  p.ckb = (u16*)take((size_t)2 * 4 * 256 * 512 * 2);
  p.cvT = (u16*)take((size_t)2 * 4 * 256 * 512 * 2);
  p.xm = (u16*)take((size_t)8192 * 1024 * 2);
  p.P = (u16*)take((size_t)8192 * 8192 * 2);
  p.Vt = (u16*)take((size_t)512 * 8192 * 2);
  p.Ana = (u16*)take((size_t)8192 * 512 * 2);
  p.Alru = (u16*)take((size_t)8192 * 512 * 2);
  p.Aconv = (u16*)take((size_t)8192 * 512 * 2);
  p.merged = (u16*)take((size_t)8192 * 1024 * 2);
  p.hloc = (u16*)take((size_t)2 * 8192 * 512 * 2);
  p.acum = (u16*)take((size_t)2 * 8192 * 512 * 2);
  p.mod = (float*)take((size_t)4 * 3 * 3072 * 4);
  p.xbuf = (float*)take((size_t)8192 * 1024 * 4);
  p.Atot = (float*)take((size_t)128 * 2 * 512 * 4);
  p.Htot = (float*)take((size_t)128 * 2 * 512 * 4);
  if (off > ws_size) { fprintf(stderr, "workspace too small: need %zu have %zu\n", off, ws_size); return; }
#ifdef MULTI_LAUNCH
  for (int ph = 0; ph < 26; ++ph) {
    p.phase_lo = ph; p.phase_hi = ph + 1;
    hipLaunchKernelGGL(mega, dim3(grid_blocks), dim3(NTHREADS), 0, stream, p);
  }
#else
  p.phase_lo = 0; p.phase_hi = 26;
  void* args[] = {&p};
  hipError_t e = hipLaunchCooperativeKernel((void*)mega, dim3(grid_blocks), dim3(NTHREADS), args, 0, stream);
  if (e != hipSuccess) fprintf(stderr, "cooperative launch failed: %s (grid %d)\n", hipGetErrorString(e), grid_blocks);
#endif
}
```

```cpp
#include <hip/hip_runtime.h>
#include <hip/hip_cooperative_groups.h>
#include <cstdio>
#include <cstring>
namespace cg = cooperative_groups;

typedef unsigned short u16;
using bf16x8 = __attribute__((ext_vector_type(8))) short;
using f32x4 = __attribute__((ext_vector_type(4))) float;
using u32x4 = __attribute__((ext_vector_type(4))) unsigned;

#define NTHREADS 256
#define SMEM_BYTES 65536
#define DYN_LDS (SMEM_BYTES + 64)

struct Params {
  const float *x_prompt, *x_sample, *cache_k, *cache_v, *state_lru, *c, *c_ctx, *norm_g, *w_mod, *b_mod,
      *w_in, *na_rpb, *lru_conv_w, *lru_conv_b, *lru_wa, *lru_ba, *lru_wx, *lru_bx, *lru_lam, *conv_w,
      *w_br_na, *w_br_lru, *w_br_conv, *w_out, *final_g;
  float* out;
  u16 *wt_in, *wt_br, *wt_out, *wgT, *ckb, *cvT, *xm, *P, *Vt, *Ana, *Alru, *Aconv, *merged, *hloc, *acum;
  float *mod, *xbuf, *Atot, *Htot;
  unsigned* bar;
  int phase_lo, phase_hi;
};

__device__ __forceinline__ int otid() { int t = threadIdx.x; asm volatile("" : "+v"(t)); return t; }
__device__ __forceinline__ unsigned f2bf(float f) {
  unsigned u = __float_as_uint(f);
  u += 0x7fffu + ((u >> 16) & 1u);
  return u >> 16;
}
__device__ __forceinline__ float bf2f(unsigned h) { return __uint_as_float(h << 16); }
__device__ __forceinline__ unsigned pack2(float a, float b) { return f2bf(a) | (f2bf(b) << 16); }
__device__ __forceinline__ float sigm(float x) { return 1.f / (1.f + __expf(-x)); }
__device__ __forceinline__ float silu(float x) { return x / (1.f + __expf(-x)); }
__device__ __forceinline__ float lo16(unsigned w) { return __uint_as_float(w << 16); }
__device__ __forceinline__ float hi16(unsigned w) { return __uint_as_float(w & 0xffff0000u); }

__device__ void transpose_unit(const float* __restrict__ src, int N, u16* __restrict__ dst, int K, int k0, int n0,
                               float* sm) {
  const int tid = otid();
#pragma unroll
  for (int i = 0; i < 4; ++i) {
    int r = (tid >> 4) + i * 16, c4 = (tid & 15) * 4;
    float4 v = *(const float4*)(src + (size_t)(k0 + r) * N + n0 + c4);
    sm[r * 65 + c4 + 0] = v.x; sm[r * 65 + c4 + 1] = v.y; sm[r * 65 + c4 + 2] = v.z; sm[r * 65 + c4 + 3] = v.w;
  }
  __syncthreads();
  const int n = tid >> 2, kq = (tid & 3) * 16;
  unsigned w[8];
#pragma unroll
  for (int kk = 0; kk < 8; ++kk) w[kk] = pack2(sm[(kq + 2 * kk) * 65 + n], sm[(kq + 2 * kk + 1) * 65 + n]);
  uint4* d = (uint4*)(dst + (size_t)(n0 + n) * K + k0 + kq);
  d[0] = make_uint4(w[0], w[1], w[2], w[3]);
  d[1] = make_uint4(w[4], w[5], w[6], w[7]);
  __syncthreads();
}

__device__ void phase0(const Params& p, char* smem) {
  float* sm = (float*)smem;
  const int tid = otid();
  const int NU = 384 + 8192 + 1536 + 1024 + 512 + 512 + 128 + 2048;
  for (int u = blockIdx.x; u < NU; u += gridDim.x) {
    int v = u;
    if (v < 384) {
      int l = v / 96, cgp = v % 96;
      int c = cgp * 32 + (tid & 31), kg = tid >> 5;
      float a0 = 0.f, a1 = 0.f, a2 = 0.f;
      const float* w = p.w_mod + (size_t)l * 1024 * 3072 + c;
      for (int k = kg * 128; k < kg * 128 + 128; ++k) {
        float wv = w[(size_t)k * 3072];
        a0 += silu(p.c_ctx[k]) * wv; a1 += silu(p.c[k]) * wv; a2 += silu(p.c[1024 + k]) * wv;
      }
      sm[(kg * 3 + 0) * 32 + (tid & 31)] = a0;
      sm[(kg * 3 + 1) * 32 + (tid & 31)] = a1;
      sm[(kg * 3 + 2) * 32 + (tid & 31)] = a2;
      __syncthreads();
      if (tid < 96) {
        int cond = tid >> 5, cc = tid & 31;
        float s = p.b_mod[l * 3072 + cgp * 32 + cc];
#pragma unroll
        for (int g = 0; g < 8; ++g) s += sm[(g * 3 + cond) * 32 + cc];
        p.mod[(size_t)(l * 3 + cond) * 3072 + cgp * 32 + cc] = s;
      }
      __syncthreads();
      continue;
    }
    v -= 384;
    if (v < 8192) {
      int l = v >> 11, r = v & 2047, kt = r >> 7, nt = r & 127;
      transpose_unit(p.w_in + (size_t)l * 1024 * 8192, 8192, p.wt_in + (size_t)l * 8192 * 1024, 1024, kt * 64, nt * 64, sm);
      continue;
    }
    v -= 8192;
    if (v < 1536) {
      int l = v / 384, r = v % 384, br = r >> 7, q = r & 127, kt = q >> 4, nt = q & 15;
      u16* dst = p.wt_br + (size_t)(l * 3 + br) * 1024 * 512;
      if (br == 0) transpose_unit(p.w_br_na + (size_t)l * 512 * 1024, 1024, dst, 512, kt * 64, nt * 64, sm);
      else if (br == 1) transpose_unit(p.w_br_lru + (size_t)l * 512 * 1024, 1024, dst, 512, kt * 64, nt * 64, sm);
      else transpose_unit(p.w_br_conv + (size_t)l * 512 * 1024, 1024, dst, 512, kt * 64, nt * 64, sm);
      continue;
    }
    v -= 1536;
    if (v < 1024) {
      int l = v >> 8, r = v & 255, kt = r >> 4, nt = r & 15;
      transpose_unit(p.w_out + (size_t)l * 1024 * 1024, 1024, p.wt_out + (size_t)l * 1024 * 1024, 1024, kt * 64, nt * 64, sm);
      continue;
    }
    v -= 1024;
    if (v < 512) {
      size_t idx = ((size_t)v * 256 + tid) * 8;
      float4 a = *(const float4*)(p.cache_k + idx), b = *(const float4*)(p.cache_k + idx + 4);
      *(uint4*)(p.ckb + idx) = make_uint4(pack2(a.x, a.y), pack2(a.z, a.w), pack2(b.x, b.y), pack2(b.z, b.w));
      continue;
    }
    v -= 512;
    if (v < 512) {
      int g = v * 256 + tid;
      int d = g & 63, h = (g >> 6) & 7, kg = (g >> 9) & 31, bl = g >> 14;
      float f[8];
#pragma unroll
      for (int j = 0; j < 8; ++j) f[j] = p.cache_v[((size_t)(bl * 256 + kg * 8 + j) * 8 + h) * 64 + d];
      *(uint4*)(p.cvT + ((size_t)(bl * 8 + h) * 64 + d) * 256 + kg * 8) =
          make_uint4(pack2(f[0], f[1]), pack2(f[2], f[3]), pack2(f[4], f[5]), pack2(f[6], f[7]));
      continue;
    }
    v -= 512;
    if (v >= 128) {
      v -= 128;
      const size_t o = ((size_t)(v & 1023) * 256 + tid) * 16;
      if (v < 1024) {
#pragma unroll
        for (int i = 0; i < 4; ++i) *(float4*)(p.xbuf + o + i * 4) = *(const float4*)(p.x_prompt + o + i * 4);
      } else {
#pragma unroll
        for (int i = 0; i < 4; ++i) *(float4*)(p.xbuf + 4194304 + o + i * 4) = *(const float4*)(p.x_sample + o + i * 4);
      }
      continue;
    }
    {
      int blk = v & 7, gate = (v >> 3) & 1, dir = (v >> 4) & 1, l = v >> 5;
      const size_t so = (size_t)((l * 2 + dir) * 8 + blk) * 4096;
      u16* dst = p.wgT + (size_t)v * 4096;
      for (int idx = tid; idx < 4096; idx += 256) {
        int k = idx >> 6, j = idx & 63;
        float wv;
        if (gate) wv = p.lru_wx[so + j * 64 + k]; else wv = p.lru_wa[so + j * 64 + k];
        dst[idx] = (u16)f2bf(wv);
      }
    }
  }
}

__device__ __forceinline__ const float* xrow(const Params& p, int l, int t) {
  return p.xbuf + (size_t)t * 1024;
}
__device__ __forceinline__ float wave_sum(float v) {
#pragma unroll
  for (int o = 32; o >= 1; o >>= 1) v += __shfl_xor(v, o);
  return v;
}

__device__ void phaseN(const Params& p, int l) {
  const int lane = otid() & 63, wave = otid() >> 6;
  const float* g = p.norm_g + l * 1024;
  for (int t = blockIdx.x * 4 + wave; t < 8192; t += gridDim.x * 4) {
    const float* x = xrow(p, l, t);
    float4 v[4];
    float ss = 0.f;
#pragma unroll
    for (int i = 0; i < 4; ++i) {
      v[i] = *(const float4*)(x + i * 256 + lane * 4);
      ss += v[i].x * v[i].x + v[i].y * v[i].y + v[i].z * v[i].z + v[i].w * v[i].w;
    }
    ss = wave_sum(ss);
    float rstd = rsqrtf(ss * (1.f / 1024.f) + 1e-6f);
    int cid = t < 4096 ? 0 : 1 + ((t - 4096) >> 11);
    const float* md = p.mod + (size_t)(l * 3 + cid) * 3072;
#pragma unroll
    for (int i = 0; i < 4; ++i) {
      int c = i * 256 + lane * 4;
      float4 gg = *(const float4*)(g + c), sh = *(const float4*)(md + c), sc = *(const float4*)(md + 1024 + c);
      float y0 = v[i].x * rstd * gg.x * (1.f + sc.x) + sh.x;
      float y1 = v[i].y * rstd * gg.y * (1.f + sc.y) + sh.y;
      float y2 = v[i].z * rstd * gg.z * (1.f + sc.z) + sh.z;
      float y3 = v[i].w * rstd * gg.w * (1.f + sc.w) + sh.w;
      *(uint2*)(p.xm + (size_t)t * 1024 + c) = make_uint2(pack2(y0, y1), pack2(y2, y3));
    }
  }
}

__device__ void phaseF(const Params& p) {
  const int lane = otid() & 63, wave = otid() >> 6;
  for (int t = blockIdx.x * 4 + wave; t < 8192; t += gridDim.x * 4) {
    const float* x = p.xbuf + (size_t)t * 1024;
    float4 v[4];
    float ss = 0.f;
#pragma unroll
    for (int i = 0; i < 4; ++i) {
      v[i] = *(const float4*)(x + i * 256 + lane * 4);
      ss += v[i].x * v[i].x + v[i].y * v[i].y + v[i].z * v[i].z + v[i].w * v[i].w;
    }
    ss = wave_sum(ss);
    float rstd = rsqrtf(ss * (1.f / 1024.f) + 1e-6f);
#pragma unroll
    for (int i = 0; i < 4; ++i) {
      int c = i * 256 + lane * 4;
      float4 gg = *(const float4*)(p.final_g + c);
      *(float4*)(p.out + (size_t)t * 1024 + c) =
          make_float4(v[i].x * rstd * gg.x, v[i].y * rstd * gg.y, v[i].z * rstd * gg.z, v[i].w * rstd * gg.w);
    }
  }
}

template <bool SWAP>
__device__ __forceinline__ void gemm_mainloop(const u16* __restrict__ A, int lda, const u16* __restrict__ B, int ldb,
                                              int K, f32x4 (&acc)[4][4], char* smem) {
  const int tid = otid(), lane = tid & 63, wave = tid >> 6;
  const int wm = wave >> 1, wn = wave & 1, fr = lane & 15, fq = lane >> 4;
  const int lr = tid >> 3, lc = tid & 7;
  const u16* ag = A + (size_t)lr * lda + lc * 8;
  const u16* bg = B + (size_t)lr * ldb + lc * 8;
  const int woff = lr * 128 + ((lc ^ ((lr >> 1) & 7)) << 4);
  char* sA = smem;
  char* sB = smem + 32768;
  uint4 ra[4], rb[4];
#pragma unroll
  for (int i = 0; i < 4; ++i) {
    ra[i] = *(const uint4*)(ag + (size_t)i * 32 * lda);
    rb[i] = *(const uint4*)(bg + (size_t)i * 32 * ldb);
  }
#pragma unroll
  for (int i = 0; i < 4; ++i) {
    *(uint4*)(sA + woff + i * 4096) = ra[i];
    *(uint4*)(sB + woff + i * 4096) = rb[i];
  }
  __syncthreads();
  const int swz_r = (fr >> 1) & 7;
  const int aoff = (wm * 64 + fr) * 128, boff = (wn * 64 + fr) * 128;
  const int nk = K >> 6;
  for (int kt = 0; kt < nk; ++kt) {
    const int cur = kt & 1;
    if (kt + 1 < nk) {
#pragma unroll
      for (int i = 0; i < 4; ++i) {
        ra[i] = *(const uint4*)(ag + (size_t)i * 32 * lda + (kt + 1) * 64);
        rb[i] = *(const uint4*)(bg + (size_t)i * 32 * ldb + (kt + 1) * 64);
      }
    }
    const char* cA = sA + cur * 16384 + aoff;
    const char* cB = sB + cur * 16384 + boff;
#pragma unroll
    for (int ks = 0; ks < 2; ++ks) {
      bf16x8 af[4], bfr[4];
      const int ch = ((ks * 4 + fq) ^ swz_r) << 4;
#pragma unroll
      for (int i = 0; i < 4; ++i) {
        af[i] = *(const bf16x8*)(cA + i * 2048 + ch);
        bfr[i] = *(const bf16x8*)(cB + i * 2048 + ch);
      }
#pragma unroll
      for (int i = 0; i < 4; ++i)
#pragma unroll
        for (int j = 0; j < 4; ++j) {
          if (SWAP) acc[i][j] = __builtin_amdgcn_mfma_f32_16x16x32_bf16(bfr[j], af[i], acc[i][j], 0, 0, 0);
          else acc[i][j] = __builtin_amdgcn_mfma_f32_16x16x32_bf16(af[i], bfr[j], acc[i][j], 0, 0, 0);
        }
    }
    if (kt + 1 < nk) {
      char* nA = sA + (cur ^ 1) * 16384 + woff;
      char* nB = sB + (cur ^ 1) * 16384 + woff;
#pragma unroll
      for (int i = 0; i < 4; ++i) {
        *(uint4*)(nA + i * 4096) = ra[i];
        *(uint4*)(nB + i * 4096) = rb[i];
      }
    }
    __syncthreads();
  }
}

__device__ __forceinline__ void zero_acc(f32x4 (&acc)[4][4]) {
#pragma unroll
  for (int i = 0; i < 4; ++i)
#pragma unroll
    for (int j = 0; j < 4; ++j) acc[i][j] = f32x4{0.f, 0.f, 0.f, 0.f};
}

__device__ void phaseA(const Params& p, int l, char* smem) {
  const int tid = otid(), lane = tid & 63, wave = tid >> 6;
  const int wm = wave >> 1, wn = wave & 1, fr = lane & 15, fq = lane >> 4;
  const u16* W = p.wt_in + (size_t)l * 8192 * 1024;
  float* newk = p.out + 8388608;
  float* newv = p.out + 16777216;
  for (int id = blockIdx.x; id < 4096; id += gridDim.x) {
    int xcd = id & 7, j_ = id >> 3;
    int grp = xcd * 8 + (j_ >> 6), within = j_ & 63;
    int mt = (grp >> 3) * 8 + (within >> 3), nt = (grp & 7) * 8 + (within & 7);
    int m0 = mt * 128, n0 = nt * 128;
    f32x4 acc[4][4];
    zero_acc(acc);
    const u16* A = p.xm + (size_t)m0 * 1024;
    const u16* B = W + (size_t)n0 * 1024;
    if (n0 >= 1024 && n0 < 1536) {
      gemm_mainloop<false>(A, 1024, B, 1024, 1024, acc, smem);
#pragma unroll
      for (int i = 0; i < 4; ++i)
#pragma unroll
        for (int j = 0; j < 4; ++j) {
          int tok0 = m0 + wm * 64 + i * 16 + fq * 4;
          int vc = n0 + wn * 64 + j * 16 + fr - 1024;
          f32x4 v = acc[i][j];
          *(uint2*)(p.Vt + (size_t)vc * 8192 + tok0) = make_uint2(pack2(v[0], v[1]), pack2(v[2], v[3]));
          if (tok0 < 4096) {
#pragma unroll
            for (int jj = 0; jj < 4; ++jj) {
              int t = tok0 + jj;
              newv[((size_t)((t >> 8) * 4 + l) * 256 + (t & 255)) * 512 + vc] = v[jj];
            }
          }
        }
    } else {
      gemm_mainloop<true>(A, 1024, B, 1024, 1024, acc, smem);
      const bool isK = (n0 >= 512 && n0 < 1024);
#pragma unroll
      for (int i = 0; i < 4; ++i)
#pragma unroll
        for (int j = 0; j < 4; ++j) {
          int t = m0 + wm * 64 + i * 16 + fr;
          int col = n0 + wn * 64 + j * 16 + fq * 4;
          f32x4 v = acc[i][j];
          *(uint2*)(p.P + (size_t)t * 8192 + col) = make_uint2(pack2(v[0], v[1]), pack2(v[2], v[3]));
          if (isK && t < 4096)
            *(float4*)(newk + ((size_t)((t >> 8) * 4 + l) * 256 + (t & 255)) * 512 + (col - 512)) =
                make_float4(v[0], v[1], v[2], v[3]);
        }
    }
  }
}

__device__ __forceinline__ bf16x8 ld16(const u16* ptr) { return *(const bf16x8*)ptr; }

__device__ void attn_unit(const Params& p, int l, int unit) {
  const int lane = otid() & 63, fr = lane & 15, fq = lane >> 4;
  const bool lat = unit >= 2048;
  int b, h, qtok0, r = 0, n = 0, row0 = 0, band0 = 0;
  if (!lat) {
    b = unit >> 7; h = (unit >> 4) & 7;
    qtok0 = b * 256 + (unit & 15) * 16;
  } else {
    int u = unit - 2048;
    b = u >> 10; r = (u >> 5) & 31; n = (u >> 3) & 3; h = u & 7;
    qtok0 = 4096 + b * 2048 + r * 64 + n * 16;
    row0 = min(max(r - 4, 0), 24);
    band0 = min(max(16 * n - 8, 0), 32);
  }
  const u16* qp = p.P + (size_t)(qtok0 + fr) * 8192 + h * 64 + fq * 8;
  const bf16x8 q0 = ld16(qp), q1 = ld16(qp + 32);
  f32x4 o[4];
#pragma unroll
  for (int dt = 0; dt < 4; ++dt) o[dt] = f32x4{0.f, 0.f, 0.f, 0.f};
  float m = -1e30f, lsum = 0.f;
  const float* rpb = p.na_rpb + (size_t)(l * 8 + h) * 15 * 31;
  const int qc = 16 * n + fr;
  const int wst = min(max(qc - 8, 0), 48);
  const int nchunks = lat ? 8 : 4;
#pragma unroll 1
  for (int c = 0; c < nchunks; ++c) {
    const bool local = lat && c < 4;
    const u16 *kb, *vb;
    size_t kstride, kslab, vstride, vslab;
    if (!lat) {
      size_t key0 = (size_t)b * 256 + c * 64;
      kb = p.P + key0 * 8192 + 512 + h * 64; kstride = 8192; kslab = (size_t)32 * 8192;
      vb = p.Vt + (size_t)(h * 64) * 8192 + key0; vstride = 8192; vslab = 32;
    } else if (local) {
      size_t tok = 4096 + (size_t)b * 2048 + (row0 + c * 2) * 64 + band0;
      kb = p.P + tok * 8192 + 512 + h * 64; kstride = 8192; kslab = (size_t)64 * 8192;
      vb = p.Vt + (size_t)(h * 64) * 8192 + tok; vstride = 8192; vslab = 64;
    } else {
      int cc = c - 4;
      kb = p.ckb + ((size_t)(b * 4 + l) * 256 + cc * 64) * 512 + h * 64; kstride = 512; kslab = (size_t)32 * 512;
      vb = p.cvT + (size_t)((b * 4 + l) * 8 + h) * 64 * 256 + cc * 64; vstride = 256; vslab = 32;
    }
    f32x4 s[4];
#pragma unroll
    for (int mt = 0; mt < 4; ++mt) {
      const u16* kp = kb + (mt >> 1) * kslab + (size_t)((mt & 1) * 16 + fr) * kstride + fq * 8;
      bf16x8 a0 = ld16(kp), a1 = ld16(kp + 32);
      f32x4 z = f32x4{0.f, 0.f, 0.f, 0.f};
      z = __builtin_amdgcn_mfma_f32_16x16x32_bf16(a0, q0, z, 0, 0, 0);
      s[mt] = __builtin_amdgcn_mfma_f32_16x16x32_bf16(a1, q1, z, 0, 0, 0);
    }
    float cmax = -1e30f;
#pragma unroll
    for (int mt = 0; mt < 4; ++mt) {
      const int row_off = row0 + c * 2 + (mt >> 1) - r + 7;
#pragma unroll
      for (int jj = 0; jj < 4; ++jj) {
        float v = s[mt][jj] * 0.125f;
        if (local) {
          int kc = band0 + (mt & 1) * 16 + fq * 4 + jj;
          bool valid = (kc >= wst) && (kc < wst + 16);
          int col_off = min(max(kc - qc, -15), 15) + 15;
          float bias = rpb[row_off * 31 + col_off];
          v = valid ? v + bias : -1e30f;
        }
        s[mt][jj] = v;
        cmax = fmaxf(cmax, v);
      }
    }
    cmax = fmaxf(cmax, __shfl_xor(cmax, 16));
    cmax = fmaxf(cmax, __shfl_xor(cmax, 32));
    const float mnew = fmaxf(m, cmax);
    const float alpha = __expf(m - mnew);
    m = mnew;
    lsum *= alpha;
#pragma unroll
    for (int dt = 0; dt < 4; ++dt) o[dt] *= alpha;
#pragma unroll
    for (int mt = 0; mt < 4; ++mt)
#pragma unroll
      for (int jj = 0; jj < 4; ++jj) {
        float pv = __expf(s[mt][jj] - m);
        lsum += pv;
        s[mt][jj] = pv;
      }
#pragma unroll
    for (int sl = 0; sl < 2; ++sl) {
      u32x4 pw = {pack2(s[2 * sl][0], s[2 * sl][1]), pack2(s[2 * sl][2], s[2 * sl][3]),
                  pack2(s[2 * sl + 1][0], s[2 * sl + 1][1]), pack2(s[2 * sl + 1][2], s[2 * sl + 1][3])};
      bf16x8 pb = __builtin_bit_cast(bf16x8, pw);
#pragma unroll
      for (int dt = 0; dt < 4; ++dt) {
        const u16* vp = vb + sl * vslab + (size_t)(dt * 16 + fr) * vstride + fq * 4;
        uint2 v0 = *(const uint2*)vp, v1 = *(const uint2*)(vp + 16);
        u32x4 vw = {v0.x, v0.y, v1.x, v1.y};
        o[dt] = __builtin_amdgcn_mfma_f32_16x16x32_bf16(__builtin_bit_cast(bf16x8, vw), pb, o[dt], 0, 0, 0);
      }
    }
  }
  lsum += __shfl_xor(lsum, 16);
  lsum += __shfl_xor(lsum, 32);
  const float inv = 1.f / lsum;
  const size_t t = qtok0 + fr;
#pragma unroll
  for (int dt = 0; dt < 4; ++dt) {
    int d0 = h * 64 + dt * 16 + fq * 4;
    uint2 g = *(const uint2*)(p.P + t * 8192 + 1536 + d0);
    float y0 = o[dt][0] * inv * silu(lo16(g.x)), y1 = o[dt][1] * inv * silu(hi16(g.x));
    float y2 = o[dt][2] * inv * silu(lo16(g.y)), y3 = o[dt][3] * inv * silu(hi16(g.y));
    *(uint2*)(p.Ana + t * 512 + d0) = make_uint2(pack2(y0, y1), pack2(y2, y3));
  }
}

__device__ void lru_unit(const Params& p, int l, int unit, char* smem) {
  const int tid = otid(), lane = tid & 63, wave = tid >> 6, fr = lane & 15, fq = lane >> 4;
  const int blk = unit & 7, dir = (unit >> 3) & 1, cs = unit >> 4;
  const int t0 = cs * 64;
  int seq_lo, seq_hi;
  if (cs < 64) { seq_lo = (cs >> 2) * 256; seq_hi = seq_lo + 256; }
  else { seq_lo = 4096 + ((cs - 64) >> 5) * 2048; seq_hi = seq_lo + 2048; }
  u16* uraw = (u16*)smem;
  u16* udb = (u16*)(smem + 8704);
  float* sa = (float*)(smem + 8704 + 9216);
  float* sb = sa + 4096;
  float* stot = sb + 4096;
  const int wbase = dir ? t0 : t0 - 3;
#pragma unroll
  for (int i = 0; i < 3; ++i) {
    int row = (tid >> 3) + i * 32, ch8 = tid & 7;
    if (row < 67) {
      int t = wbase + row;
      uint4 v = make_uint4(0, 0, 0, 0);
      if (t >= seq_lo && t < seq_hi) v = *(const uint4*)(p.P + (size_t)t * 8192 + 2048 + blk * 64 + ch8 * 8);
      *(uint4*)(uraw + row * 64 + ch8 * 8) = v;
    }
  }
  __syncthreads();
  {
    const int ch = tid & 63, tg = tid >> 6;
    const int cw = blk * 64 + ch;
    const float* cwp = p.lru_conv_w + (size_t)((l * 2 + dir) * 4) * 512 + cw;
    const float w0 = cwp[0], w1 = cwp[512], w2 = cwp[1024], w3 = cwp[1536];
    const float cb = p.lru_conv_b[(l * 2 + dir) * 512 + cw];
    for (int t = tg * 16; t < tg * 16 + 16; ++t) {
      float ud = cb + w0 * bf2f(uraw[t * 64 + ch]) + w1 * bf2f(uraw[(t + 1) * 64 + ch]) +
                 w2 * bf2f(uraw[(t + 2) * 64 + ch]) + w3 * bf2f(uraw[(t + 3) * 64 + ch]);
      sb[t * 64 + ch] = ud;
      udb[t * 72 + ch] = (u16)f2bf(ud);
    }
  }
  __syncthreads();
  {
    f32x4 ar[4], ai[4];
#pragma unroll
    for (int nt = 0; nt < 4; ++nt) { ar[nt] = f32x4{0.f, 0.f, 0.f, 0.f}; ai[nt] = f32x4{0.f, 0.f, 0.f, 0.f}; }
    const u16* wr = p.wgT + (size_t)(((l * 2 + dir) * 2 + 0) * 8 + blk) * 4096;
    const u16* wi = p.wgT + (size_t)(((l * 2 + dir) * 2 + 1) * 8 + blk) * 4096;
#pragma unroll
    for (int ks = 0; ks < 2; ++ks) {
      bf16x8 af = *(const bf16x8*)(udb + (wave * 16 + fr) * 72 + ks * 32 + fq * 8);
#pragma unroll
      for (int nt = 0; nt < 4; ++nt) {
        bf16x8 br = ld16(wr + (nt * 16 + fr) * 64 + ks * 32 + fq * 8);
        bf16x8 bi = ld16(wi + (nt * 16 + fr) * 64 + ks * 32 + fq * 8);
        ar[nt] = __builtin_amdgcn_mfma_f32_16x16x32_bf16(af, br, ar[nt], 0, 0, 0);
        ai[nt] = __builtin_amdgcn_mfma_f32_16x16x32_bf16(af, bi, ai[nt], 0, 0, 0);
      }
    }
#pragma unroll
    for (int nt = 0; nt < 4; ++nt) {
      const int k = nt * 16 + fr, cw = blk * 64 + k;
      const int pi = (l * 2 + dir) * 512 + cw;
      const float ba = p.lru_ba[pi], bx = p.lru_bx[pi], lam = p.lru_lam[pi];
      const float sp = log1pf(__expf(-lam));
#pragma unroll
      for (int jj = 0; jj < 4; ++jj) {
        const int t = wave * 16 + fq * 4 + jj;
        float rg = sigm(ar[nt][jj] + ba), ig = sigm(ai[nt][jj] + bx);
        float la = -8.f * rg * sp;
        float a = __expf(la);
        float ud = sb[t * 64 + k];
        float bb = sqrtf(-expm1f(2.f * la)) * (ig * ud);
        sa[t * 64 + k] = a;
        sb[t * 64 + k] = bb;
      }
    }
  }
  __syncthreads();
  {
    const int ch = tid & 63, sub = tid >> 6;
    float h = 0.f, ac = 1.f;
    for (int q = 0; q < 16; ++q) {
      int pos = sub * 16 + q;
      int t = dir ? 63 - pos : pos;
      float a = sa[t * 64 + ch], bb = sb[t * 64 + ch];
      h = a * h + bb;
      ac *= a;
      sa[t * 64 + ch] = ac;
      sb[t * 64 + ch] = h;
    }
    stot[(sub * 64 + ch) * 2] = ac;
    stot[(sub * 64 + ch) * 2 + 1] = h;
    __syncthreads();
    float cA = 1.f, cH = 0.f;
    for (int s2 = 0; s2 < sub; ++s2) {
      float A2 = stot[(s2 * 64 + ch) * 2], H2 = stot[(s2 * 64 + ch) * 2 + 1];
      cH = A2 * cH + H2;
      cA *= A2;
    }
    u16* hl = p.hloc + ((size_t)dir * 8192 + t0) * 512 + blk * 64 + ch;
    u16* acp = p.acum + ((size_t)dir * 8192 + t0) * 512 + blk * 64 + ch;
    float hf = 0.f, af = 1.f;
    for (int q = 0; q < 16; ++q) {
      int pos = sub * 16 + q;
      int t = dir ? 63 - pos : pos;
      hf = sb[t * 64 + ch] + sa[t * 64 + ch] * cH;
      af = sa[t * 64 + ch] * cA;
      hl[(size_t)t * 512] = (u16)f2bf(hf);
      acp[(size_t)t * 512] = (u16)f2bf(af);
    }
    if (sub == 3) {
      p.Atot[(size_t)(cs * 2 + dir) * 512 + blk * 64 + ch] = af;
      p.Htot[(size_t)(cs * 2 + dir) * 512 + blk * 64 + ch] = hf;
    }
  }
  __syncthreads();
}

__device__ void phaseB(const Params& p, int l, char* smem) {
  const int wave = __builtin_amdgcn_readfirstlane(otid() >> 6);
  for (int it = blockIdx.x; it < 3072; it += gridDim.x) {
    if (it < 1024) attn_unit(p, l, it * 4 + wave);
    else lru_unit(p, l, it - 1024, smem);
  }
}

__device__ void phaseB2(const Params& p, int l) {
  const int tid = otid();
  float* new_state = p.out + 25165824;
  for (int u = blockIdx.x; u < 512; u += gridDim.x) {
    const int cs = u >> 2, quarter = u & 3;
    const int ch = quarter * 128 + (tid & 127), half = tid >> 7;
    int first, c, nch, b, seq_lo, seq_hi;
    const bool lat = cs >= 64;
    if (!lat) { b = cs >> 2; c = cs & 3; nch = 4; first = b * 4; seq_lo = b * 256; seq_hi = seq_lo + 256; }
    else { b = (cs - 64) >> 5; c = (cs - 64) & 31; nch = 32; first = 64 + b * 32; seq_lo = 4096 + b * 2048; seq_hi = seq_lo + 2048; }
    float cf = lat ? p.state_lru[(size_t)((b * 4 + l) * 2 + 0) * 512 + ch] : 0.f;
    float cbk = lat ? p.state_lru[(size_t)((b * 4 + l) * 2 + 1) * 512 + ch] : 0.f;
    for (int c2 = 0; c2 < c; ++c2) {
      size_t ix = (size_t)((first + c2) * 2 + 0) * 512 + ch;
      cf = p.Atot[ix] * cf + p.Htot[ix];
    }
    for (int c2 = nch - 1; c2 > c; --c2) {
      size_t ix = (size_t)((first + c2) * 2 + 1) * 512 + ch;
      cbk = p.Atot[ix] * cbk + p.Htot[ix];
    }
    if (!lat && half == 0) {
      if (c == 3) {
        size_t ix = (size_t)(cs * 2 + 0) * 512 + ch;
        new_state[(size_t)((b * 4 + l) * 2 + 0) * 512 + ch] = p.Atot[ix] * cf + p.Htot[ix];
      }
      if (c == 0) {
        size_t ix = (size_t)(cs * 2 + 1) * 512 + ch;
        new_state[(size_t)((b * 4 + l) * 2 + 1) * 512 + ch] = p.Atot[ix] * cbk + p.Htot[ix];
      }
    }
    const float cw0 = p.conv_w[(l * 3 + 0) * 512 + ch], cw1 = p.conv_w[(l * 3 + 1) * 512 + ch],
                cw2 = p.conv_w[(l * 3 + 2) * 512 + ch];
    const int tb = cs * 64 + half * 32;
    float prev = 0.f, cur = 0.f;
    if (tb - 1 >= seq_lo) {
      const u16* pr = p.P + (size_t)(tb - 1) * 8192;
      prev = bf2f(pr[3584 + ch]) * bf2f(pr[4096 + ch]);
    }
    {
      const u16* pr = p.P + (size_t)tb * 8192;
      cur = bf2f(pr[3584 + ch]) * bf2f(pr[4096 + ch]);
    }
    for (int tt = 0; tt < 32; ++tt) {
      const int t = tb + tt;
      const u16* pr = p.P + (size_t)t * 8192;
      float nxt = 0.f;
      if (t + 1 < seq_hi) {
        const u16* pn = pr + 8192;
        nxt = bf2f(pn[3584 + ch]) * bf2f(pn[4096 + ch]);
      }
      float hf = bf2f(p.hloc[(size_t)t * 512 + ch]) + bf2f(p.acum[(size_t)t * 512 + ch]) * cf;
      float hb = bf2f(p.hloc[((size_t)8192 + t) * 512 + ch]) + bf2f(p.acum[((size_t)8192 + t) * 512 + ch]) * cbk;
      float gl = bf2f(pr[2560 + ch]);
      p.Alru[(size_t)t * 512 + ch] = (u16)f2bf((hf + hb) * silu(gl));
      float conv = cw0 * prev + cw1 * cur + cw2 * nxt;
      float cbv = bf2f(pr[3072 + ch]), gc = bf2f(pr[4608 + ch]);
      p.Aconv[(size_t)t * 512 + ch] = (u16)f2bf(cbv * conv * silu(gc));
      prev = cur; cur = nxt;
    }
  }
}

__device__ void phaseC1(const Params& p, int l, char* smem) {
  const int tid = otid(), lane = tid & 63, wave = tid >> 6;
  const int wm = wave >> 1, wn = wave & 1, fr = lane & 15, fq = lane >> 4;
  for (int id = blockIdx.x; id < 512; id += gridDim.x) {
    int xcd = id & 7, j_ = id >> 3;
    int mt = xcd * 8 + (j_ >> 3), nt = j_ & 7;
    int m0 = mt * 128, n0 = nt * 128;
    f32x4 tot[4][4];
    zero_acc(tot);
#pragma unroll 1
    for (int br = 0; br < 3; ++br) {
      f32x4 acc[4][4];
      zero_acc(acc);
      const u16* A = p.Ana + (size_t)br * 8192 * 512 + (size_t)m0 * 512;
      const u16* B = p.wt_br + (size_t)(l * 3 + br) * 1024 * 512 + (size_t)n0 * 512;
      gemm_mainloop<true>(A, 512, B, 512, 512, acc, smem);
#pragma unroll
      for (int i = 0; i < 4; ++i)
#pragma unroll
        for (int j = 0; j < 4; ++j) {
          int t = m0 + wm * 64 + i * 16 + fr;
          int col = n0 + wn * 64 + j * 16 + fq * 4;
          uint2 g = *(const uint2*)(p.P + (size_t)t * 8192 + 5120 + br * 1024 + col);
          tot[i][j][0] += sigm(lo16(g.x)) * acc[i][j][0];
          tot[i][j][1] += sigm(hi16(g.x)) * acc[i][j][1];
          tot[i][j][2] += sigm(lo16(g.y)) * acc[i][j][2];
          tot[i][j][3] += sigm(hi16(g.y)) * acc[i][j][3];
        }
    }
#pragma unroll
    for (int i = 0; i < 4; ++i)
#pragma unroll
      for (int j = 0; j < 4; ++j) {
        int t = m0 + wm * 64 + i * 16 + fr;
        int col = n0 + wn * 64 + j * 16 + fq * 4;
        *(uint2*)(p.merged + (size_t)t * 1024 + col) =
            make_uint2(pack2(tot[i][j][0], tot[i][j][1]), pack2(tot[i][j][2], tot[i][j][3]));
      }
  }
}

__device__ void phaseC2(const Params& p, int l, char* smem) {
  const int tid = otid(), lane = tid & 63, wave = tid >> 6;
  const int wm = wave >> 1, wn = wave & 1, fr = lane & 15, fq = lane >> 4;
  for (int id = blockIdx.x; id < 512; id += gridDim.x) {
    int xcd = id & 7, j_ = id >> 3;
    int mt = xcd * 8 + (j_ >> 3), nt = j_ & 7;
    int m0 = mt * 128, n0 = nt * 128;
    f32x4 acc[4][4];
    zero_acc(acc);
    gemm_mainloop<true>(p.merged + (size_t)m0 * 1024, 1024, p.wt_out + (size_t)l * 1024 * 1024 + (size_t)n0 * 1024, 1024,
                        1024, acc, smem);
#pragma unroll
    for (int i = 0; i < 4; ++i)
#pragma unroll
      for (int j = 0; j < 4; ++j) {
        int t = m0 + wm * 64 + i * 16 + fr;
        int col = n0 + wn * 64 + j * 16 + fq * 4;
        int cid = t < 4096 ? 0 : 1 + ((t - 4096) >> 11);
        float4 gt = *(const float4*)(p.mod + (size_t)(l * 3 + cid) * 3072 + 2048 + col);
        float4 xo = *(const float4*)(xrow(p, l, t) + col);
        *(float4*)(p.xbuf + (size_t)t * 1024 + col) =
            make_float4(xo.x + gt.x * acc[i][j][0], xo.y + gt.y * acc[i][j][1], xo.z + gt.z * acc[i][j][2],
                        xo.w + gt.w * acc[i][j][3]);
      }
  }
}

#define XB_TMO      128
#define XB_XCNT(j)  (256  + 64 * (j))
#define XB_XSUB(j)  (1280 + 64 * (j))
#define XB_XGEN(j)  (2304 + 64 * (j))
#define XB_TOP      3328
#define XB_TOPGEN   3392
#define XCD_BAR_WORDS 3456
#define XB_SPIN_CAP (1u << 18)
#define LAS __attribute__((address_space(3)))
__device__ __forceinline__ unsigned xb_ld(unsigned* p) { return __hip_atomic_load(p, __ATOMIC_RELAXED, __HIP_MEMORY_SCOPE_AGENT); }
__device__ __forceinline__ unsigned xb_add(unsigned* p, unsigned v) { return __hip_atomic_fetch_add(p, v, __ATOMIC_RELAXED, __HIP_MEMORY_SCOPE_AGENT); }
__device__ __forceinline__ unsigned xb_xcc_id() { return (unsigned)__builtin_amdgcn_s_getreg((3 << 11) | 20) & 0xFu; }
#define XB_SPIN(cond, bar) do { unsigned _sp = 0; while (cond) { __builtin_amdgcn_s_sleep(1); \
    if ((++_sp & 255u) == 0u) { if (xb_ld(&(bar)[XB_TMO])) break; if (_sp > XB_SPIN_CAP) { atomicAdd(&(bar)[XB_TMO], 1u); break; } } } } while (0)
struct XcdBarrier { unsigned* bar; unsigned x; volatile LAS unsigned* st; };
__device__ __forceinline__ XcdBarrier xcd_barrier_post(unsigned* bar, volatile LAS unsigned* st) {
  XcdBarrier b; b.bar = bar; b.x = xb_xcc_id(); b.st = st;
  if (threadIdx.x == 0) (void)xb_add(&bar[XB_XCNT(b.x)], 1u);
  return b;
}
__device__ __forceinline__ void xcd_barrier_complete(unsigned* bar, unsigned x, unsigned& nloc, unsigned& nx) {
  const unsigned G = gridDim.x * gridDim.y * gridDim.z;
  unsigned sum, cnt, mine, sp = 0u;
  for (;;) {
    sum = 0u; cnt = 0u; mine = 0u;
#pragma unroll
    for (unsigned j = 0; j < 16; ++j) { const unsigned c = xb_ld(&bar[XB_XCNT(j)]); sum += c; cnt += (c > 0u) ? 1u : 0u; mine = (j == x) ? c : mine; }
    if (sum == G) break;
    __builtin_amdgcn_s_sleep(1);
    if ((++sp & 255u) == 0u) { if (xb_ld(&bar[XB_TMO])) break; if (sp > XB_SPIN_CAP) { atomicAdd(&bar[XB_TMO], 1u); break; } }
  }
  nloc = mine > 0u ? mine : 1u; nx = cnt > 0u ? cnt : 1u;
}
__device__ __forceinline__ void xcd_barrier(const XcdBarrier& b) {
  asm volatile("s_waitcnt vmcnt(0)" ::: "memory");
  __syncthreads();
  if (threadIdx.x == 0) {
    unsigned* bar = b.bar;
    __builtin_amdgcn_s_waitcnt(0);
    unsigned nloc = b.st[0], nx = b.st[1];
    if (nloc == 0u) { xcd_barrier_complete(bar, b.x, nloc, nx); b.st[0] = nloc; b.st[1] = nx; }
    const unsigned old = xb_add(&bar[XB_XSUB(b.x)], 1u);
    const unsigned gen = old / nloc;
    if (old + 1u == (gen + 1u) * nloc) {
      __builtin_amdgcn_fence(__ATOMIC_RELEASE, "agent");
      asm volatile("s_waitcnt vmcnt(0)" ::: "memory");
      const unsigned og = xb_add(&bar[XB_TOP], 1u);
      const unsigned tg = og / nx;
      if (og + 1u == (tg + 1u) * nx) xb_add(&bar[XB_TOPGEN], 1u);
      else XB_SPIN(xb_ld(&bar[XB_TOPGEN]) == tg, bar);
      __builtin_amdgcn_fence(__ATOMIC_ACQUIRE, "agent");
      xb_add(&bar[XB_XGEN(b.x)], 1u);
      asm volatile("s_waitcnt vmcnt(0)" ::: "memory");
    } else {
      XB_SPIN(xb_ld(&bar[XB_XGEN(b.x)]) == gen, bar);
      __builtin_amdgcn_fence(__ATOMIC_ACQUIRE, "agent");
      asm volatile("s_waitcnt vmcnt(0)" ::: "memory");
    }
  }
  __syncthreads();
}

#ifndef PROBE
#define PROBE 0
#endif
__global__ void __launch_bounds__(NTHREADS, 2) mega(Params p) {
  extern __shared__ __attribute__((aligned(16))) char dsm[];
  char* smem = dsm;
  cg::grid_group grid = cg::this_grid();
  if (threadIdx.x == 0) *(uint4*)(dsm + SMEM_BYTES) = make_uint4(0u, 0u, 0u, 0u);
  __syncthreads();
  XcdBarrier xb = xcd_barrier_post(p.bar, (volatile LAS unsigned*)(dsm + SMEM_BYTES));
  const int lo = p.phase_lo, hi = p.phase_hi;
  if (hi > 1000) grid.sync();
#define GRID_SYNC() xcd_barrier(xb)
#define RUN_PHASE(PH, CALL) { const int ph_ = (PH); if (ph_ >= lo && ph_ < hi) { CALL; if (ph_ + 1 < hi) GRID_SYNC(); } }
#define RUN_PHASE_REP(PID, PH, CALL) { RUN_PHASE(PH, CALL); if (PROBE == (PID)) { RUN_PHASE(PH, CALL); } }
  RUN_PHASE_REP(1, 0, phase0(p, smem));
#pragma unroll 1
  for (int l = 0; l < 4; ++l) {
    RUN_PHASE_REP(2, 1 + l * 6, phaseN(p, l));
    RUN_PHASE_REP(3, 2 + l * 6, phaseA(p, l, smem));
    RUN_PHASE_REP(4, 3 + l * 6, phaseB(p, l, smem));
    RUN_PHASE_REP(5, 4 + l * 6, phaseB2(p, l));
    RUN_PHASE_REP(6, 5 + l * 6, phaseC1(p, l, smem));
    RUN_PHASE(6 + l * 6, phaseC2(p, l, smem));
    if (PROBE == 7) { for (int e = 0; e < 6; ++e) GRID_SYNC(); }
  }
  RUN_PHASE(25, phaseF(p));
}

extern "C" void kernel_launch(void* const* d_in, const int* in_sizes, int n_in, void* d_out, int out_size, void* d_ws,
                              size_t ws_size, hipStream_t stream) {
  static int grid_blocks = 0;
  if (!grid_blocks) {
    int dev = 0, cus = 0, per_cu = 0;
    hipGetDevice(&dev);
    hipDeviceGetAttribute(&cus, hipDeviceAttributeMultiprocessorCount, dev);
    hipFuncSetAttribute((const void*)mega, hipFuncAttributeMaxDynamicSharedMemorySize, DYN_LDS);
    hipOccupancyMaxActiveBlocksPerMultiprocessor(&per_cu, mega, NTHREADS, DYN_LDS);
    if (per_cu > 2) per_cu = 2;
    if (per_cu < 1) per_cu = 1;
    grid_blocks = cus * per_cu;
  }
  Params p;
  memset(&p, 0, sizeof(p));
  const float** fp = (const float**)&p;
  for (int i = 0; i < 25; ++i) fp[i] = (const float*)d_in[i];
  p.out = (float*)d_out;
  char* w = (char*)d_ws;
  size_t off = 0;
  auto take = [&](size_t bytes) { char* r = w + off; off += (bytes + 255) & ~(size_t)255; return r; };
  p.wt_in = (u16*)take((size_t)4 * 8192 * 1024 * 2);
  p.wt_br = (u16*)take((size_t)4 * 3 * 1024 * 512 * 2);
  p.wt_out = (u16*)take((size_t)4 * 1024 * 1024 * 2);
  p.wgT = (u16*)take((size_t)128 * 4096 * 2);
  p.ckb = (u16*)take((size_t)2 * 4 * 256 * 512 * 2);
  p.cvT = (u16*)take((size_t)2 * 4 * 256 * 512 * 2);
  p.xm = (u16*)take((size_t)8192 * 1024 * 2);
  p.P = (u16*)take((size_t)8192 * 8192 * 2);
  p.Vt = (u16*)take((size_t)512 * 8192 * 2);
  p.Ana = (u16*)take((size_t)8192 * 512 * 2);
  p.Alru = (u16*)take((size_t)8192 * 512 * 2);
  p.Aconv = (u16*)take((size_t)8192 * 512 * 2);
  p.merged = (u16*)take((size_t)8192 * 1024 * 2);
  p.hloc = (u16*)take((size_t)2 * 8192 * 512 * 2);
  p.acum = (u16*)take((size_t)2 * 8192 * 512 * 2);
  p.mod = (float*)take((size_t)4 * 3 * 3072 * 4);
  p.xbuf = (float*)take((size_t)8192 * 1024 * 4);
  p.Atot = (float*)take((size_t)128 * 2 * 512 * 4);
  p.Htot = (float*)take((size_t)128 * 2 * 512 * 4);
  p.bar = (unsigned*)take((size_t)XCD_BAR_WORDS * 4);
  if (off > ws_size) { fprintf(stderr, "workspace too small: need %zu have %zu\n", off, ws_size); return; }
#ifdef MULTI_LAUNCH
  for (int ph = 0; ph < 26; ++ph) {
    p.phase_lo = ph; p.phase_hi = ph + 1;
    hipLaunchKernelGGL(mega, dim3(grid_blocks), dim3(NTHREADS), DYN_LDS, stream, p);
  }
#else
  p.phase_lo = 0; p.phase_hi = 26;
  hipMemsetAsync(p.bar, 0, (size_t)XCD_BAR_WORDS * 4, stream);
  void* args[] = {&p};
  hipError_t e = hipLaunchCooperativeKernel((void*)mega, dim3(grid_blocks), dim3(NTHREADS), args, DYN_LDS, stream);
  if (e != hipSuccess) fprintf(stderr, "cooperative launch failed: %s (grid %d)\n", hipGetErrorString(e), grid_blocks);
#endif
}
```

```cpp
#include <hip/hip_runtime.h>
#include <hip/hip_cooperative_groups.h>
#include <cstdio>
#include <cstring>
namespace cg = cooperative_groups;

typedef unsigned short u16;
using bf16x8 = __attribute__((ext_vector_type(8))) short;
using f32x4 = __attribute__((ext_vector_type(4))) float;
using u32x4 = __attribute__((ext_vector_type(4))) unsigned;

#define NTHREADS 256
#define SMEM_BYTES 65536
#define DYN_LDS (SMEM_BYTES + 64)

struct Params {
  const float *x_prompt, *x_sample, *cache_k, *cache_v, *state_lru, *c, *c_ctx, *norm_g, *w_mod, *b_mod,
      *w_in, *na_rpb, *lru_conv_w, *lru_conv_b, *lru_wa, *lru_ba, *lru_wx, *lru_bx, *lru_lam, *conv_w,
      *w_br_na, *w_br_lru, *w_br_conv, *w_out, *final_g;
  float* out;
  u16 *wt_in, *wt_br, *wt_out, *wgT, *ckb, *cvT, *xm, *P, *Vt, *Ana, *Alru, *Aconv, *merged, *hloc, *acum;
  float *mod, *xbuf, *Atot, *Htot;
  unsigned* bar;
  int phase_lo, phase_hi;
};

__device__ __forceinline__ int otid() { int t = threadIdx.x; asm volatile("" : "+v"(t)); return t; }
__device__ __forceinline__ unsigned f2bf(float f) {
  unsigned u = __float_as_uint(f);
  u += 0x7fffu + ((u >> 16) & 1u);
  return u >> 16;
}
__device__ __forceinline__ float bf2f(unsigned h) { return __uint_as_float(h << 16); }
__device__ __forceinline__ unsigned pack2(float a, float b) { return f2bf(a) | (f2bf(b) << 16); }
__device__ __forceinline__ float sigm(float x) { return 1.f / (1.f + __expf(-x)); }
__device__ __forceinline__ float silu(float x) { return x / (1.f + __expf(-x)); }
__device__ __forceinline__ float lo16(unsigned w) { return __uint_as_float(w << 16); }
__device__ __forceinline__ float hi16(unsigned w) { return __uint_as_float(w & 0xffff0000u); }

__device__ void transpose_unit(const float* __restrict__ src, int N, u16* __restrict__ dst, int K, int k0, int n0,
                               float* sm) {
  const int tid = otid();
#pragma unroll
  for (int i = 0; i < 4; ++i) {
    int r = (tid >> 4) + i * 16, c4 = (tid & 15) * 4;
    float4 v = *(const float4*)(src + (size_t)(k0 + r) * N + n0 + c4);
    sm[r * 65 + c4 + 0] = v.x; sm[r * 65 + c4 + 1] = v.y; sm[r * 65 + c4 + 2] = v.z; sm[r * 65 + c4 + 3] = v.w;
  }
  __syncthreads();
  const int n = tid >> 2, kq = (tid & 3) * 16;
  unsigned w[8];
#pragma unroll
  for (int kk = 0; kk < 8; ++kk) w[kk] = pack2(sm[(kq + 2 * kk) * 65 + n], sm[(kq + 2 * kk + 1) * 65 + n]);
  uint4* d = (uint4*)(dst + (size_t)(n0 + n) * K + k0 + kq);
  d[0] = make_uint4(w[0], w[1], w[2], w[3]);
  d[1] = make_uint4(w[4], w[5], w[6], w[7]);
  __syncthreads();
}

__device__ void phase0(const Params& p, char* smem) {
  float* sm = (float*)smem;
  const int tid = otid();
  const int NU = 384 + 8192 + 1536 + 1024 + 512 + 512 + 128 + 2048;
  for (int u = blockIdx.x; u < NU; u += gridDim.x) {
    int v = u;
    if (v < 384) {
      int l = v / 96, cgp = v % 96;
      int c = cgp * 32 + (tid & 31), kg = tid >> 5;
      float a0 = 0.f, a1 = 0.f, a2 = 0.f;
      const float* w = p.w_mod + (size_t)l * 1024 * 3072 + c;
      for (int k = kg * 128; k < kg * 128 + 128; ++k) {
        float wv = w[(size_t)k * 3072];
        a0 += silu(p.c_ctx[k]) * wv; a1 += silu(p.c[k]) * wv; a2 += silu(p.c[1024 + k]) * wv;
      }
      sm[(kg * 3 + 0) * 32 + (tid & 31)] = a0;
      sm[(kg * 3 + 1) * 32 + (tid & 31)] = a1;
      sm[(kg * 3 + 2) * 32 + (tid & 31)] = a2;
      __syncthreads();
      if (tid < 96) {
        int cond = tid >> 5, cc = tid & 31;
        float s = p.b_mod[l * 3072 + cgp * 32 + cc];
#pragma unroll
        for (int g = 0; g < 8; ++g) s += sm[(g * 3 + cond) * 32 + cc];
        p.mod[(size_t)(l * 3 + cond) * 3072 + cgp * 32 + cc] = s;
      }
      __syncthreads();
      continue;
    }
    v -= 384;
    if (v < 8192) {
      int l = v >> 11, r = v & 2047, kt = r >> 7, nt = r & 127;
      transpose_unit(p.w_in + (size_t)l * 1024 * 8192, 8192, p.wt_in + (size_t)l * 8192 * 1024, 1024, kt * 64, nt * 64, sm);
      continue;
    }
    v -= 8192;
    if (v < 1536) {
      int l = v / 384, r = v % 384, br = r >> 7, q = r & 127, kt = q >> 4, nt = q & 15;
      u16* dst = p.wt_br + (size_t)(l * 3 + br) * 1024 * 512;
      if (br == 0) transpose_unit(p.w_br_na + (size_t)l * 512 * 1024, 1024, dst, 512, kt * 64, nt * 64, sm);
      else if (br == 1) transpose_unit(p.w_br_lru + (size_t)l * 512 * 1024, 1024, dst, 512, kt * 64, nt * 64, sm);
      else transpose_unit(p.w_br_conv + (size_t)l * 512 * 1024, 1024, dst, 512, kt * 64, nt * 64, sm);
      continue;
    }
    v -= 1536;
    if (v < 1024) {
      int l = v >> 8, r = v & 255, kt = r >> 4, nt = r & 15;
      transpose_unit(p.w_out + (size_t)l * 1024 * 1024, 1024, p.wt_out + (size_t)l * 1024 * 1024, 1024, kt * 64, nt * 64, sm);
      continue;
    }
    v -= 1024;
    if (v < 512) {
      size_t idx = ((size_t)v * 256 + tid) * 8;
      float4 a = *(const float4*)(p.cache_k + idx), b = *(const float4*)(p.cache_k + idx + 4);
      *(uint4*)(p.ckb + idx) = make_uint4(pack2(a.x, a.y), pack2(a.z, a.w), pack2(b.x, b.y), pack2(b.z, b.w));
      continue;
    }
    v -= 512;
    if (v < 512) {
      int g = v * 256 + tid;
      int d = g & 63, h = (g >> 6) & 7, kg = (g >> 9) & 31, bl = g >> 14;
      float f[8];
#pragma unroll
      for (int j = 0; j < 8; ++j) f[j] = p.cache_v[((size_t)(bl * 256 + kg * 8 + j) * 8 + h) * 64 + d];
      *(uint4*)(p.cvT + ((size_t)(bl * 8 + h) * 64 + d) * 256 + kg * 8) =
          make_uint4(pack2(f[0], f[1]), pack2(f[2], f[3]), pack2(f[4], f[5]), pack2(f[6], f[7]));
      continue;
    }
    v -= 512;
    if (v >= 128) {
      v -= 128;
      const size_t o = ((size_t)(v & 1023) * 256 + tid) * 16;
      if (v < 1024) {
#pragma unroll
        for (int i = 0; i < 4; ++i) *(float4*)(p.xbuf + o + i * 4) = *(const float4*)(p.x_prompt + o + i * 4);
      } else {
#pragma unroll
        for (int i = 0; i < 4; ++i) *(float4*)(p.xbuf + 4194304 + o + i * 4) = *(const float4*)(p.x_sample + o + i * 4);
      }
      continue;
    }
    {
      int blk = v & 7, gate = (v >> 3) & 1, dir = (v >> 4) & 1, l = v >> 5;
      const size_t so = (size_t)((l * 2 + dir) * 8 + blk) * 4096;
      u16* dst = p.wgT + (size_t)v * 4096;
      for (int idx = tid; idx < 4096; idx += 256) {
        int k = idx >> 6, j = idx & 63;
        float wv;
        if (gate) wv = p.lru_wx[so + j * 64 + k]; else wv = p.lru_wa[so + j * 64 + k];
        dst[idx] = (u16)f2bf(wv);
      }
    }
  }
}

__device__ __forceinline__ const float* xrow(const Params& p, int l, int t) {
  return p.xbuf + (size_t)t * 1024;
}
__device__ __forceinline__ float wave_sum(float v) {
#pragma unroll
  for (int o = 32; o >= 1; o >>= 1) v += __shfl_xor(v, o);
  return v;
}

__device__ void phaseN(const Params& p, int l) {
  const int lane = otid() & 63, wave = otid() >> 6;
  const float* g = p.norm_g + l * 1024;
  for (int t = blockIdx.x * 4 + wave; t < 8192; t += gridDim.x * 4) {
    const float* x = xrow(p, l, t);
    float4 v[4];
    float ss = 0.f;
#pragma unroll
    for (int i = 0; i < 4; ++i) {
      v[i] = *(const float4*)(x + i * 256 + lane * 4);
      ss += v[i].x * v[i].x + v[i].y * v[i].y + v[i].z * v[i].z + v[i].w * v[i].w;
    }
    ss = wave_sum(ss);
    float rstd = rsqrtf(ss * (1.f / 1024.f) + 1e-6f);
    int cid = t < 4096 ? 0 : 1 + ((t - 4096) >> 11);
    const float* md = p.mod + (size_t)(l * 3 + cid) * 3072;
#pragma unroll
    for (int i = 0; i < 4; ++i) {
      int c = i * 256 + lane * 4;
      float4 gg = *(const float4*)(g + c), sh = *(const float4*)(md + c), sc = *(const float4*)(md + 1024 + c);
      float y0 = v[i].x * rstd * gg.x * (1.f + sc.x) + sh.x;
      float y1 = v[i].y * rstd * gg.y * (1.f + sc.y) + sh.y;
      float y2 = v[i].z * rstd * gg.z * (1.f + sc.z) + sh.z;
      float y3 = v[i].w * rstd * gg.w * (1.f + sc.w) + sh.w;
      *(uint2*)(p.xm + (size_t)t * 1024 + c) = make_uint2(pack2(y0, y1), pack2(y2, y3));
    }
  }
}

__device__ void phaseF(const Params& p) {
  const int lane = otid() & 63, wave = otid() >> 6;
  for (int t = blockIdx.x * 4 + wave; t < 8192; t += gridDim.x * 4) {
    const float* x = p.xbuf + (size_t)t * 1024;
    float4 v[4];
    float ss = 0.f;
#pragma unroll
    for (int i = 0; i < 4; ++i) {
      v[i] = *(const float4*)(x + i * 256 + lane * 4);
      ss += v[i].x * v[i].x + v[i].y * v[i].y + v[i].z * v[i].z + v[i].w * v[i].w;
    }
    ss = wave_sum(ss);
    float rstd = rsqrtf(ss * (1.f / 1024.f) + 1e-6f);
#pragma unroll
    for (int i = 0; i < 4; ++i) {
      int c = i * 256 + lane * 4;
      float4 gg = *(const float4*)(p.final_g + c);
      *(float4*)(p.out + (size_t)t * 1024 + c) =
          make_float4(v[i].x * rstd * gg.x, v[i].y * rstd * gg.y, v[i].z * rstd * gg.z, v[i].w * rstd * gg.w);
    }
  }
}

template <bool SWAP>
__device__ __forceinline__ void gemm_mainloop(const u16* __restrict__ A, int lda, const u16* __restrict__ B, int ldb,
                                              int K, f32x4 (&acc)[4][4], char* smem) {
  const int tid = otid(), lane = tid & 63, wave = tid >> 6;
  const int wm = wave >> 1, wn = wave & 1, fr = lane & 15, fq = lane >> 4;
  const int lr = tid >> 3, lc = (tid & 7) ^ ((lr >> 1) & 7);
  const u16* ag = A + (size_t)lr * lda + lc * 8;
  const u16* bg = B + (size_t)lr * ldb + lc * 8;
  char* sA = smem + tid * 16;
  char* sB = smem + 32768 + tid * 16;
#define GLDS(gp, lp) __builtin_amdgcn_global_load_lds((const unsigned*)(gp), (unsigned*)(lp), 16, 0, 0)
#pragma unroll
  for (int i = 0; i < 4; ++i) {
    GLDS(ag + (size_t)i * 32 * lda, sA + i * 4096);
    GLDS(bg + (size_t)i * 32 * ldb, sB + i * 4096);
  }
  asm volatile("s_waitcnt vmcnt(0)" ::: "memory");
  __syncthreads();
  const int swz_r = (fr >> 1) & 7;
  const int aoff = (wm * 64 + fr) * 128, boff = 32768 + (wn * 64 + fr) * 128;
  const int nk = K >> 6;
  for (int kt = 0; kt < nk; ++kt) {
    const int cur = kt & 1;
    if (kt + 1 < nk) {
#pragma unroll
      for (int i = 0; i < 4; ++i) {
        GLDS(ag + (size_t)i * 32 * lda + (kt + 1) * 64, sA + (cur ^ 1) * 16384 + i * 4096);
        GLDS(bg + (size_t)i * 32 * ldb + (kt + 1) * 64, sB + (cur ^ 1) * 16384 + i * 4096);
      }
    }
    const char* cA = smem + cur * 16384 + aoff;
    const char* cB = smem + cur * 16384 + boff;
#pragma unroll
    for (int ks = 0; ks < 2; ++ks) {
      bf16x8 af[4], bfr[4];
      const int ch = ((ks * 4 + fq) ^ swz_r) << 4;
#pragma unroll
      for (int i = 0; i < 4; ++i) {
        af[i] = *(const bf16x8*)(cA + i * 2048 + ch);
        bfr[i] = *(const bf16x8*)(cB + i * 2048 + ch);
      }
#pragma unroll
      for (int i = 0; i < 4; ++i)
#pragma unroll
        for (int j = 0; j < 4; ++j) {
          if (SWAP) acc[i][j] = __builtin_amdgcn_mfma_f32_16x16x32_bf16(bfr[j], af[i], acc[i][j], 0, 0, 0);
          else acc[i][j] = __builtin_amdgcn_mfma_f32_16x16x32_bf16(af[i], bfr[j], acc[i][j], 0, 0, 0);
        }
    }
    asm volatile("s_waitcnt vmcnt(0)" ::: "memory");
    __syncthreads();
  }
#undef GLDS
}

__device__ __forceinline__ void zero_acc(f32x4 (&acc)[4][4]) {
#pragma unroll
  for (int i = 0; i < 4; ++i)
#pragma unroll
    for (int j = 0; j < 4; ++j) acc[i][j] = f32x4{0.f, 0.f, 0.f, 0.f};
}

__device__ void phaseA(const Params& p, int l, char* smem) {
  const int tid = otid(), lane = tid & 63, wave = tid >> 6;
  const int wm = wave >> 1, wn = wave & 1, fr = lane & 15, fq = lane >> 4;
  const u16* W = p.wt_in + (size_t)l * 8192 * 1024;
  float* newk = p.out + 8388608;
  float* newv = p.out + 16777216;
  for (int id = blockIdx.x; id < 4096; id += gridDim.x) {
    int xcd = id & 7, j_ = id >> 3;
    int grp = xcd * 8 + (j_ >> 6), within = j_ & 63;
    int mt = (grp >> 3) * 8 + (within >> 3), nt = (grp & 7) * 8 + (within & 7);
    int m0 = mt * 128, n0 = nt * 128;
    f32x4 acc[4][4];
    zero_acc(acc);
    const u16* A = p.xm + (size_t)m0 * 1024;
    const u16* B = W + (size_t)n0 * 1024;
    if (n0 >= 1024 && n0 < 1536) {
      gemm_mainloop<false>(A, 1024, B, 1024, 1024, acc, smem);
#pragma unroll
      for (int i = 0; i < 4; ++i)
#pragma unroll
        for (int j = 0; j < 4; ++j) {
          int tok0 = m0 + wm * 64 + i * 16 + fq * 4;
          int vc = n0 + wn * 64 + j * 16 + fr - 1024;
          f32x4 v = acc[i][j];
          *(uint2*)(p.Vt + (size_t)vc * 8192 + tok0) = make_uint2(pack2(v[0], v[1]), pack2(v[2], v[3]));
          if (tok0 < 4096) {
#pragma unroll
            for (int jj = 0; jj < 4; ++jj) {
              int t = tok0 + jj;
              newv[((size_t)((t >> 8) * 4 + l) * 256 + (t & 255)) * 512 + vc] = v[jj];
            }
          }
        }
    } else {
      gemm_mainloop<true>(A, 1024, B, 1024, 1024, acc, smem);
      const bool isK = (n0 >= 512 && n0 < 1024);
#pragma unroll
      for (int i = 0; i < 4; ++i)
#pragma unroll
        for (int j = 0; j < 4; ++j) {
          int t = m0 + wm * 64 + i * 16 + fr;
          int col = n0 + wn * 64 + j * 16 + fq * 4;
          f32x4 v = acc[i][j];
          *(uint2*)(p.P + (size_t)t * 8192 + col) = make_uint2(pack2(v[0], v[1]), pack2(v[2], v[3]));
          if (isK && t < 4096)
            *(float4*)(newk + ((size_t)((t >> 8) * 4 + l) * 256 + (t & 255)) * 512 + (col - 512)) =
                make_float4(v[0], v[1], v[2], v[3]);
        }
    }
  }
}

__device__ __forceinline__ bf16x8 ld16(const u16* ptr) { return *(const bf16x8*)ptr; }

__device__ void attn_unit(const Params& p, int l, int unit) {
  const int lane = otid() & 63, fr = lane & 15, fq = lane >> 4;
  const bool lat = unit >= 2048;
  int b, h, qtok0, r = 0, n = 0, row0 = 0, band0 = 0;
  if (!lat) {
    b = unit >> 7; h = (unit >> 4) & 7;
    qtok0 = b * 256 + (unit & 15) * 16;
  } else {
    int u = unit - 2048;
    b = u >> 10; r = (u >> 5) & 31; n = (u >> 3) & 3; h = u & 7;
    qtok0 = 4096 + b * 2048 + r * 64 + n * 16;
    row0 = min(max(r - 4, 0), 24);
    band0 = min(max(16 * n - 8, 0), 32);
  }
  const u16* qp = p.P + (size_t)(qtok0 + fr) * 8192 + h * 64 + fq * 8;
  const bf16x8 q0 = ld16(qp), q1 = ld16(qp + 32);
  f32x4 o[4];
#pragma unroll
  for (int dt = 0; dt < 4; ++dt) o[dt] = f32x4{0.f, 0.f, 0.f, 0.f};
  float m = -1e30f, lsum = 0.f;
  const float* rpb = p.na_rpb + (size_t)(l * 8 + h) * 15 * 31;
  const int qc = 16 * n + fr;
  const int wst = min(max(qc - 8, 0), 48);
  const int nchunks = lat ? 8 : 4;
#pragma unroll 1
  for (int c = 0; c < nchunks; ++c) {
    const bool local = lat && c < 4;
    const u16 *kb, *vb;
    size_t kstride, kslab, vstride, vslab;
    if (!lat) {
      size_t key0 = (size_t)b * 256 + c * 64;
      kb = p.P + key0 * 8192 + 512 + h * 64; kstride = 8192; kslab = (size_t)32 * 8192;
      vb = p.Vt + (size_t)(h * 64) * 8192 + key0; vstride = 8192; vslab = 32;
    } else if (local) {
      size_t tok = 4096 + (size_t)b * 2048 + (row0 + c * 2) * 64 + band0;
      kb = p.P + tok * 8192 + 512 + h * 64; kstride = 8192; kslab = (size_t)64 * 8192;
      vb = p.Vt + (size_t)(h * 64) * 8192 + tok; vstride = 8192; vslab = 64;
    } else {
      int cc = c - 4;
      kb = p.ckb + ((size_t)(b * 4 + l) * 256 + cc * 64) * 512 + h * 64; kstride = 512; kslab = (size_t)32 * 512;
      vb = p.cvT + (size_t)((b * 4 + l) * 8 + h) * 64 * 256 + cc * 64; vstride = 256; vslab = 32;
    }
    f32x4 s[4];
#pragma unroll
    for (int mt = 0; mt < 4; ++mt) {
      const u16* kp = kb + (mt >> 1) * kslab + (size_t)((mt & 1) * 16 + fr) * kstride + fq * 8;
      bf16x8 a0 = ld16(kp), a1 = ld16(kp + 32);
      f32x4 z = f32x4{0.f, 0.f, 0.f, 0.f};
      z = __builtin_amdgcn_mfma_f32_16x16x32_bf16(a0, q0, z, 0, 0, 0);
      s[mt] = __builtin_amdgcn_mfma_f32_16x16x32_bf16(a1, q1, z, 0, 0, 0);
    }
    float cmax = -1e30f;
#pragma unroll
    for (int mt = 0; mt < 4; ++mt) {
      const int row_off = row0 + c * 2 + (mt >> 1) - r + 7;
#pragma unroll
      for (int jj = 0; jj < 4; ++jj) {
        float v = s[mt][jj] * 0.125f;
        if (local) {
          int kc = band0 + (mt & 1) * 16 + fq * 4 + jj;
          bool valid = (kc >= wst) && (kc < wst + 16);
          int col_off = min(max(kc - qc, -15), 15) + 15;
          float bias = rpb[row_off * 31 + col_off];
          v = valid ? v + bias : -1e30f;
        }
        s[mt][jj] = v;
        cmax = fmaxf(cmax, v);
      }
    }
    cmax = fmaxf(cmax, __shfl_xor(cmax, 16));
    cmax = fmaxf(cmax, __shfl_xor(cmax, 32));
    const float mnew = fmaxf(m, cmax);
    const float alpha = __expf(m - mnew);
    m = mnew;
    lsum *= alpha;
#pragma unroll
    for (int dt = 0; dt < 4; ++dt) o[dt] *= alpha;
#pragma unroll
    for (int mt = 0; mt < 4; ++mt)
#pragma unroll
      for (int jj = 0; jj < 4; ++jj) {
        float pv = __expf(s[mt][jj] - m);
        lsum += pv;
        s[mt][jj] = pv;
      }
#pragma unroll
    for (int sl = 0; sl < 2; ++sl) {
      u32x4 pw = {pack2(s[2 * sl][0], s[2 * sl][1]), pack2(s[2 * sl][2], s[2 * sl][3]),
                  pack2(s[2 * sl + 1][0], s[2 * sl + 1][1]), pack2(s[2 * sl + 1][2], s[2 * sl + 1][3])};
      bf16x8 pb = __builtin_bit_cast(bf16x8, pw);
#pragma unroll
      for (int dt = 0; dt < 4; ++dt) {
        const u16* vp = vb + sl * vslab + (size_t)(dt * 16 + fr) * vstride + fq * 4;
        uint2 v0 = *(const uint2*)vp, v1 = *(const uint2*)(vp + 16);
        u32x4 vw = {v0.x, v0.y, v1.x, v1.y};
        o[dt] = __builtin_amdgcn_mfma_f32_16x16x32_bf16(__builtin_bit_cast(bf16x8, vw), pb, o[dt], 0, 0, 0);
      }
    }
  }
  lsum += __shfl_xor(lsum, 16);
  lsum += __shfl_xor(lsum, 32);
  const float inv = 1.f / lsum;
  const size_t t = qtok0 + fr;
#pragma unroll
  for (int dt = 0; dt < 4; ++dt) {
    int d0 = h * 64 + dt * 16 + fq * 4;
    uint2 g = *(const uint2*)(p.P + t * 8192 + 1536 + d0);
    float y0 = o[dt][0] * inv * silu(lo16(g.x)), y1 = o[dt][1] * inv * silu(hi16(g.x));
    float y2 = o[dt][2] * inv * silu(lo16(g.y)), y3 = o[dt][3] * inv * silu(hi16(g.y));
    *(uint2*)(p.Ana + t * 512 + d0) = make_uint2(pack2(y0, y1), pack2(y2, y3));
  }
}

__device__ void lru_unit(const Params& p, int l, int unit, char* smem) {
  const int tid = otid(), lane = tid & 63, wave = tid >> 6, fr = lane & 15, fq = lane >> 4;
  const int blk = unit & 7, dir = (unit >> 3) & 1, cs = unit >> 4;
  const int t0 = cs * 64;
  int seq_lo, seq_hi;
  if (cs < 64) { seq_lo = (cs >> 2) * 256; seq_hi = seq_lo + 256; }
  else { seq_lo = 4096 + ((cs - 64) >> 5) * 2048; seq_hi = seq_lo + 2048; }
  u16* uraw = (u16*)smem;
  u16* udb = (u16*)(smem + 8704);
  float* sa = (float*)(smem + 8704 + 9216);
  float* sb = sa + 4096;
  float* stot = sb + 4096;
  const int wbase = dir ? t0 : t0 - 3;
#pragma unroll
  for (int i = 0; i < 3; ++i) {
    int row = (tid >> 3) + i * 32, ch8 = tid & 7;
    if (row < 67) {
      int t = wbase + row;
      uint4 v = make_uint4(0, 0, 0, 0);
      if (t >= seq_lo && t < seq_hi) v = *(const uint4*)(p.P + (size_t)t * 8192 + 2048 + blk * 64 + ch8 * 8);
      *(uint4*)(uraw + row * 64 + ch8 * 8) = v;
    }
  }
  __syncthreads();
  {
    const int ch = tid & 63, tg = tid >> 6;
    const int cw = blk * 64 + ch;
    const float* cwp = p.lru_conv_w + (size_t)((l * 2 + dir) * 4) * 512 + cw;
    const float w0 = cwp[0], w1 = cwp[512], w2 = cwp[1024], w3 = cwp[1536];
    const float cb = p.lru_conv_b[(l * 2 + dir) * 512 + cw];
    for (int t = tg * 16; t < tg * 16 + 16; ++t) {
      float ud = cb + w0 * bf2f(uraw[t * 64 + ch]) + w1 * bf2f(uraw[(t + 1) * 64 + ch]) +
                 w2 * bf2f(uraw[(t + 2) * 64 + ch]) + w3 * bf2f(uraw[(t + 3) * 64 + ch]);
      sb[t * 64 + ch] = ud;
      udb[t * 72 + ch] = (u16)f2bf(ud);
    }
  }
  __syncthreads();
  {
    f32x4 ar[4], ai[4];
#pragma unroll
    for (int nt = 0; nt < 4; ++nt) { ar[nt] = f32x4{0.f, 0.f, 0.f, 0.f}; ai[nt] = f32x4{0.f, 0.f, 0.f, 0.f}; }
    const u16* wr = p.wgT + (size_t)(((l * 2 + dir) * 2 + 0) * 8 + blk) * 4096;
    const u16* wi = p.wgT + (size_t)(((l * 2 + dir) * 2 + 1) * 8 + blk) * 4096;
#pragma unroll
    for (int ks = 0; ks < 2; ++ks) {
      bf16x8 af = *(const bf16x8*)(udb + (wave * 16 + fr) * 72 + ks * 32 + fq * 8);
#pragma unroll
      for (int nt = 0; nt < 4; ++nt) {
        bf16x8 br = ld16(wr + (nt * 16 + fr) * 64 + ks * 32 + fq * 8);
        bf16x8 bi = ld16(wi + (nt * 16 + fr) * 64 + ks * 32 + fq * 8);
        ar[nt] = __builtin_amdgcn_mfma_f32_16x16x32_bf16(af, br, ar[nt], 0, 0, 0);
        ai[nt] = __builtin_amdgcn_mfma_f32_16x16x32_bf16(af, bi, ai[nt], 0, 0, 0);
      }
    }
#pragma unroll
    for (int nt = 0; nt < 4; ++nt) {
      const int k = nt * 16 + fr, cw = blk * 64 + k;
      const int pi = (l * 2 + dir) * 512 + cw;
      const float ba = p.lru_ba[pi], bx = p.lru_bx[pi], lam = p.lru_lam[pi];
      const float sp = log1pf(__expf(-lam));
#pragma unroll
      for (int jj = 0; jj < 4; ++jj) {
        const int t = wave * 16 + fq * 4 + jj;
        float rg = sigm(ar[nt][jj] + ba), ig = sigm(ai[nt][jj] + bx);
        float la = -8.f * rg * sp;
        float a = __expf(la);
        float ud = sb[t * 64 + k];
        float bb = sqrtf(-expm1f(2.f * la)) * (ig * ud);
        sa[t * 64 + k] = a;
        sb[t * 64 + k] = bb;
      }
    }
  }
  __syncthreads();
  {
    const int ch = tid & 63, sub = tid >> 6;
    float h = 0.f, ac = 1.f;
    for (int q = 0; q < 16; ++q) {
      int pos = sub * 16 + q;
      int t = dir ? 63 - pos : pos;
      float a = sa[t * 64 + ch], bb = sb[t * 64 + ch];
      h = a * h + bb;
      ac *= a;
      sa[t * 64 + ch] = ac;
      sb[t * 64 + ch] = h;
    }
    stot[(sub * 64 + ch) * 2] = ac;
    stot[(sub * 64 + ch) * 2 + 1] = h;
    __syncthreads();
    float cA = 1.f, cH = 0.f;
    for (int s2 = 0; s2 < sub; ++s2) {
      float A2 = stot[(s2 * 64 + ch) * 2], H2 = stot[(s2 * 64 + ch) * 2 + 1];
      cH = A2 * cH + H2;
      cA *= A2;
    }
    u16* hl = p.hloc + ((size_t)dir * 8192 + t0) * 512 + blk * 64 + ch;
    u16* acp = p.acum + ((size_t)dir * 8192 + t0) * 512 + blk * 64 + ch;
    float hf = 0.f, af = 1.f;
    for (int q = 0; q < 16; ++q) {
      int pos = sub * 16 + q;
      int t = dir ? 63 - pos : pos;
      hf = sb[t * 64 + ch] + sa[t * 64 + ch] * cH;
      af = sa[t * 64 + ch] * cA;
      hl[(size_t)t * 512] = (u16)f2bf(hf);
      acp[(size_t)t * 512] = (u16)f2bf(af);
    }
    if (sub == 3) {
      p.Atot[(size_t)(cs * 2 + dir) * 512 + blk * 64 + ch] = af;
      p.Htot[(size_t)(cs * 2 + dir) * 512 + blk * 64 + ch] = hf;
    }
  }
  __syncthreads();
}

__device__ void phaseB(const Params& p, int l, char* smem) {
  const int wave = __builtin_amdgcn_readfirstlane(otid() >> 6);
  for (int it = blockIdx.x; it < 3072; it += gridDim.x) {
    if (it < 1024) attn_unit(p, l, it * 4 + wave);
    else lru_unit(p, l, it - 1024, smem);
  }
}

__device__ void phaseB2(const Params& p, int l) {
  const int tid = otid();
  float* new_state = p.out + 25165824;
  for (int u = blockIdx.x; u < 512; u += gridDim.x) {
    const int cs = u >> 2, quarter = u & 3;
    const int ch = quarter * 128 + (tid & 127), half = tid >> 7;
    int first, c, nch, b, seq_lo, seq_hi;
    const bool lat = cs >= 64;
    if (!lat) { b = cs >> 2; c = cs & 3; nch = 4; first = b * 4; seq_lo = b * 256; seq_hi = seq_lo + 256; }
    else { b = (cs - 64) >> 5; c = (cs - 64) & 31; nch = 32; first = 64 + b * 32; seq_lo = 4096 + b * 2048; seq_hi = seq_lo + 2048; }
    float cf = lat ? p.state_lru[(size_t)((b * 4 + l) * 2 + 0) * 512 + ch] : 0.f;
    float cbk = lat ? p.state_lru[(size_t)((b * 4 + l) * 2 + 1) * 512 + ch] : 0.f;
    for (int c2 = 0; c2 < c; ++c2) {
      size_t ix = (size_t)((first + c2) * 2 + 0) * 512 + ch;
      cf = p.Atot[ix] * cf + p.Htot[ix];
    }
    for (int c2 = nch - 1; c2 > c; --c2) {
      size_t ix = (size_t)((first + c2) * 2 + 1) * 512 + ch;
      cbk = p.Atot[ix] * cbk + p.Htot[ix];
    }
    if (!lat && half == 0) {
      if (c == 3) {
        size_t ix = (size_t)(cs * 2 + 0) * 512 + ch;
        new_state[(size_t)((b * 4 + l) * 2 + 0) * 512 + ch] = p.Atot[ix] * cf + p.Htot[ix];
      }
      if (c == 0) {
        size_t ix = (size_t)(cs * 2 + 1) * 512 + ch;
        new_state[(size_t)((b * 4 + l) * 2 + 1) * 512 + ch] = p.Atot[ix] * cbk + p.Htot[ix];
      }
    }
    const float cw0 = p.conv_w[(l * 3 + 0) * 512 + ch], cw1 = p.conv_w[(l * 3 + 1) * 512 + ch],
                cw2 = p.conv_w[(l * 3 + 2) * 512 + ch];
    const int tb = cs * 64 + half * 32;
    float prev = 0.f, cur = 0.f;
    if (tb - 1 >= seq_lo) {
      const u16* pr = p.P + (size_t)(tb - 1) * 8192;
      prev = bf2f(pr[3584 + ch]) * bf2f(pr[4096 + ch]);
    }
    {
      const u16* pr = p.P + (size_t)tb * 8192;
      cur = bf2f(pr[3584 + ch]) * bf2f(pr[4096 + ch]);
    }
    for (int tt = 0; tt < 32; ++tt) {
      const int t = tb + tt;
      const u16* pr = p.P + (size_t)t * 8192;
      float nxt = 0.f;
      if (t + 1 < seq_hi) {
        const u16* pn = pr + 8192;
        nxt = bf2f(pn[3584 + ch]) * bf2f(pn[4096 + ch]);
      }
      float hf = bf2f(p.hloc[(size_t)t * 512 + ch]) + bf2f(p.acum[(size_t)t * 512 + ch]) * cf;
      float hb = bf2f(p.hloc[((size_t)8192 + t) * 512 + ch]) + bf2f(p.acum[((size_t)8192 + t) * 512 + ch]) * cbk;
      float gl = bf2f(pr[2560 + ch]);
      p.Alru[(size_t)t * 512 + ch] = (u16)f2bf((hf + hb) * silu(gl));
      float conv = cw0 * prev + cw1 * cur + cw2 * nxt;
      float cbv = bf2f(pr[3072 + ch]), gc = bf2f(pr[4608 + ch]);
      p.Aconv[(size_t)t * 512 + ch] = (u16)f2bf(cbv * conv * silu(gc));
      prev = cur; cur = nxt;
    }
  }
}

__device__ void phaseC1(const Params& p, int l, char* smem) {
  const int tid = otid(), lane = tid & 63, wave = tid >> 6;
  const int wm = wave >> 1, wn = wave & 1, fr = lane & 15, fq = lane >> 4;
  for (int id = blockIdx.x; id < 512; id += gridDim.x) {
    int xcd = id & 7, j_ = id >> 3;
    int mt = xcd * 8 + (j_ >> 3), nt = j_ & 7;
    int m0 = mt * 128, n0 = nt * 128;
    f32x4 tot[4][4];
    zero_acc(tot);
#pragma unroll 1
    for (int br = 0; br < 3; ++br) {
      f32x4 acc[4][4];
      zero_acc(acc);
      const u16* A = p.Ana + (size_t)br * 8192 * 512 + (size_t)m0 * 512;
      const u16* B = p.wt_br + (size_t)(l * 3 + br) * 1024 * 512 + (size_t)n0 * 512;
      gemm_mainloop<true>(A, 512, B, 512, 512, acc, smem);
#pragma unroll
      for (int i = 0; i < 4; ++i)
#pragma unroll
        for (int j = 0; j < 4; ++j) {
          int t = m0 + wm * 64 + i * 16 + fr;
          int col = n0 + wn * 64 + j * 16 + fq * 4;
          uint2 g = *(const uint2*)(p.P + (size_t)t * 8192 + 5120 + br * 1024 + col);
          tot[i][j][0] += sigm(lo16(g.x)) * acc[i][j][0];
          tot[i][j][1] += sigm(hi16(g.x)) * acc[i][j][1];
          tot[i][j][2] += sigm(lo16(g.y)) * acc[i][j][2];
          tot[i][j][3] += sigm(hi16(g.y)) * acc[i][j][3];
        }
    }
#pragma unroll
    for (int i = 0; i < 4; ++i)
#pragma unroll
      for (int j = 0; j < 4; ++j) {
        int t = m0 + wm * 64 + i * 16 + fr;
        int col = n0 + wn * 64 + j * 16 + fq * 4;
        *(uint2*)(p.merged + (size_t)t * 1024 + col) =
            make_uint2(pack2(tot[i][j][0], tot[i][j][1]), pack2(tot[i][j][2], tot[i][j][3]));
      }
  }
}

__device__ void phaseC2(const Params& p, int l, char* smem) {
  const int tid = otid(), lane = tid & 63, wave = tid >> 6;
  const int wm = wave >> 1, wn = wave & 1, fr = lane & 15, fq = lane >> 4;
  for (int id = blockIdx.x; id < 512; id += gridDim.x) {
    int xcd = id & 7, j_ = id >> 3;
    int mt = xcd * 8 + (j_ >> 3), nt = j_ & 7;
    int m0 = mt * 128, n0 = nt * 128;
    f32x4 acc[4][4];
    zero_acc(acc);
    gemm_mainloop<true>(p.merged + (size_t)m0 * 1024, 1024, p.wt_out + (size_t)l * 1024 * 1024 + (size_t)n0 * 1024, 1024,
                        1024, acc, smem);
#pragma unroll
    for (int i = 0; i < 4; ++i)
#pragma unroll
      for (int j = 0; j < 4; ++j) {
        int t = m0 + wm * 64 + i * 16 + fr;
        int col = n0 + wn * 64 + j * 16 + fq * 4;
        int cid = t < 4096 ? 0 : 1 + ((t - 4096) >> 11);
        float4 gt = *(const float4*)(p.mod + (size_t)(l * 3 + cid) * 3072 + 2048 + col);
        float4 xo = *(const float4*)(xrow(p, l, t) + col);
        *(float4*)(p.xbuf + (size_t)t * 1024 + col) =
            make_float4(xo.x + gt.x * acc[i][j][0], xo.y + gt.y * acc[i][j][1], xo.z + gt.z * acc[i][j][2],
                        xo.w + gt.w * acc[i][j][3]);
      }
  }
}

#define XB_TMO      128
#define XB_XCNT(j)  (256  + 64 * (j))
#define XB_XSUB(j)  (1280 + 64 * (j))
#define XB_XGEN(j)  (2304 + 64 * (j))
#define XB_TOP      3328
#define XB_TOPGEN   3392
#define XCD_BAR_WORDS 3456
#define XB_SPIN_CAP (1u << 18)
#define LAS __attribute__((address_space(3)))
__device__ __forceinline__ unsigned xb_ld(unsigned* p) { return __hip_atomic_load(p, __ATOMIC_RELAXED, __HIP_MEMORY_SCOPE_AGENT); }
__device__ __forceinline__ unsigned xb_add(unsigned* p, unsigned v) { return __hip_atomic_fetch_add(p, v, __ATOMIC_RELAXED, __HIP_MEMORY_SCOPE_AGENT); }
__device__ __forceinline__ unsigned xb_xcc_id() { return (unsigned)__builtin_amdgcn_s_getreg((3 << 11) | 20) & 0xFu; }
#define XB_SPIN(cond, bar) do { unsigned _sp = 0; while (cond) { __builtin_amdgcn_s_sleep(1); \
    if ((++_sp & 255u) == 0u) { if (xb_ld(&(bar)[XB_TMO])) break; if (_sp > XB_SPIN_CAP) { atomicAdd(&(bar)[XB_TMO], 1u); break; } } } } while (0)
struct XcdBarrier { unsigned* bar; unsigned x; volatile LAS unsigned* st; };
__device__ __forceinline__ XcdBarrier xcd_barrier_post(unsigned* bar, volatile LAS unsigned* st) {
  XcdBarrier b; b.bar = bar; b.x = xb_xcc_id(); b.st = st;
  if (threadIdx.x == 0) (void)xb_add(&bar[XB_XCNT(b.x)], 1u);
  return b;
}
__device__ __forceinline__ void xcd_barrier_complete(unsigned* bar, unsigned x, unsigned& nloc, unsigned& nx) {
  const unsigned G = gridDim.x * gridDim.y * gridDim.z;
  unsigned sum, cnt, mine, sp = 0u;
  for (;;) {
    sum = 0u; cnt = 0u; mine = 0u;
#pragma unroll
    for (unsigned j = 0; j < 16; ++j) { const unsigned c = xb_ld(&bar[XB_XCNT(j)]); sum += c; cnt += (c > 0u) ? 1u : 0u; mine = (j == x) ? c : mine; }
    if (sum == G) break;
    __builtin_amdgcn_s_sleep(1);
    if ((++sp & 255u) == 0u) { if (xb_ld(&bar[XB_TMO])) break; if (sp > XB_SPIN_CAP) { atomicAdd(&bar[XB_TMO], 1u); break; } }
  }
  nloc = mine > 0u ? mine : 1u; nx = cnt > 0u ? cnt : 1u;
}
__device__ __forceinline__ void xcd_barrier(const XcdBarrier& b) {
  asm volatile("s_waitcnt vmcnt(0)" ::: "memory");
  __syncthreads();
  if (threadIdx.x == 0) {
    unsigned* bar = b.bar;
    __builtin_amdgcn_s_waitcnt(0);
    unsigned nloc = b.st[0], nx = b.st[1];
    if (nloc == 0u) { xcd_barrier_complete(bar, b.x, nloc, nx); b.st[0] = nloc; b.st[1] = nx; }
    const unsigned old = xb_add(&bar[XB_XSUB(b.x)], 1u);
    const unsigned gen = old / nloc;
    if (old + 1u == (gen + 1u) * nloc) {
      __builtin_amdgcn_fence(__ATOMIC_RELEASE, "agent");
      asm volatile("s_waitcnt vmcnt(0)" ::: "memory");
      const unsigned og = xb_add(&bar[XB_TOP], 1u);
      const unsigned tg = og / nx;
      if (og + 1u == (tg + 1u) * nx) xb_add(&bar[XB_TOPGEN], 1u);
      else XB_SPIN(xb_ld(&bar[XB_TOPGEN]) == tg, bar);
      __builtin_amdgcn_fence(__ATOMIC_ACQUIRE, "agent");
      xb_add(&bar[XB_XGEN(b.x)], 1u);
      asm volatile("s_waitcnt vmcnt(0)" ::: "memory");
    } else {
      XB_SPIN(xb_ld(&bar[XB_XGEN(b.x)]) == gen, bar);
      __builtin_amdgcn_fence(__ATOMIC_ACQUIRE, "agent");
      asm volatile("s_waitcnt vmcnt(0)" ::: "memory");
    }
  }
  __syncthreads();
}

#ifndef PROBE
#define PROBE 0
#endif
__global__ void __launch_bounds__(NTHREADS, 2) mega(Params p) {
  extern __shared__ __attribute__((aligned(16))) char dsm[];
  char* smem = dsm;
  cg::grid_group grid = cg::this_grid();
  if (threadIdx.x == 0) *(uint4*)(dsm + SMEM_BYTES) = make_uint4(0u, 0u, 0u, 0u);
  __syncthreads();
  XcdBarrier xb = xcd_barrier_post(p.bar, (volatile LAS unsigned*)(dsm + SMEM_BYTES));
  const int lo = p.phase_lo, hi = p.phase_hi;
  if (hi > 1000) grid.sync();
#define GRID_SYNC() xcd_barrier(xb)
#define RUN_PHASE(PH, CALL) { const int ph_ = (PH); if (ph_ >= lo && ph_ < hi) { CALL; if (ph_ + 1 < hi) GRID_SYNC(); } }
#define RUN_PHASE_REP(PID, PH, CALL) { RUN_PHASE(PH, CALL); if (PROBE == (PID)) { RUN_PHASE(PH, CALL); } }
  RUN_PHASE_REP(1, 0, phase0(p, smem));
#pragma unroll 1
  for (int l = 0; l < 4; ++l) {
    RUN_PHASE_REP(2, 1 + l * 6, phaseN(p, l));
    RUN_PHASE_REP(3, 2 + l * 6, phaseA(p, l, smem));
    RUN_PHASE_REP(4, 3 + l * 6, phaseB(p, l, smem));
    RUN_PHASE_REP(5, 4 + l * 6, phaseB2(p, l));
    RUN_PHASE_REP(6, 5 + l * 6, phaseC1(p, l, smem));
    RUN_PHASE(6 + l * 6, phaseC2(p, l, smem));
    if (PROBE == 7) { for (int e = 0; e < 6; ++e) GRID_SYNC(); }
  }
  RUN_PHASE(25, phaseF(p));
}

extern "C" void kernel_launch(void* const* d_in, const int* in_sizes, int n_in, void* d_out, int out_size, void* d_ws,
                              size_t ws_size, hipStream_t stream) {
  static int grid_blocks = 0;
  if (!grid_blocks) {
    int dev = 0, cus = 0, per_cu = 0;
    hipGetDevice(&dev);
    hipDeviceGetAttribute(&cus, hipDeviceAttributeMultiprocessorCount, dev);
    hipFuncSetAttribute((const void*)mega, hipFuncAttributeMaxDynamicSharedMemorySize, DYN_LDS);
    hipOccupancyMaxActiveBlocksPerMultiprocessor(&per_cu, mega, NTHREADS, DYN_LDS);
    if (per_cu > 2) per_cu = 2;
    if (per_cu < 1) per_cu = 1;
    grid_blocks = cus * per_cu;
  }
  Params p;
  memset(&p, 0, sizeof(p));
  const float** fp = (const float**)&p;
  for (int i = 0; i < 25; ++i) fp[i] = (const float*)d_in[i];
  p.out = (float*)d_out;
  char* w = (char*)d_ws;
  size_t off = 0;
  auto take = [&](size_t bytes) { char* r = w + off; off += (bytes + 255) & ~(size_t)255; return r; };
  p.wt_in = (u16*)take((size_t)4 * 8192 * 1024 * 2);
  p.wt_br = (u16*)take((size_t)4 * 3 * 1024 * 512 * 2);
  p.wt_out = (u16*)take((size_t)4 * 1024 * 1024 * 2);
  p.wgT = (u16*)take((size_t)128 * 4096 * 2);
  p.ckb = (u16*)take((size_t)2 * 4 * 256 * 512 * 2);
  p.cvT = (u16*)take((size_t)2 * 4 * 256 * 512 * 2);
  p.xm = (u16*)take((size_t)8192 * 1024 * 2);
  p.P = (u16*)take((size_t)8192 * 8192 * 2);
  p.Vt = (u16*)take((size_t)512 * 8192 * 2);
  p.Ana = (u16*)take((size_t)8192 * 512 * 2);
  p.Alru = (u16*)take((size_t)8192 * 512 * 2);
  p.Aconv = (u16*)take((size_t)8192 * 512 * 2);
  p.merged = (u16*)take((size_t)8192 * 1024 * 2);
  p.hloc = (u16*)take((size_t)2 * 8192 * 512 * 2);
  p.acum = (u16*)take((size_t)2 * 8192 * 512 * 2);
  p.mod = (float*)take((size_t)4 * 3 * 3072 * 4);
  p.xbuf = (float*)take((size_t)8192 * 1024 * 4);
  p.Atot = (float*)take((size_t)128 * 2 * 512 * 4);
  p.Htot = (float*)take((size_t)128 * 2 * 512 * 4);
  p.bar = (unsigned*)take((size_t)XCD_BAR_WORDS * 4);
  if (off > ws_size) { fprintf(stderr, "workspace too small: need %zu have %zu\n", off, ws_size); return; }
#ifdef MULTI_LAUNCH
  for (int ph = 0; ph < 26; ++ph) {
    p.phase_lo = ph; p.phase_hi = ph + 1;
    hipLaunchKernelGGL(mega, dim3(grid_blocks), dim3(NTHREADS), DYN_LDS, stream, p);
  }
#else
  p.phase_lo = 0; p.phase_hi = 26;
  hipMemsetAsync(p.bar, 0, (size_t)XCD_BAR_WORDS * 4, stream);
  void* args[] = {&p};
  hipError_t e = hipLaunchCooperativeKernel((void*)mega, dim3(grid_blocks), dim3(NTHREADS), args, DYN_LDS, stream);
  if (e != hipSuccess) fprintf(stderr, "cooperative launch failed: %s (grid %d)\n", hipGetErrorString(e), grid_blocks);
#endif
}
```

```cpp
#include <hip/hip_runtime.h>
#include <hip/hip_cooperative_groups.h>
#include <cstdio>
#include <cstring>
namespace cg = cooperative_groups;

typedef unsigned short u16;
using bf16x8 = __attribute__((ext_vector_type(8))) short;
using f32x4 = __attribute__((ext_vector_type(4))) float;
using u32x4 = __attribute__((ext_vector_type(4))) unsigned;

#define NTHREADS 512
#define SMEM_BYTES 131072
#define DYN_LDS (SMEM_BYTES + 64)

struct Params {
  const float *x_prompt, *x_sample, *cache_k, *cache_v, *state_lru, *c, *c_ctx, *norm_g, *w_mod, *b_mod,
      *w_in, *na_rpb, *lru_conv_w, *lru_conv_b, *lru_wa, *lru_ba, *lru_wx, *lru_bx, *lru_lam, *conv_w,
      *w_br_na, *w_br_lru, *w_br_conv, *w_out, *final_g;
  float* out;
  u16 *wt_in, *wt_br, *wt_out, *wgT, *ckb, *cvT, *xm, *P, *Vt, *Ana, *Alru, *Aconv, *merged, *hloc, *acum;
  float *mod, *xbuf, *Atot, *Htot, *sp8;
  unsigned* bar;
  int phase_lo, phase_hi;
};

__device__ __forceinline__ int otid() { int t = threadIdx.x & 255; asm volatile("" : "+v"(t)); return t; }
__device__ __forceinline__ int otid512() { int t = threadIdx.x; asm volatile("" : "+v"(t)); return t; }
__device__ __forceinline__ int vbid() { return blockIdx.x * 2 + __builtin_amdgcn_readfirstlane((int)(threadIdx.x >> 8)); }
#define NVB ((int)gridDim.x * 2)
__device__ __forceinline__ unsigned f2bf(float f) {
  unsigned u = __float_as_uint(f);
  u += 0x7fffu + ((u >> 16) & 1u);
  return u >> 16;
}
__device__ __forceinline__ float bf2f(unsigned h) { return __uint_as_float(h << 16); }
__device__ __forceinline__ unsigned pack2(float a, float b) { return f2bf(a) | (f2bf(b) << 16); }
__device__ __forceinline__ float sigm(float x) { return __builtin_amdgcn_rcpf(1.f + __expf(-x)); }
__device__ __forceinline__ float silu(float x) { return x * __builtin_amdgcn_rcpf(1.f + __expf(-x)); }
__device__ __forceinline__ float lo16(unsigned w) { return __uint_as_float(w << 16); }
__device__ __forceinline__ float hi16(unsigned w) { return __uint_as_float(w & 0xffff0000u); }

__device__ void transpose_unit(const float* __restrict__ src, int N, u16* __restrict__ dst, int K, int k0, int n0,
                               float* sm) {
  const int tid = otid();
#pragma unroll
  for (int i = 0; i < 4; ++i) {
    int r = (tid >> 4) + i * 16, c4 = (tid & 15) * 4;
    float4 v = *(const float4*)(src + (size_t)(k0 + r) * N + n0 + c4);
    sm[r * 65 + c4 + 0] = v.x; sm[r * 65 + c4 + 1] = v.y; sm[r * 65 + c4 + 2] = v.z; sm[r * 65 + c4 + 3] = v.w;
  }
  __syncthreads();
  const int n = tid >> 2, kq = (tid & 3) * 16;
  unsigned w[8];
#pragma unroll
  for (int kk = 0; kk < 8; ++kk) w[kk] = pack2(sm[(kq + 2 * kk) * 65 + n], sm[(kq + 2 * kk + 1) * 65 + n]);
  uint4* d = (uint4*)(dst + (size_t)(n0 + n) * K + k0 + kq);
  d[0] = make_uint4(w[0], w[1], w[2], w[3]);
  d[1] = make_uint4(w[4], w[5], w[6], w[7]);
  __syncthreads();
}

__device__ void phase0(const Params& p, char* smem) {
  float* sm = (float*)smem;
  const int tid = otid();
  const int NU = 384 + 8192 + 1536 + 1024 + 512 + 512 + 128 + 2048;
  for (int u = vbid(); u < NU; u += NVB) {
    int v = u;
    if (v < 384) {
      int l = v / 96, cgp = v % 96;
      int c = cgp * 32 + (tid & 31), kg = tid >> 5;
      float a0 = 0.f, a1 = 0.f, a2 = 0.f;
      const float* w = p.w_mod + (size_t)l * 1024 * 3072 + c;
      for (int k = kg * 128; k < kg * 128 + 128; ++k) {
        float wv = w[(size_t)k * 3072];
        a0 += silu(p.c_ctx[k]) * wv; a1 += silu(p.c[k]) * wv; a2 += silu(p.c[1024 + k]) * wv;
      }
      sm[(kg * 3 + 0) * 32 + (tid & 31)] = a0;
      sm[(kg * 3 + 1) * 32 + (tid & 31)] = a1;
      sm[(kg * 3 + 2) * 32 + (tid & 31)] = a2;
      __syncthreads();
      if (tid < 96) {
        int cond = tid >> 5, cc = tid & 31;
        float s = p.b_mod[l * 3072 + cgp * 32 + cc];
#pragma unroll
        for (int g = 0; g < 8; ++g) s += sm[(g * 3 + cond) * 32 + cc];
        p.mod[(size_t)(l * 3 + cond) * 3072 + cgp * 32 + cc] = s;
      }
      __syncthreads();
      continue;
    }
    v -= 384;
    if (v < 8192) {
      int l = v >> 11, r = v & 2047, kt = r >> 7, nt = r & 127;
      transpose_unit(p.w_in + (size_t)l * 1024 * 8192, 8192, p.wt_in + (size_t)l * 8192 * 1024, 1024, kt * 64, nt * 64, sm);
      continue;
    }
    v -= 8192;
    if (v < 1536) {
      int l = v / 384, r = v % 384, br = r >> 7, q = r & 127, kt = q >> 4, nt = q & 15;
      u16* dst = p.wt_br + (size_t)(l * 3 + br) * 1024 * 512;
      if (br == 0) transpose_unit(p.w_br_na + (size_t)l * 512 * 1024, 1024, dst, 512, kt * 64, nt * 64, sm);
      else if (br == 1) transpose_unit(p.w_br_lru + (size_t)l * 512 * 1024, 1024, dst, 512, kt * 64, nt * 64, sm);
      else transpose_unit(p.w_br_conv + (size_t)l * 512 * 1024, 1024, dst, 512, kt * 64, nt * 64, sm);
      continue;
    }
    v -= 1536;
    if (v < 1024) {
      int l = v >> 8, r = v & 255, kt = r >> 4, nt = r & 15;
      transpose_unit(p.w_out + (size_t)l * 1024 * 1024, 1024, p.wt_out + (size_t)l * 1024 * 1024, 1024, kt * 64, nt * 64, sm);
      continue;
    }
    v -= 1024;
    if (v < 512) {
      size_t idx = ((size_t)v * 256 + tid) * 8;
      float4 a = *(const float4*)(p.cache_k + idx), b = *(const float4*)(p.cache_k + idx + 4);
      *(uint4*)(p.ckb + idx) = make_uint4(pack2(a.x, a.y), pack2(a.z, a.w), pack2(b.x, b.y), pack2(b.z, b.w));
      continue;
    }
    v -= 512;
    if (v < 512) {
      int g = v * 256 + tid;
      int d = g & 63, h = (g >> 6) & 7, kg = (g >> 9) & 31, bl = g >> 14;
      float f[8];
#pragma unroll
      for (int j = 0; j < 8; ++j) f[j] = p.cache_v[((size_t)(bl * 256 + kg * 8 + j) * 8 + h) * 64 + d];
      *(uint4*)(p.cvT + ((size_t)(bl * 8 + h) * 64 + d) * 256 + kg * 8) =
          make_uint4(pack2(f[0], f[1]), pack2(f[2], f[3]), pack2(f[4], f[5]), pack2(f[6], f[7]));
      continue;
    }
    v -= 512;
    if (v >= 128) {
      v -= 128;
      const size_t o = ((size_t)(v & 1023) * 256 + tid) * 16;
      if (v < 1024) {
#pragma unroll
        for (int i = 0; i < 4; ++i) *(float4*)(p.xbuf + o + i * 4) = *(const float4*)(p.x_prompt + o + i * 4);
      } else {
#pragma unroll
        for (int i = 0; i < 4; ++i) *(float4*)(p.xbuf + 4194304 + o + i * 4) = *(const float4*)(p.x_sample + o + i * 4);
      }
      continue;
    }
    {
      int blk = v & 7, gate = (v >> 3) & 1, dir = (v >> 4) & 1, l = v >> 5;
      if (v == 0) {
        for (int i = tid; i < 4096; i += 256) p.sp8[i] = 8.f * log1pf(expf(-p.lru_lam[i]));
      }
      const size_t so = (size_t)((l * 2 + dir) * 8 + blk) * 4096;
      u16* dst = p.wgT + (size_t)v * 4096;
      for (int idx = tid; idx < 4096; idx += 256) {
        int k = idx >> 6, j = idx & 63;
        float wv;
        if (gate) wv = p.lru_wx[so + j * 64 + k]; else wv = p.lru_wa[so + j * 64 + k];
        dst[idx] = (u16)f2bf(wv);
      }
    }
  }
}

__device__ __forceinline__ const float* xrow(const Params& p, int l, int t) {
  return p.xbuf + (size_t)t * 1024;
}
__device__ __forceinline__ float wave_sum(float v) {
#pragma unroll
  for (int o = 32; o >= 1; o >>= 1) v += __shfl_xor(v, o);
  return v;
}

__device__ void phaseN(const Params& p, int l) {
  const int lane = otid() & 63, wave = otid() >> 6;
  const float* g = p.norm_g + l * 1024;
  for (int t = vbid() * 4 + wave; t < 8192; t += NVB * 4) {
    const float* x = xrow(p, l, t);
    float4 v[4];
    float ss = 0.f;
#pragma unroll
    for (int i = 0; i < 4; ++i) {
      v[i] = *(const float4*)(x + i * 256 + lane * 4);
      ss += v[i].x * v[i].x + v[i].y * v[i].y + v[i].z * v[i].z + v[i].w * v[i].w;
    }
    ss = wave_sum(ss);
    float rstd = rsqrtf(ss * (1.f / 1024.f) + 1e-6f);
    int cid = t < 4096 ? 0 : 1 + ((t - 4096) >> 11);
    const float* md = p.mod + (size_t)(l * 3 + cid) * 3072;
#pragma unroll
    for (int i = 0; i < 4; ++i) {
      int c = i * 256 + lane * 4;
      float4 gg = *(const float4*)(g + c), sh = *(const float4*)(md + c), sc = *(const float4*)(md + 1024 + c);
      float y0 = v[i].x * rstd * gg.x * (1.f + sc.x) + sh.x;
      float y1 = v[i].y * rstd * gg.y * (1.f + sc.y) + sh.y;
      float y2 = v[i].z * rstd * gg.z * (1.f + sc.z) + sh.z;
      float y3 = v[i].w * rstd * gg.w * (1.f + sc.w) + sh.w;
      *(uint2*)(p.xm + (size_t)t * 1024 + c) = make_uint2(pack2(y0, y1), pack2(y2, y3));
    }
  }
}

__device__ void phaseF(const Params& p) {
  const int lane = otid() & 63, wave = otid() >> 6;
  for (int t = vbid() * 4 + wave; t < 8192; t += NVB * 4) {
    const float* x = p.xbuf + (size_t)t * 1024;
    float4 v[4];
    float ss = 0.f;
#pragma unroll
    for (int i = 0; i < 4; ++i) {
      v[i] = *(const float4*)(x + i * 256 + lane * 4);
      ss += v[i].x * v[i].x + v[i].y * v[i].y + v[i].z * v[i].z + v[i].w * v[i].w;
    }
    ss = wave_sum(ss);
    float rstd = rsqrtf(ss * (1.f / 1024.f) + 1e-6f);
#pragma unroll
    for (int i = 0; i < 4; ++i) {
      int c = i * 256 + lane * 4;
      float4 gg = *(const float4*)(p.final_g + c);
      *(float4*)(p.out + (size_t)t * 1024 + c) =
          make_float4(v[i].x * rstd * gg.x, v[i].y * rstd * gg.y, v[i].z * rstd * gg.z, v[i].w * rstd * gg.w);
    }
  }
}

__device__ __forceinline__ int perm64(int r) { return (r & 0x43) | ((r & 0x30) >> 2) | ((r & 0x0c) << 2); }

template <int MI, int NJ, int WM, int WN, bool SWAP, bool PERM_A, bool PERM_B>
__device__ __forceinline__ void gemm_mainloop(const u16* __restrict__ A, int lda, const u16* __restrict__ B, int ldb,
                                              int K, f32x4 (&acc)[MI][NJ], char* smem) {
  constexpr int AR = WM * MI * 16, BR = WN * NJ * 16;
  constexpr int A_BYTES = AR * 128, STAGE = (AR + BR) * 128;
  const int tid = otid512(), lane = tid & 63, wave = tid >> 6;
  const int wm = wave / WN, wn = wave % WN, fr = lane & 15, fq = lane >> 4;
  const int lr = tid >> 3, lc = (tid & 7) ^ ((lr >> 1) & 7);
  const u16* ag = A + (size_t)(PERM_A ? perm64(lr) : lr) * lda + lc * 8;
  const u16* bg = B + (size_t)(PERM_B ? perm64(lr) : lr) * ldb + lc * 8;
  char* sA = smem + tid * 16;
  char* sB = smem + A_BYTES + tid * 16;
#define GLDS(gp, lp) __builtin_amdgcn_global_load_lds((const unsigned*)(gp), (unsigned*)(lp), 16, 0, 0)
#pragma unroll
  for (int i = 0; i < AR / 64; ++i) GLDS(ag + (size_t)i * 64 * lda, sA + i * 8192);
#pragma unroll
  for (int i = 0; i < BR / 64; ++i) GLDS(bg + (size_t)i * 64 * ldb, sB + i * 8192);
  asm volatile("s_waitcnt vmcnt(0)" ::: "memory");
  __syncthreads();
  const int swz_r = (fr >> 1) & 7;
  const int aoff = (wm * MI * 16 + fr) * 128, boff = A_BYTES + (wn * NJ * 16 + fr) * 128;
  const int nk = K >> 6;
  for (int kt = 0; kt < nk; ++kt) {
    const int cur = kt & 1;
    if (kt + 1 < nk) {
#pragma unroll
      for (int i = 0; i < AR / 64; ++i) GLDS(ag + (size_t)i * 64 * lda + (kt + 1) * 64, sA + (cur ^ 1) * STAGE + i * 8192);
#pragma unroll
      for (int i = 0; i < BR / 64; ++i) GLDS(bg + (size_t)i * 64 * ldb + (kt + 1) * 64, sB + (cur ^ 1) * STAGE + i * 8192);
    }
    const char* cA = smem + cur * STAGE + aoff;
    const char* cB = smem + cur * STAGE + boff;
#pragma unroll
    for (int ks = 0; ks < 2; ++ks) {
      bf16x8 af[MI], bfr[NJ];
      const int ch = ((ks * 4 + fq) ^ swz_r) << 4;
#pragma unroll
      for (int j = 0; j < NJ; ++j) bfr[j] = *(const bf16x8*)(cB + j * 2048 + ch);
#pragma unroll
      for (int i = 0; i < MI; ++i) af[i] = *(const bf16x8*)(cA + i * 2048 + ch);
#pragma unroll
      for (int i = 0; i < MI; ++i)
#pragma unroll
        for (int j = 0; j < NJ; ++j) {
          if (SWAP) acc[i][j] = __builtin_amdgcn_mfma_f32_16x16x32_bf16(bfr[j], af[i], acc[i][j], 0, 0, 0);
          else acc[i][j] = __builtin_amdgcn_mfma_f32_16x16x32_bf16(af[i], bfr[j], acc[i][j], 0, 0, 0);
        }
    }
    asm volatile("s_waitcnt vmcnt(0)" ::: "memory");
    __syncthreads();
  }
#undef GLDS
}

template <int MI, int NJ>
__device__ __forceinline__ void zero_acc(f32x4 (&acc)[MI][NJ]) {
#pragma unroll
  for (int i = 0; i < MI; ++i)
#pragma unroll
    for (int j = 0; j < NJ; ++j) acc[i][j] = f32x4{0.f, 0.f, 0.f, 0.f};
}

__device__ void phaseA(const Params& p, int l, char* smem) {
  const int tid = otid512(), lane = tid & 63, wave = tid >> 6;
  const int wm = wave >> 2, wn = wave & 3, fr = lane & 15, fq = lane >> 4;
  const u16* W = p.wt_in + (size_t)l * 8192 * 1024;
  float* newk = p.out + 8388608;
  float* newv = p.out + 16777216;
  for (int id = blockIdx.x; id < 1024; id += gridDim.x) {
    const int xcd = id & 7, j_ = id >> 3;
    const int mt = xcd * 4 + (j_ & 3), nt = (j_ >> 5) * 8 + ((j_ >> 2) & 7);
    const int m0 = mt * 256, n0 = nt * 256;
    f32x4 acc[8][4];
    zero_acc<8, 4>(acc);
    const u16* A = p.xm + (size_t)m0 * 1024;
    const u16* B = W + (size_t)n0 * 1024;
    if (n0 >= 1024 && n0 < 1536) {
      gemm_mainloop<8, 4, 2, 4, false, true, false>(A, 1024, B, 1024, 1024, acc, smem);
#pragma unroll
      for (int g = 0; g < 2; ++g)
#pragma unroll
        for (int j = 0; j < 4; ++j) {
          const int tok0 = m0 + wm * 128 + g * 64 + fq * 16;
          const int vc = n0 + wn * 64 + j * 16 + fr - 1024;
          uint4 w0 = make_uint4(pack2(acc[g * 4 + 0][j][0], acc[g * 4 + 0][j][1]), pack2(acc[g * 4 + 0][j][2], acc[g * 4 + 0][j][3]),
                                pack2(acc[g * 4 + 1][j][0], acc[g * 4 + 1][j][1]), pack2(acc[g * 4 + 1][j][2], acc[g * 4 + 1][j][3]));
          uint4 w1 = make_uint4(pack2(acc[g * 4 + 2][j][0], acc[g * 4 + 2][j][1]), pack2(acc[g * 4 + 2][j][2], acc[g * 4 + 2][j][3]),
                                pack2(acc[g * 4 + 3][j][0], acc[g * 4 + 3][j][1]), pack2(acc[g * 4 + 3][j][2], acc[g * 4 + 3][j][3]));
          *(uint4*)(p.Vt + (size_t)vc * 8192 + tok0) = w0;
          *(uint4*)(p.Vt + (size_t)vc * 8192 + tok0 + 8) = w1;
          if (tok0 < 4096) {
#pragma unroll
            for (int i4 = 0; i4 < 4; ++i4)
#pragma unroll
              for (int jj = 0; jj < 4; ++jj) {
                const int t = tok0 + i4 * 4 + jj;
                newv[((size_t)((t >> 8) * 4 + l) * 256 + (t & 255)) * 512 + vc] = acc[g * 4 + i4][j][jj];
              }
          }
        }
    } else {
      gemm_mainloop<8, 4, 2, 4, true, false, true>(A, 1024, B, 1024, 1024, acc, smem);
      const bool isK = (n0 >= 512 && n0 < 1024);
#pragma unroll
      for (int i = 0; i < 8; ++i) {
        const int t = m0 + wm * 128 + i * 16 + fr;
        const int col = n0 + wn * 64 + fq * 16;
        uint4 w0 = make_uint4(pack2(acc[i][0][0], acc[i][0][1]), pack2(acc[i][0][2], acc[i][0][3]),
                              pack2(acc[i][1][0], acc[i][1][1]), pack2(acc[i][1][2], acc[i][1][3]));
        uint4 w1 = make_uint4(pack2(acc[i][2][0], acc[i][2][1]), pack2(acc[i][2][2], acc[i][2][3]),
                              pack2(acc[i][3][0], acc[i][3][1]), pack2(acc[i][3][2], acc[i][3][3]));
        *(uint4*)(p.P + (size_t)t * 8192 + col) = w0;
        *(uint4*)(p.P + (size_t)t * 8192 + col + 8) = w1;
        if (isK && t < 4096) {
          float* dst = newk + ((size_t)((t >> 8) * 4 + l) * 256 + (t & 255)) * 512 + (col - 512);
#pragma unroll
          for (int j = 0; j < 4; ++j) *(float4*)(dst + j * 4) = make_float4(acc[i][j][0], acc[i][j][1], acc[i][j][2], acc[i][j][3]);
        }
      }
    }
  }
}

__device__ __forceinline__ bf16x8 ld16(const u16* ptr) { return *(const bf16x8*)ptr; }

__device__ void attn_unit(const Params& p, int l, int unit) {
  const int lane = otid() & 63, fr = lane & 15, fq = lane >> 4;
  const bool lat = unit >= 2048;
  int b, h, qtok0, r = 0, n = 0, row0 = 0, band0 = 0;
  if (!lat) {
    b = unit >> 7; h = (unit >> 4) & 7;
    qtok0 = b * 256 + (unit & 15) * 16;
  } else {
    int u = unit - 2048;
    b = u >> 10; r = (u >> 5) & 31; n = (u >> 3) & 3; h = u & 7;
    qtok0 = 4096 + b * 2048 + r * 64 + n * 16;
    row0 = min(max(r - 4, 0), 24);
    band0 = min(max(16 * n - 8, 0), 32);
  }
  const u16* qp = p.P + (size_t)(qtok0 + fr) * 8192 + h * 64 + fq * 8;
  const bf16x8 q0 = ld16(qp), q1 = ld16(qp + 32);
  f32x4 o[4];
#pragma unroll
  for (int dt = 0; dt < 4; ++dt) o[dt] = f32x4{0.f, 0.f, 0.f, 0.f};
  float m = -1e30f, lsum = 0.f;
  const float* rpb = p.na_rpb + (size_t)(l * 8 + h) * 15 * 31;
  const int qc = 16 * n + fr;
  const int wst = min(max(qc - 8, 0), 48);
  const int nchunks = lat ? 8 : 4;
#pragma unroll 1
  for (int c = 0; c < nchunks; ++c) {
    const bool local = lat && c < 4;
    const u16 *kb, *vb;
    size_t kstride, kslab, vstride, vslab;
    if (!lat) {
      size_t key0 = (size_t)b * 256 + c * 64;
      kb = p.P + key0 * 8192 + 512 + h * 64; kstride = 8192; kslab = (size_t)32 * 8192;
      vb = p.Vt + (size_t)(h * 64) * 8192 + key0; vstride = 8192; vslab = 32;
    } else if (local) {
      size_t tok = 4096 + (size_t)b * 2048 + (row0 + c * 2) * 64 + band0;
      kb = p.P + tok * 8192 + 512 + h * 64; kstride = 8192; kslab = (size_t)64 * 8192;
      vb = p.Vt + (size_t)(h * 64) * 8192 + tok; vstride = 8192; vslab = 64;
    } else {
      int cc = c - 4;
      kb = p.ckb + ((size_t)(b * 4 + l) * 256 + cc * 64) * 512 + h * 64; kstride = 512; kslab = (size_t)32 * 512;
      vb = p.cvT + (size_t)((b * 4 + l) * 8 + h) * 64 * 256 + cc * 64; vstride = 256; vslab = 32;
    }
    f32x4 s[4];
#pragma unroll
    for (int mt = 0; mt < 4; ++mt) {
      const u16* kp = kb + (mt >> 1) * kslab + (size_t)((mt & 1) * 16 + fr) * kstride + fq * 8;
      bf16x8 a0 = ld16(kp), a1 = ld16(kp + 32);
      f32x4 z = f32x4{0.f, 0.f, 0.f, 0.f};
      z = __builtin_amdgcn_mfma_f32_16x16x32_bf16(a0, q0, z, 0, 0, 0);
      s[mt] = __builtin_amdgcn_mfma_f32_16x16x32_bf16(a1, q1, z, 0, 0, 0);
    }
    float cmax = -1e30f;
#pragma unroll
    for (int mt = 0; mt < 4; ++mt) {
      const int row_off = row0 + c * 2 + (mt >> 1) - r + 7;
#pragma unroll
      for (int jj = 0; jj < 4; ++jj) {
        float v = s[mt][jj] * 0.125f;
        if (local) {
          int kc = band0 + (mt & 1) * 16 + fq * 4 + jj;
          bool valid = (kc >= wst) && (kc < wst + 16);
          int col_off = min(max(kc - qc, -15), 15) + 15;
          float bias = rpb[row_off * 31 + col_off];
          v = valid ? v + bias : -1e30f;
        }
        s[mt][jj] = v;
        cmax = fmaxf(cmax, v);
      }
    }
    cmax = fmaxf(cmax, __shfl_xor(cmax, 16));
    cmax = fmaxf(cmax, __shfl_xor(cmax, 32));
    const float mnew = fmaxf(m, cmax);
    const float alpha = __expf(m - mnew);
    m = mnew;
    lsum *= alpha;
#pragma unroll
    for (int dt = 0; dt < 4; ++dt) o[dt] *= alpha;
#pragma unroll
    for (int mt = 0; mt < 4; ++mt)
#pragma unroll
      for (int jj = 0; jj < 4; ++jj) {
        float pv = __expf(s[mt][jj] - m);
        lsum += pv;
        s[mt][jj] = pv;
      }
#pragma unroll
    for (int sl = 0; sl < 2; ++sl) {
      u32x4 pw = {pack2(s[2 * sl][0], s[2 * sl][1]), pack2(s[2 * sl][2], s[2 * sl][3]),
                  pack2(s[2 * sl + 1][0], s[2 * sl + 1][1]), pack2(s[2 * sl + 1][2], s[2 * sl + 1][3])};
      bf16x8 pb = __builtin_bit_cast(bf16x8, pw);
#pragma unroll
      for (int dt = 0; dt < 4; ++dt) {
        const u16* vp = vb + sl * vslab + (size_t)(dt * 16 + fr) * vstride + fq * 4;
        uint2 v0 = *(const uint2*)vp, v1 = *(const uint2*)(vp + 16);
        u32x4 vw = {v0.x, v0.y, v1.x, v1.y};
        o[dt] = __builtin_amdgcn_mfma_f32_16x16x32_bf16(__builtin_bit_cast(bf16x8, vw), pb, o[dt], 0, 0, 0);
      }
    }
  }
  lsum += __shfl_xor(lsum, 16);
  lsum += __shfl_xor(lsum, 32);
  const float inv = 1.f / lsum;
  const size_t t = qtok0 + fr;
#pragma unroll
  for (int dt = 0; dt < 4; ++dt) {
    int d0 = h * 64 + dt * 16 + fq * 4;
    uint2 g = *(const uint2*)(p.P + t * 8192 + 1536 + d0);
    float y0 = o[dt][0] * inv * silu(lo16(g.x)), y1 = o[dt][1] * inv * silu(hi16(g.x));
    float y2 = o[dt][2] * inv * silu(lo16(g.y)), y3 = o[dt][3] * inv * silu(hi16(g.y));
    *(uint2*)(p.Ana + t * 512 + d0) = make_uint2(pack2(y0, y1), pack2(y2, y3));
  }
}

__device__ void lru_unit(const Params& p, int l, int unit, char* smem) {
  const int tid = otid(), lane = tid & 63, wave = tid >> 6, fr = lane & 15, fq = lane >> 4;
  const int blk = unit & 7, dir = (unit >> 3) & 1, cs = unit >> 4;
  const int t0 = cs * 64;
  int seq_lo, seq_hi;
  if (cs < 64) { seq_lo = (cs >> 2) * 256; seq_hi = seq_lo + 256; }
  else { seq_lo = 4096 + ((cs - 64) >> 5) * 2048; seq_hi = seq_lo + 2048; }
  u16* uraw = (u16*)smem;
  u16* udb = (u16*)(smem + 8704);
  float* sa = (float*)(smem + 8704 + 9216);
  float* sb = sa + 4096;
  float* stot = sb + 4096;
  const int wbase = dir ? t0 : t0 - 3;
#pragma unroll
  for (int i = 0; i < 3; ++i) {
    int row = (tid >> 3) + i * 32, ch8 = tid & 7;
    if (row < 67) {
      int t = wbase + row;
      uint4 v = make_uint4(0, 0, 0, 0);
      if (t >= seq_lo && t < seq_hi) v = *(const uint4*)(p.P + (size_t)t * 8192 + 2048 + blk * 64 + ch8 * 8);
      *(uint4*)(uraw + row * 64 + ch8 * 8) = v;
    }
  }
  __syncthreads();
  {
    const int ch = tid & 63, tg = tid >> 6;
    const int cw = blk * 64 + ch;
    const float* cwp = p.lru_conv_w + (size_t)((l * 2 + dir) * 4) * 512 + cw;
    const float w0 = cwp[0], w1 = cwp[512], w2 = cwp[1024], w3 = cwp[1536];
    const float cb = p.lru_conv_b[(l * 2 + dir) * 512 + cw];
    for (int t = tg * 16; t < tg * 16 + 16; ++t) {
      float ud = cb + w0 * bf2f(uraw[t * 64 + ch]) + w1 * bf2f(uraw[(t + 1) * 64 + ch]) +
                 w2 * bf2f(uraw[(t + 2) * 64 + ch]) + w3 * bf2f(uraw[(t + 3) * 64 + ch]);
      sb[t * 64 + ch] = ud;
      udb[t * 72 + ch] = (u16)f2bf(ud);
    }
  }
  __syncthreads();
  {
    f32x4 ar[4], ai[4];
#pragma unroll
    for (int nt = 0; nt < 4; ++nt) { ar[nt] = f32x4{0.f, 0.f, 0.f, 0.f}; ai[nt] = f32x4{0.f, 0.f, 0.f, 0.f}; }
    const u16* wr = p.wgT + (size_t)(((l * 2 + dir) * 2 + 0) * 8 + blk) * 4096;
    const u16* wi = p.wgT + (size_t)(((l * 2 + dir) * 2 + 1) * 8 + blk) * 4096;
#pragma unroll
    for (int ks = 0; ks < 2; ++ks) {
      bf16x8 af = *(const bf16x8*)(udb + (wave * 16 + fr) * 72 + ks * 32 + fq * 8);
#pragma unroll
      for (int nt = 0; nt < 4; ++nt) {
        bf16x8 br = ld16(wr + (nt * 16 + fr) * 64 + ks * 32 + fq * 8);
        bf16x8 bi = ld16(wi + (nt * 16 + fr) * 64 + ks * 32 + fq * 8);
        ar[nt] = __builtin_amdgcn_mfma_f32_16x16x32_bf16(af, br, ar[nt], 0, 0, 0);
        ai[nt] = __builtin_amdgcn_mfma_f32_16x16x32_bf16(af, bi, ai[nt], 0, 0, 0);
      }
    }
#pragma unroll
    for (int nt = 0; nt < 4; ++nt) {
      const int k = nt * 16 + fr, cw = blk * 64 + k;
      const int pi = (l * 2 + dir) * 512 + cw;
      const float ba = p.lru_ba[pi], bx = p.lru_bx[pi];
      const float sp = p.sp8[pi];
#pragma unroll
      for (int jj = 0; jj < 4; ++jj) {
        const int t = wave * 16 + fq * 4 + jj;
        float rg = sigm(ar[nt][jj] + ba), ig = sigm(ai[nt][jj] + bx);
        float la = -rg * sp;
        float a = __expf(la);
        float ud = sb[t * 64 + k];
        float x2 = 2.f * la;
        float ser = -x2 * (1.f + x2 * (0.5f + x2 * (0.16666667f + x2 * (0.041666668f + x2 * (0.0083333338f + x2 * 0.0013888889f)))));
        float om = x2 > -0.5f ? ser : 1.f - a * a;
        float bb = __builtin_amdgcn_sqrtf(om) * (ig * ud);
        sa[t * 64 + k] = a;
        sb[t * 64 + k] = bb;
      }
    }
  }
  __syncthreads();
  {
    const int ch = tid & 63, sub = tid >> 6;
    float h = 0.f, ac = 1.f;
    for (int q = 0; q < 16; ++q) {
      int pos = sub * 16 + q;
      int t = dir ? 63 - pos : pos;
      float a = sa[t * 64 + ch], bb = sb[t * 64 + ch];
      h = a * h + bb;
      ac *= a;
      sa[t * 64 + ch] = ac;
      sb[t * 64 + ch] = h;
    }
    stot[(sub * 64 + ch) * 2] = ac;
    stot[(sub * 64 + ch) * 2 + 1] = h;
    __syncthreads();
    float cA = 1.f, cH = 0.f;
    for (int s2 = 0; s2 < sub; ++s2) {
      float A2 = stot[(s2 * 64 + ch) * 2], H2 = stot[(s2 * 64 + ch) * 2 + 1];
      cH = A2 * cH + H2;
      cA *= A2;
    }
    u16* hl = p.hloc + ((size_t)dir * 8192 + t0) * 512 + blk * 64 + ch;
    u16* acp = p.acum + ((size_t)dir * 8192 + t0) * 512 + blk * 64 + ch;
    float hf = 0.f, af = 1.f;
    for (int q = 0; q < 16; ++q) {
      int pos = sub * 16 + q;
      int t = dir ? 63 - pos : pos;
      hf = sb[t * 64 + ch] + sa[t * 64 + ch] * cH;
      af = sa[t * 64 + ch] * cA;
      hl[(size_t)t * 512] = (u16)f2bf(hf);
      acp[(size_t)t * 512] = (u16)f2bf(af);
    }
    if (sub == 3) {
      p.Atot[(size_t)(cs * 2 + dir) * 512 + blk * 64 + ch] = af;
      p.Htot[(size_t)(cs * 2 + dir) * 512 + blk * 64 + ch] = hf;
    }
  }
  __syncthreads();
}

__device__ void phaseB(const Params& p, int l, char* smem) {
  const int wave = __builtin_amdgcn_readfirstlane(otid() >> 6);
  for (int it = vbid(); it < 3072; it += NVB) {
    if (it < 1024) attn_unit(p, l, it * 4 + wave);
    else lru_unit(p, l, it - 1024, smem);
  }
}

__device__ __forceinline__ void unpack8(uint4 v, float (&f)[8]) {
  f[0] = lo16(v.x); f[1] = hi16(v.x); f[2] = lo16(v.y); f[3] = hi16(v.y);
  f[4] = lo16(v.z); f[5] = hi16(v.z); f[6] = lo16(v.w); f[7] = hi16(v.w);
}
__device__ void phaseB2(const Params& p, int l, char* smem) {
  const int tid = otid();
  float* scar = (float*)smem;
  float* new_state = p.out + 25165824;
  for (int u = vbid(); u < 512; u += NVB) {
    const int cs = u >> 2, quarter = u & 3;
    int first, c, nch, b, seq_lo, seq_hi;
    const bool lat = cs >= 64;
    if (!lat) { b = cs >> 2; c = cs & 3; nch = 4; first = b * 4; seq_lo = b * 256; seq_hi = seq_lo + 256; }
    else { b = (cs - 64) >> 5; c = (cs - 64) & 31; nch = 32; first = 64 + b * 32; seq_lo = 4096 + b * 2048; seq_hi = seq_lo + 2048; }
    {
      const int dir = tid >> 7, ch = quarter * 128 + (tid & 127);
      float carry = lat ? p.state_lru[(size_t)((b * 4 + l) * 2 + dir) * 512 + ch] : 0.f;
      const int nprev = dir ? (nch - 1 - c) : c;
      const int start = dir ? (nch - 1) : 0, step = dir ? -1 : 1;
      if (!lat) {
        float A_[3], H_[3];
#pragma unroll
        for (int s = 0; s < 3; ++s) {
          const int cc = min(max(start + step * s, 0), 3);
          const size_t ix = (size_t)((first + cc) * 2 + dir) * 512 + ch;
          A_[s] = p.Atot[ix]; H_[s] = p.Htot[ix];
        }
#pragma unroll
        for (int s = 0; s < 3; ++s) if (s < nprev) carry = A_[s] * carry + H_[s];
        const bool last = dir ? (c == 0) : (c == 3);
        if (last) {
          const size_t ix = (size_t)(cs * 2 + dir) * 512 + ch;
          new_state[(size_t)((b * 4 + l) * 2 + dir) * 512 + ch] = p.Atot[ix] * carry + p.Htot[ix];
        }
      } else {
        float A_[31], H_[31];
#pragma unroll
        for (int s = 0; s < 31; ++s) {
          const int cc = min(max(start + step * s, 0), 31);
          const size_t ix = (size_t)((first + cc) * 2 + dir) * 512 + ch;
          A_[s] = p.Atot[ix]; H_[s] = p.Htot[ix];
        }
#pragma unroll
        for (int s = 0; s < 31; ++s) if (s < nprev) carry = A_[s] * carry + H_[s];
      }
      scar[tid] = carry;
    }
    __syncthreads();
    {
      const int c8 = tid & 15, ch0 = quarter * 128 + c8 * 8;
      float cf[8], cb[8], w0[8], w1[8], w2[8];
#pragma unroll
      for (int e = 0; e < 8; ++e) {
        cf[e] = scar[c8 * 8 + e]; cb[e] = scar[128 + c8 * 8 + e];
        w0[e] = p.conv_w[(l * 3 + 0) * 512 + ch0 + e]; w1[e] = p.conv_w[(l * 3 + 1) * 512 + ch0 + e];
        w2[e] = p.conv_w[(l * 3 + 2) * 512 + ch0 + e];
      }
#pragma unroll 2
      for (int i = 0; i < 4; ++i) {
        const int t = cs * 64 + (tid >> 4) + i * 16;
        const u16* pr = p.P + (size_t)t * 8192 + ch0;
        const uint4 z4 = make_uint4(0u, 0u, 0u, 0u);
        uint4 hf4 = *(const uint4*)(p.hloc + (size_t)t * 512 + ch0), af4 = *(const uint4*)(p.acum + (size_t)t * 512 + ch0);
        uint4 hb4 = *(const uint4*)(p.hloc + ((size_t)8192 + t) * 512 + ch0), ab4 = *(const uint4*)(p.acum + ((size_t)8192 + t) * 512 + ch0);
        uint4 gl4 = *(const uint4*)(pr + 2560), cb4 = *(const uint4*)(pr + 3072), gc4 = *(const uint4*)(pr + 4608);
        uint4 cc1 = *(const uint4*)(pr + 3584), chh1 = *(const uint4*)(pr + 4096);
        uint4 cc0 = z4, chh0 = z4, cc2 = z4, chh2 = z4;
        if (t - 1 >= seq_lo) { cc0 = *(const uint4*)(pr - 8192 + 3584); chh0 = *(const uint4*)(pr - 8192 + 4096); }
        if (t + 1 < seq_hi) { cc2 = *(const uint4*)(pr + 8192 + 3584); chh2 = *(const uint4*)(pr + 8192 + 4096); }
        float hf[8], af[8], hb[8], ab[8], gl[8], cbv[8], gc[8], a0[8], b0[8], a1[8], b1[8], a2[8], b2[8], ol[8], oc[8];
        unpack8(hf4, hf); unpack8(af4, af); unpack8(hb4, hb); unpack8(ab4, ab); unpack8(gl4, gl); unpack8(cb4, cbv); unpack8(gc4, gc);
        unpack8(cc0, a0); unpack8(chh0, b0); unpack8(cc1, a1); unpack8(chh1, b1); unpack8(cc2, a2); unpack8(chh2, b2);
#pragma unroll
        for (int e = 0; e < 8; ++e) {
          float h = (hf[e] + af[e] * cf[e]) + (hb[e] + ab[e] * cb[e]);
          ol[e] = h * silu(gl[e]);
          float conv = w0[e] * (a0[e] * b0[e]) + w1[e] * (a1[e] * b1[e]) + w2[e] * (a2[e] * b2[e]);
          oc[e] = cbv[e] * conv * silu(gc[e]);
        }
        *(uint4*)(p.Alru + (size_t)t * 512 + ch0) = make_uint4(pack2(ol[0], ol[1]), pack2(ol[2], ol[3]), pack2(ol[4], ol[5]), pack2(ol[6], ol[7]));
        *(uint4*)(p.Aconv + (size_t)t * 512 + ch0) = make_uint4(pack2(oc[0], oc[1]), pack2(oc[2], oc[3]), pack2(oc[4], oc[5]), pack2(oc[6], oc[7]));
      }
    }
    __syncthreads();
  }
}

__device__ void phaseC1(const Params& p, int l, char* smem) {
  const int tid = otid512(), lane = tid & 63, wave = tid >> 6;
  const int wm = wave >> 1, wn = wave & 1, fr = lane & 15, fq = lane >> 4;
  for (int id = blockIdx.x; id < 256; id += gridDim.x) {
    const int xcd = id & 7, j_ = id >> 3;
    const int mt = xcd * 4 + (j_ >> 3), nt = j_ & 7;
    const int m0 = mt * 256, n0 = nt * 128;
    f32x4 tot[4][4];
    zero_acc<4, 4>(tot);
#pragma unroll 1
    for (int br = 0; br < 3; ++br) {
      f32x4 acc[4][4];
      zero_acc<4, 4>(acc);
      const u16* A = p.Ana + (size_t)br * 8192 * 512 + (size_t)m0 * 512;
      const u16* B = p.wt_br + (size_t)(l * 3 + br) * 1024 * 512 + (size_t)n0 * 512;
      gemm_mainloop<4, 4, 4, 2, true, false, true>(A, 512, B, 512, 512, acc, smem);
#pragma unroll
      for (int i = 0; i < 4; ++i) {
        const int t = m0 + wm * 64 + i * 16 + fr;
        const int col = n0 + wn * 64 + fq * 16;
        const u16* gp = p.P + (size_t)t * 8192 + 5120 + br * 1024 + col;
        uint4 g0 = *(const uint4*)gp, g1 = *(const uint4*)(gp + 8);
        tot[i][0][0] += sigm(lo16(g0.x)) * acc[i][0][0]; tot[i][0][1] += sigm(hi16(g0.x)) * acc[i][0][1];
        tot[i][0][2] += sigm(lo16(g0.y)) * acc[i][0][2]; tot[i][0][3] += sigm(hi16(g0.y)) * acc[i][0][3];
        tot[i][1][0] += sigm(lo16(g0.z)) * acc[i][1][0]; tot[i][1][1] += sigm(hi16(g0.z)) * acc[i][1][1];
        tot[i][1][2] += sigm(lo16(g0.w)) * acc[i][1][2]; tot[i][1][3] += sigm(hi16(g0.w)) * acc[i][1][3];
        tot[i][2][0] += sigm(lo16(g1.x)) * acc[i][2][0]; tot[i][2][1] += sigm(hi16(g1.x)) * acc[i][2][1];
        tot[i][2][2] += sigm(lo16(g1.y)) * acc[i][2][2]; tot[i][2][3] += sigm(hi16(g1.y)) * acc[i][2][3];
        tot[i][3][0] += sigm(lo16(g1.z)) * acc[i][3][0]; tot[i][3][1] += sigm(hi16(g1.z)) * acc[i][3][1];
        tot[i][3][2] += sigm(lo16(g1.w)) * acc[i][3][2]; tot[i][3][3] += sigm(hi16(g1.w)) * acc[i][3][3];
      }
    }
#pragma unroll
    for (int i = 0; i < 4; ++i) {
      const int t = m0 + wm * 64 + i * 16 + fr;
      const int col = n0 + wn * 64 + fq * 16;
      uint4 w0 = make_uint4(pack2(tot[i][0][0], tot[i][0][1]), pack2(tot[i][0][2], tot[i][0][3]),
                            pack2(tot[i][1][0], tot[i][1][1]), pack2(tot[i][1][2], tot[i][1][3]));
      uint4 w1 = make_uint4(pack2(tot[i][2][0], tot[i][2][1]), pack2(tot[i][2][2], tot[i][2][3]),
                            pack2(tot[i][3][0], tot[i][3][1]), pack2(tot[i][3][2], tot[i][3][3]));
      *(uint4*)(p.merged + (size_t)t * 1024 + col) = w0;
      *(uint4*)(p.merged + (size_t)t * 1024 + col + 8) = w1;
    }
  }
}

__device__ void phaseC2(const Params& p, int l, char* smem) {
  const int tid = otid512(), lane = tid & 63, wave = tid >> 6;
  const int wm = wave >> 1, wn = wave & 1, fr = lane & 15, fq = lane >> 4;
  for (int id = blockIdx.x; id < 256; id += gridDim.x) {
    const int xcd = id & 7, j_ = id >> 3;
    const int mt = xcd * 4 + (j_ >> 3), nt = j_ & 7;
    const int m0 = mt * 256, n0 = nt * 128;
    f32x4 acc[4][4];
    zero_acc<4, 4>(acc);
    gemm_mainloop<4, 4, 4, 2, true, false, true>(p.merged + (size_t)m0 * 1024, 1024,
                                                 p.wt_out + (size_t)l * 1024 * 1024 + (size_t)n0 * 1024, 1024, 1024, acc, smem);
#pragma unroll
    for (int i = 0; i < 4; ++i) {
      const int t = m0 + wm * 64 + i * 16 + fr;
      const int col = n0 + wn * 64 + fq * 16;
      const int cid = t < 4096 ? 0 : 1 + ((t - 4096) >> 11);
      const float* gt = p.mod + (size_t)(l * 3 + cid) * 3072 + 2048 + col;
      float* xr = p.xbuf + (size_t)t * 1024 + col;
#pragma unroll
      for (int j = 0; j < 4; ++j) {
        float4 g4 = *(const float4*)(gt + j * 4);
        float4 xo = *(const float4*)(xr + j * 4);
        *(float4*)(xr + j * 4) = make_float4(xo.x + g4.x * acc[i][j][0], xo.y + g4.y * acc[i][j][1],
                                             xo.z + g4.z * acc[i][j][2], xo.w + g4.w * acc[i][j][3]);
      }
    }
  }
}

#define XB_TMO      128
#define XB_XCNT(j)  (256  + 64 * (j))
#define XB_XSUB(j)  (1280 + 64 * (j))
#define XB_XGEN(j)  (2304 + 64 * (j))
#define XB_TOP      3328
#define XB_TOPGEN   3392
#define XCD_BAR_WORDS 3456
#define XB_SPIN_CAP (1u << 18)
#define LAS __attribute__((address_space(3)))
__device__ __forceinline__ unsigned xb_ld(unsigned* p) { return __hip_atomic_load(p, __ATOMIC_RELAXED, __HIP_MEMORY_SCOPE_AGENT); }
__device__ __forceinline__ unsigned xb_add(unsigned* p, unsigned v) { return __hip_atomic_fetch_add(p, v, __ATOMIC_RELAXED, __HIP_MEMORY_SCOPE_AGENT); }
__device__ __forceinline__ unsigned xb_xcc_id() { return (unsigned)__builtin_amdgcn_s_getreg((3 << 11) | 20) & 0xFu; }
#define XB_SPIN(cond, bar) do { unsigned _sp = 0; while (cond) { __builtin_amdgcn_s_sleep(1); \
    if ((++_sp & 255u) == 0u) { if (xb_ld(&(bar)[XB_TMO])) break; if (_sp > XB_SPIN_CAP) { atomicAdd(&(bar)[XB_TMO], 1u); break; } } } } while (0)
struct XcdBarrier { unsigned* bar; unsigned x; volatile LAS unsigned* st; };
__device__ __forceinline__ XcdBarrier xcd_barrier_post(unsigned* bar, volatile LAS unsigned* st) {
  XcdBarrier b; b.bar = bar; b.x = xb_xcc_id(); b.st = st;
  if (threadIdx.x == 0) (void)xb_add(&bar[XB_XCNT(b.x)], 1u);
  return b;
}
__device__ __forceinline__ void xcd_barrier_complete(unsigned* bar, unsigned x, unsigned& nloc, unsigned& nx) {
  const unsigned G = gridDim.x * gridDim.y * gridDim.z;
  unsigned sum, cnt, mine, sp = 0u;
  for (;;) {
    sum = 0u; cnt = 0u; mine = 0u;
#pragma unroll
    for (unsigned j = 0; j < 16; ++j) { const unsigned c = xb_ld(&bar[XB_XCNT(j)]); sum += c; cnt += (c > 0u) ? 1u : 0u; mine = (j == x) ? c : mine; }
    if (sum == G) break;
    __builtin_amdgcn_s_sleep(1);
    if ((++sp & 255u) == 0u) { if (xb_ld(&bar[XB_TMO])) break; if (sp > XB_SPIN_CAP) { atomicAdd(&bar[XB_TMO], 1u); break; } }
  }
  nloc = mine > 0u ? mine : 1u; nx = cnt > 0u ? cnt : 1u;
}
__device__ __forceinline__ void xcd_barrier(const XcdBarrier& b) {
  asm volatile("s_waitcnt vmcnt(0)" ::: "memory");
  __syncthreads();
  if (threadIdx.x == 0) {
    unsigned* bar = b.bar;
    __builtin_amdgcn_s_waitcnt(0);
    unsigned nloc = b.st[0], nx = b.st[1];
    if (nloc == 0u) { xcd_barrier_complete(bar, b.x, nloc, nx); b.st[0] = nloc; b.st[1] = nx; }
    const unsigned old = xb_add(&bar[XB_XSUB(b.x)], 1u);
    const unsigned gen = old / nloc;
    if (old + 1u == (gen + 1u) * nloc) {
      __builtin_amdgcn_fence(__ATOMIC_RELEASE, "agent");
      asm volatile("s_waitcnt vmcnt(0)" ::: "memory");
      const unsigned og = xb_add(&bar[XB_TOP], 1u);
      const unsigned tg = og / nx;
      if (og + 1u == (tg + 1u) * nx) xb_add(&bar[XB_TOPGEN], 1u);
      else XB_SPIN(xb_ld(&bar[XB_TOPGEN]) == tg, bar);
      __builtin_amdgcn_fence(__ATOMIC_ACQUIRE, "agent");
      xb_add(&bar[XB_XGEN(b.x)], 1u);
      asm volatile("s_waitcnt vmcnt(0)" ::: "memory");
    } else {
      XB_SPIN(xb_ld(&bar[XB_XGEN(b.x)]) == gen, bar);
      __builtin_amdgcn_fence(__ATOMIC_ACQUIRE, "agent");
      asm volatile("s_waitcnt vmcnt(0)" ::: "memory");
    }
  }
  __syncthreads();
}

#ifndef PROBE
#define PROBE 0
#endif
__global__ void __launch_bounds__(NTHREADS) mega(Params p) {
  extern __shared__ __attribute__((aligned(16))) char dsm[];
  char* smem = dsm;
  char* hsm = dsm + __builtin_amdgcn_readfirstlane((int)(threadIdx.x >> 8)) * 65536;
  cg::grid_group grid = cg::this_grid();
  if (threadIdx.x == 0) *(uint4*)(dsm + SMEM_BYTES) = make_uint4(0u, 0u, 0u, 0u);
  __syncthreads();
  XcdBarrier xb = xcd_barrier_post(p.bar, (volatile LAS unsigned*)(dsm + SMEM_BYTES));
  const int lo = p.phase_lo, hi = p.phase_hi;
  if (hi > 1000) grid.sync();
#define GRID_SYNC() xcd_barrier(xb)
#define RUN_PHASE(PH, CALL) { const int ph_ = (PH); if (ph_ >= lo && ph_ < hi) { CALL; if (ph_ + 1 < hi) GRID_SYNC(); } }
#define RUN_PHASE_REP(PID, PH, CALL) { RUN_PHASE(PH, CALL); if (PROBE == (PID)) { RUN_PHASE(PH, CALL); } }
  RUN_PHASE_REP(1, 0, phase0(p, hsm));
#pragma unroll 1
  for (int l = 0; l < 4; ++l) {
    RUN_PHASE_REP(2, 1 + l * 6, phaseN(p, l));
    RUN_PHASE_REP(3, 2 + l * 6, phaseA(p, l, smem));
    RUN_PHASE_REP(4, 3 + l * 6, phaseB(p, l, hsm));
    RUN_PHASE_REP(5, 4 + l * 6, phaseB2(p, l, hsm));
    RUN_PHASE_REP(6, 5 + l * 6, phaseC1(p, l, smem));
    RUN_PHASE(6 + l * 6, phaseC2(p, l, smem));
    if (PROBE == 7) { for (int e = 0; e < 6; ++e) GRID_SYNC(); }
  }
  RUN_PHASE(25, phaseF(p));
}

extern "C" void kernel_launch(void* const* d_in, const int* in_sizes, int n_in, void* d_out, int out_size, void* d_ws,
                              size_t ws_size, hipStream_t stream) {
  static int grid_blocks = 0;
  if (!grid_blocks) {
    int dev = 0, cus = 0, per_cu = 0;
    hipGetDevice(&dev);
    hipDeviceGetAttribute(&cus, hipDeviceAttributeMultiprocessorCount, dev);
    hipFuncSetAttribute((const void*)mega, hipFuncAttributeMaxDynamicSharedMemorySize, DYN_LDS);
    hipOccupancyMaxActiveBlocksPerMultiprocessor(&per_cu, mega, NTHREADS, DYN_LDS);
    if (per_cu > 1) per_cu = 1;
    if (per_cu < 1) per_cu = 1;
    grid_blocks = cus * per_cu;
  }
  Params p;
  memset(&p, 0, sizeof(p));
  const float** fp = (const float**)&p;
  for (int i = 0; i < 25; ++i) fp[i] = (const float*)d_in[i];
  p.out = (float*)d_out;
  char* w = (char*)d_ws;
  size_t off = 0;
  auto take = [&](size_t bytes) { char* r = w + off; off += (bytes + 255) & ~(size_t)255; return r; };
  p.wt_in = (u16*)take((size_t)4 * 8192 * 1024 * 2);
  p.wt_br = (u16*)take((size_t)4 * 3 * 1024 * 512 * 2);
  p.wt_out = (u16*)take((size_t)4 * 1024 * 1024 * 2);
  p.wgT = (u16*)take((size_t)128 * 4096 * 2);
  p.ckb = (u16*)take((size_t)2 * 4 * 256 * 512 * 2);
  p.cvT = (u16*)take((size_t)2 * 4 * 256 * 512 * 2);
  p.xm = (u16*)take((size_t)8192 * 1024 * 2);
  p.P = (u16*)take((size_t)8192 * 8192 * 2);
  p.Vt = (u16*)take((size_t)512 * 8192 * 2);
  p.Ana = (u16*)take((size_t)8192 * 512 * 2);
  p.Alru = (u16*)take((size_t)8192 * 512 * 2);
  p.Aconv = (u16*)take((size_t)8192 * 512 * 2);
  p.merged = (u16*)take((size_t)8192 * 1024 * 2);
  p.hloc = (u16*)take((size_t)2 * 8192 * 512 * 2);
  p.acum = (u16*)take((size_t)2 * 8192 * 512 * 2);
  p.mod = (float*)take((size_t)4 * 3 * 3072 * 4);
  p.xbuf = (float*)take((size_t)8192 * 1024 * 4);
  p.Atot = (float*)take((size_t)128 * 2 * 512 * 4);
  p.Htot = (float*)take((size_t)128 * 2 * 512 * 4);
  p.sp8 = (float*)take((size_t)4096 * 4);
  p.bar = (unsigned*)take((size_t)XCD_BAR_WORDS * 4);
  if (off > ws_size) { fprintf(stderr, "workspace too small: need %zu have %zu\n", off, ws_size); return; }
#ifdef MULTI_LAUNCH
  for (int ph = 0; ph < 26; ++ph) {
    p.phase_lo = ph; p.phase_hi = ph + 1;
    hipLaunchKernelGGL(mega, dim3(grid_blocks), dim3(NTHREADS), DYN_LDS, stream, p);
  }
#else
  p.phase_lo = 0; p.phase_hi = 26;
  hipMemsetAsync(p.bar, 0, (size_t)XCD_BAR_WORDS * 4, stream);
  void* args[] = {&p};
  hipError_t e = hipLaunchCooperativeKernel((void*)mega, dim3(grid_blocks), dim3(NTHREADS), args, DYN_LDS, stream);
  if (e != hipSuccess) fprintf(stderr, "cooperative launch failed: %s (grid %d)\n", hipGetErrorString(e), grid_blocks);
#endif
}
```

```cpp
#include <hip/hip_runtime.h>
#include <hip/hip_cooperative_groups.h>
#include <cstdio>
#include <cstring>
namespace cg = cooperative_groups;

typedef unsigned short u16;
using bf16x8 = __attribute__((ext_vector_type(8))) short;
using f32x4 = __attribute__((ext_vector_type(4))) float;
using u32x4 = __attribute__((ext_vector_type(4))) unsigned;

#define NTHREADS 512
#define SMEM_BYTES 131072
#define DYN_LDS (SMEM_BYTES + 64)

struct Params {
  const float *x_prompt, *x_sample, *cache_k, *cache_v, *state_lru, *c, *c_ctx, *norm_g, *w_mod, *b_mod,
      *w_in, *na_rpb, *lru_conv_w, *lru_conv_b, *lru_wa, *lru_ba, *lru_wx, *lru_bx, *lru_lam, *conv_w,
      *w_br_na, *w_br_lru, *w_br_conv, *w_out, *final_g;
  float* out;
  u16 *wt_in, *wt_br, *wt_out, *wgT, *ckb, *cvT, *xm, *P, *Vt, *Ana, *Alru, *Aconv, *merged, *hloc, *acum;
  float *mod, *xbuf, *Atot, *Htot, *sp8;
  unsigned* bar;
  int phase_lo, phase_hi;
};

__device__ __forceinline__ int otid() { int t = threadIdx.x & 255; asm volatile("" : "+v"(t)); return t; }
__device__ __forceinline__ int otid512() { int t = threadIdx.x; asm volatile("" : "+v"(t)); return t; }
__device__ __forceinline__ int vbid() { return blockIdx.x * 2 + __builtin_amdgcn_readfirstlane((int)(threadIdx.x >> 8)); }
#define NVB ((int)gridDim.x * 2)
__device__ __forceinline__ unsigned f2bf(float f) {
  unsigned u = __float_as_uint(f);
  u += 0x7fffu + ((u >> 16) & 1u);
  return u >> 16;
}
__device__ __forceinline__ float bf2f(unsigned h) { return __uint_as_float(h << 16); }
__device__ __forceinline__ unsigned pack2(float a, float b) { return f2bf(a) | (f2bf(b) << 16); }
__device__ __forceinline__ float sigm(float x) { return __builtin_amdgcn_rcpf(1.f + __expf(-x)); }
__device__ __forceinline__ float silu(float x) { return x * __builtin_amdgcn_rcpf(1.f + __expf(-x)); }
__device__ __forceinline__ float lo16(unsigned w) { return __uint_as_float(w << 16); }
__device__ __forceinline__ float hi16(unsigned w) { return __uint_as_float(w & 0xffff0000u); }

__device__ void transpose_unit(const float* __restrict__ src, int N, u16* __restrict__ dst, int K, int k0, int n0,
                               float* sm) {
  const int tid = otid();
#pragma unroll
  for (int i = 0; i < 4; ++i) {
    int r = (tid >> 4) + i * 16, c4 = (tid & 15) * 4;
    float4 v = *(const float4*)(src + (size_t)(k0 + r) * N + n0 + c4);
    sm[r * 65 + c4 + 0] = v.x; sm[r * 65 + c4 + 1] = v.y; sm[r * 65 + c4 + 2] = v.z; sm[r * 65 + c4 + 3] = v.w;
  }
  __syncthreads();
  const int n = tid >> 2, kq = (tid & 3) * 16;
  unsigned w[8];
#pragma unroll
  for (int kk = 0; kk < 8; ++kk) w[kk] = pack2(sm[(kq + 2 * kk) * 65 + n], sm[(kq + 2 * kk + 1) * 65 + n]);
  uint4* d = (uint4*)(dst + (size_t)(n0 + n) * K + k0 + kq);
  d[0] = make_uint4(w[0], w[1], w[2], w[3]);
  d[1] = make_uint4(w[4], w[5], w[6], w[7]);
  __syncthreads();
}

__device__ void phase0(const Params& p, char* smem) {
  float* sm = (float*)smem;
  const int tid = otid();
  const int NU = 384 + 8192 + 1536 + 1024 + 512 + 512 + 128 + 2048;
  for (int u = vbid(); u < NU; u += NVB) {
    int v = u;
    if (v < 384) {
      int l = v / 96, cgp = v % 96;
      int c = cgp * 32 + (tid & 31), kg = tid >> 5;
      float a0 = 0.f, a1 = 0.f, a2 = 0.f;
      const float* w = p.w_mod + (size_t)l * 1024 * 3072 + c;
      for (int k = kg * 128; k < kg * 128 + 128; ++k) {
        float wv = w[(size_t)k * 3072];
        a0 += silu(p.c_ctx[k]) * wv; a1 += silu(p.c[k]) * wv; a2 += silu(p.c[1024 + k]) * wv;
      }
      sm[(kg * 3 + 0) * 32 + (tid & 31)] = a0;
      sm[(kg * 3 + 1) * 32 + (tid & 31)] = a1;
      sm[(kg * 3 + 2) * 32 + (tid & 31)] = a2;
      __syncthreads();
      if (tid < 96) {
        int cond = tid >> 5, cc = tid & 31;
        float s = p.b_mod[l * 3072 + cgp * 32 + cc];
#pragma unroll
        for (int g = 0; g < 8; ++g) s += sm[(g * 3 + cond) * 32 + cc];
        p.mod[(size_t)(l * 3 + cond) * 3072 + cgp * 32 + cc] = s;
      }
      __syncthreads();
      continue;
    }
    v -= 384;
    if (v < 8192) {
      int l = v >> 11, r = v & 2047, kt = r >> 7, nt = r & 127;
      transpose_unit(p.w_in + (size_t)l * 1024 * 8192, 8192, p.wt_in + (size_t)l * 8192 * 1024, 1024, kt * 64, nt * 64, sm);
      continue;
    }
    v -= 8192;
    if (v < 1536) {
      int l = v / 384, r = v % 384, br = r >> 7, q = r & 127, kt = q >> 4, nt = q & 15;
      u16* dst = p.wt_br + (size_t)(l * 3 + br) * 1024 * 512;
      if (br == 0) transpose_unit(p.w_br_na + (size_t)l * 512 * 1024, 1024, dst, 512, kt * 64, nt * 64, sm);
      else if (br == 1) transpose_unit(p.w_br_lru + (size_t)l * 512 * 1024, 1024, dst, 512, kt * 64, nt * 64, sm);
      else transpose_unit(p.w_br_conv + (size_t)l * 512 * 1024, 1024, dst, 512, kt * 64, nt * 64, sm);
      continue;
    }
    v -= 1536;
    if (v < 1024) {
      int l = v >> 8, r = v & 255, kt = r >> 4, nt = r & 15;
      transpose_unit(p.w_out + (size_t)l * 1024 * 1024, 1024, p.wt_out + (size_t)l * 1024 * 1024, 1024, kt * 64, nt * 64, sm);
      continue;
    }
    v -= 1024;
    if (v < 512) {
      size_t idx = ((size_t)v * 256 + tid) * 8;
      float4 a = *(const float4*)(p.cache_k + idx), b = *(const float4*)(p.cache_k + idx + 4);
      *(uint4*)(p.ckb + idx) = make_uint4(pack2(a.x, a.y), pack2(a.z, a.w), pack2(b.x, b.y), pack2(b.z, b.w));
      continue;
    }
    v -= 512;
    if (v < 512) {
      int g = v * 256 + tid;
      int d = g & 63, h = (g >> 6) & 7, kg = (g >> 9) & 31, bl = g >> 14;
      float f[8];
#pragma unroll
      for (int j = 0; j < 8; ++j) f[j] = p.cache_v[((size_t)(bl * 256 + kg * 8 + j) * 8 + h) * 64 + d];
      *(uint4*)(p.cvT + ((size_t)(bl * 8 + h) * 64 + d) * 256 + kg * 8) =
          make_uint4(pack2(f[0], f[1]), pack2(f[2], f[3]), pack2(f[4], f[5]), pack2(f[6], f[7]));
      continue;
    }
    v -= 512;
    if (v >= 128) {
      v -= 128;
      const size_t o = ((size_t)(v & 1023) * 256 + tid) * 16;
      if (v < 1024) {
#pragma unroll
        for (int i = 0; i < 4; ++i) *(float4*)(p.xbuf + o + i * 4) = *(const float4*)(p.x_prompt + o + i * 4);
      } else {
#pragma unroll
        for (int i = 0; i < 4; ++i) *(float4*)(p.xbuf + 4194304 + o + i * 4) = *(const float4*)(p.x_sample + o + i * 4);
      }
      continue;
    }
    {
      int blk = v & 7, gate = (v >> 3) & 1, dir = (v >> 4) & 1, l = v >> 5;
      if (v == 0) {
        for (int i = tid; i < 4096; i += 256) p.sp8[i] = 8.f * log1pf(expf(-p.lru_lam[i]));
      }
      const size_t so = (size_t)((l * 2 + dir) * 8 + blk) * 4096;
      u16* dst = p.wgT + (size_t)v * 4096;
      for (int idx = tid; idx < 4096; idx += 256) {
        int k = idx >> 6, j = idx & 63;
        float wv;
        if (gate) wv = p.lru_wx[so + j * 64 + k]; else wv = p.lru_wa[so + j * 64 + k];
        dst[idx] = (u16)f2bf(wv);
      }
    }
  }
}

__device__ __forceinline__ const float* xrow(const Params& p, int l, int t) {
  return p.xbuf + (size_t)t * 1024;
}
__device__ __forceinline__ float wave_sum(float v) {
#pragma unroll
  for (int o = 32; o >= 1; o >>= 1) v += __shfl_xor(v, o);
  return v;
}

__device__ void phaseN(const Params& p, int l) {
  const int lane = otid() & 63, wave = otid() >> 6;
  const float* g = p.norm_g + l * 1024;
  for (int t = vbid() * 4 + wave; t < 8192; t += NVB * 4) {
    const float* x = xrow(p, l, t);
    float4 v[4];
    float ss = 0.f;
#pragma unroll
    for (int i = 0; i < 4; ++i) {
      v[i] = *(const float4*)(x + i * 256 + lane * 4);
      ss += v[i].x * v[i].x + v[i].y * v[i].y + v[i].z * v[i].z + v[i].w * v[i].w;
    }
    ss = wave_sum(ss);
    float rstd = rsqrtf(ss * (1.f / 1024.f) + 1e-6f);
    int cid = t < 4096 ? 0 : 1 + ((t - 4096) >> 11);
    const float* md = p.mod + (size_t)(l * 3 + cid) * 3072;
#pragma unroll
    for (int i = 0; i < 4; ++i) {
      int c = i * 256 + lane * 4;
      float4 gg = *(const float4*)(g + c), sh = *(const float4*)(md + c), sc = *(const float4*)(md + 1024 + c);
      float y0 = v[i].x * rstd * gg.x * (1.f + sc.x) + sh.x;
      float y1 = v[i].y * rstd * gg.y * (1.f + sc.y) + sh.y;
      float y2 = v[i].z * rstd * gg.z * (1.f + sc.z) + sh.z;
      float y3 = v[i].w * rstd * gg.w * (1.f + sc.w) + sh.w;
      *(uint2*)(p.xm + (size_t)t * 1024 + c) = make_uint2(pack2(y0, y1), pack2(y2, y3));
    }
  }
}

__device__ void phaseF(const Params& p) {
  const int lane = otid() & 63, wave = otid() >> 6;
  for (int t = vbid() * 4 + wave; t < 8192; t += NVB * 4) {
    const float* x = p.xbuf + (size_t)t * 1024;
    float4 v[4];
    float ss = 0.f;
#pragma unroll
    for (int i = 0; i < 4; ++i) {
      v[i] = *(const float4*)(x + i * 256 + lane * 4);
      ss += v[i].x * v[i].x + v[i].y * v[i].y + v[i].z * v[i].z + v[i].w * v[i].w;
    }
    ss = wave_sum(ss);
    float rstd = rsqrtf(ss * (1.f / 1024.f) + 1e-6f);
#pragma unroll
    for (int i = 0; i < 4; ++i) {
      int c = i * 256 + lane * 4;
      float4 gg = *(const float4*)(p.final_g + c);
      *(float4*)(p.out + (size_t)t * 1024 + c) =
          make_float4(v[i].x * rstd * gg.x, v[i].y * rstd * gg.y, v[i].z * rstd * gg.z, v[i].w * rstd * gg.w);
    }
  }
}

__device__ __forceinline__ int perm64(int r) { return (r & 0x43) | ((r & 0x30) >> 2) | ((r & 0x0c) << 2); }

template <int MI, int NJ, int WM, int WN, bool SWAP, bool PERM_A, bool PERM_B>
__device__ __forceinline__ void gemm_mainloop(const u16* __restrict__ A, int lda, const u16* __restrict__ B, int ldb,
                                              int K, f32x4 (&acc)[MI][NJ], char* smem) {
  constexpr int AR = WM * MI * 16, BR = WN * NJ * 16;
  constexpr int A_BYTES = AR * 128, STAGE = (AR + BR) * 128;
  const int tid = otid512(), lane = tid & 63, wave = tid >> 6;
  const int wm = wave / WN, wn = wave % WN, fr = lane & 15, fq = lane >> 4;
  const int lr = tid >> 3, lc = (tid & 7) ^ ((lr >> 1) & 7);
  const u16* ag = A + (size_t)(PERM_A ? perm64(lr) : lr) * lda + lc * 8;
  const u16* bg = B + (size_t)(PERM_B ? perm64(lr) : lr) * ldb + lc * 8;
  char* sA = smem + tid * 16;
  char* sB = smem + A_BYTES + tid * 16;
#define GLDS(gp, lp) __builtin_amdgcn_global_load_lds((const unsigned*)(gp), (unsigned*)(lp), 16, 0, 0)
#pragma unroll
  for (int i = 0; i < AR / 64; ++i) GLDS(ag + (size_t)i * 64 * lda, sA + i * 8192);
#pragma unroll
  for (int i = 0; i < BR / 64; ++i) GLDS(bg + (size_t)i * 64 * ldb, sB + i * 8192);
  asm volatile("s_waitcnt vmcnt(0)" ::: "memory");
  __syncthreads();
  const int swz_r = (fr >> 1) & 7;
  const int aoff = (wm * MI * 16 + fr) * 128, boff = A_BYTES + (wn * NJ * 16 + fr) * 128;
  const int nk = K >> 6;
  for (int kt = 0; kt < nk; ++kt) {
    const int cur = kt & 1;
    if (kt + 1 < nk) {
#pragma unroll
      for (int i = 0; i < AR / 64; ++i) GLDS(ag + (size_t)i * 64 * lda + (kt + 1) * 64, sA + (cur ^ 1) * STAGE + i * 8192);
#pragma unroll
      for (int i = 0; i < BR / 64; ++i) GLDS(bg + (size_t)i * 64 * ldb + (kt + 1) * 64, sB + (cur ^ 1) * STAGE + i * 8192);
    }
    const char* cA = smem + cur * STAGE + aoff;
    const char* cB = smem + cur * STAGE + boff;
#pragma unroll
    for (int ks = 0; ks < 2; ++ks) {
      bf16x8 af[MI], bfr[NJ];
      const int ch = ((ks * 4 + fq) ^ swz_r) << 4;
#pragma unroll
      for (int j = 0; j < NJ; ++j) bfr[j] = *(const bf16x8*)(cB + j * 2048 + ch);
#pragma unroll
      for (int i = 0; i < MI; ++i) af[i] = *(const bf16x8*)(cA + i * 2048 + ch);
#pragma unroll
      for (int i = 0; i < MI; ++i)
#pragma unroll
        for (int j = 0; j < NJ; ++j) {
          if (SWAP) acc[i][j] = __builtin_amdgcn_mfma_f32_16x16x32_bf16(bfr[j], af[i], acc[i][j], 0, 0, 0);
          else acc[i][j] = __builtin_amdgcn_mfma_f32_16x16x32_bf16(af[i], bfr[j], acc[i][j], 0, 0, 0);
        }
    }
    asm volatile("s_waitcnt vmcnt(0)" ::: "memory");
    __syncthreads();
  }
#undef GLDS
}

template <int MI, int NJ>
__device__ __forceinline__ void zero_acc(f32x4 (&acc)[MI][NJ]) {
#pragma unroll
  for (int i = 0; i < MI; ++i)
#pragma unroll
    for (int j = 0; j < NJ; ++j) acc[i][j] = f32x4{0.f, 0.f, 0.f, 0.f};
}

__device__ void phaseA(const Params& p, int l, char* smem) {
  const int tid = otid512(), lane = tid & 63, wave = tid >> 6;
  const int wm = wave >> 2, wn = wave & 3, fr = lane & 15, fq = lane >> 4;
  const u16* W = p.wt_in + (size_t)l * 8192 * 1024;
  float* newk = p.out + 8388608;
  float* newv = p.out + 16777216;
  for (int id = blockIdx.x; id < 1024; id += gridDim.x) {
    const int xcd = id & 7, j_ = id >> 3;
    const int mt = xcd * 4 + (j_ & 3), nt = (j_ >> 5) * 8 + ((j_ >> 2) & 7);
    const int m0 = mt * 256, n0 = nt * 256;
    f32x4 acc[8][4];
    zero_acc<8, 4>(acc);
    const u16* A = p.xm + (size_t)m0 * 1024;
    const u16* B = W + (size_t)n0 * 1024;
    if (n0 >= 1024 && n0 < 1536) {
      gemm_mainloop<8, 4, 2, 4, false, true, false>(A, 1024, B, 1024, 1024, acc, smem);
#pragma unroll
      for (int g = 0; g < 2; ++g)
#pragma unroll
        for (int j = 0; j < 4; ++j) {
          const int tok0 = m0 + wm * 128 + g * 64 + fq * 16;
          const int vc = n0 + wn * 64 + j * 16 + fr - 1024;
          uint4 w0 = make_uint4(pack2(acc[g * 4 + 0][j][0], acc[g * 4 + 0][j][1]), pack2(acc[g * 4 + 0][j][2], acc[g * 4 + 0][j][3]),
                                pack2(acc[g * 4 + 1][j][0], acc[g * 4 + 1][j][1]), pack2(acc[g * 4 + 1][j][2], acc[g * 4 + 1][j][3]));
          uint4 w1 = make_uint4(pack2(acc[g * 4 + 2][j][0], acc[g * 4 + 2][j][1]), pack2(acc[g * 4 + 2][j][2], acc[g * 4 + 2][j][3]),
                                pack2(acc[g * 4 + 3][j][0], acc[g * 4 + 3][j][1]), pack2(acc[g * 4 + 3][j][2], acc[g * 4 + 3][j][3]));
          *(uint4*)(p.Vt + (size_t)vc * 8192 + tok0) = w0;
          *(uint4*)(p.Vt + (size_t)vc * 8192 + tok0 + 8) = w1;
          if (tok0 < 4096) {
#pragma unroll
            for (int i4 = 0; i4 < 4; ++i4)
#pragma unroll
              for (int jj = 0; jj < 4; ++jj) {
                const int t = tok0 + i4 * 4 + jj;
                newv[((size_t)((t >> 8) * 4 + l) * 256 + (t & 255)) * 512 + vc] = acc[g * 4 + i4][j][jj];
              }
          }
        }
    } else {
      gemm_mainloop<8, 4, 2, 4, true, false, true>(A, 1024, B, 1024, 1024, acc, smem);
      const bool isK = (n0 >= 512 && n0 < 1024);
#pragma unroll
      for (int i = 0; i < 8; ++i) {
        const int t = m0 + wm * 128 + i * 16 + fr;
        const int col = n0 + wn * 64 + fq * 16;
        uint4 w0 = make_uint4(pack2(acc[i][0][0], acc[i][0][1]), pack2(acc[i][0][2], acc[i][0][3]),
                              pack2(acc[i][1][0], acc[i][1][1]), pack2(acc[i][1][2], acc[i][1][3]));
        uint4 w1 = make_uint4(pack2(acc[i][2][0], acc[i][2][1]), pack2(acc[i][2][2], acc[i][2][3]),
                              pack2(acc[i][3][0], acc[i][3][1]), pack2(acc[i][3][2], acc[i][3][3]));
        *(uint4*)(p.P + (size_t)t * 8192 + col) = w0;
        *(uint4*)(p.P + (size_t)t * 8192 + col + 8) = w1;
        if (isK && t < 4096) {
          float* dst = newk + ((size_t)((t >> 8) * 4 + l) * 256 + (t & 255)) * 512 + (col - 512);
#pragma unroll
          for (int j = 0; j < 4; ++j) *(float4*)(dst + j * 4) = make_float4(acc[i][j][0], acc[i][j][1], acc[i][j][2], acc[i][j][3]);
        }
      }
    }
  }
}

__device__ __forceinline__ bf16x8 ld16(const u16* ptr) { return *(const bf16x8*)ptr; }

__device__ void attn_unit(const Params& p, int l, int unit, char* smem) {
  const int lane = otid() & 63, fr = lane & 15, fq = lane >> 4;
  const bool lat = unit >= 2048;
  int b, h, qtok0, r = 0, n = 0, row0 = 0, band0 = 0;
  if (!lat) {
    b = unit >> 7; h = (unit >> 4) & 7;
    qtok0 = b * 256 + (unit & 15) * 16;
  } else {
    int u = unit - 2048;
    b = u >> 10; r = (u >> 5) & 31; n = (u >> 3) & 3; h = u & 7;
    qtok0 = 4096 + b * 2048 + r * 64 + n * 16;
    row0 = min(max(r - 4, 0), 24);
    band0 = min(max(16 * n - 8, 0), 32);
  }
  const u16* qp = p.P + (size_t)(qtok0 + fr) * 8192 + h * 64 + fq * 8;
  const bf16x8 q0 = ld16(qp), q1 = ld16(qp + 32);
  f32x4 o[4];
#pragma unroll
  for (int dt = 0; dt < 4; ++dt) o[dt] = f32x4{0.f, 0.f, 0.f, 0.f};
  float m = -1e30f, lsum = 0.f;
  float* rpb = (float*)(smem + 57344 + __builtin_amdgcn_readfirstlane(otid() >> 6) * 2048);
  if (lat) {
    const float* rg = p.na_rpb + (size_t)(l * 8 + h) * 15 * 31;
#pragma unroll
    for (int i = 0; i < 8; ++i) {
      const int idx = lane + 64 * i;
      if (idx < 465) rpb[idx] = rg[idx];
    }
    asm volatile("s_waitcnt vmcnt(0) lgkmcnt(0)" ::: "memory");
  }
  const int qc = 16 * n + fr;
  const int wst = min(max(qc - 8, 0), 48);
  const int nchunks = lat ? 8 : 4;
  const u16 *kb, *vb;
  int kstride, kslab, vstride, vslab;
#define CHUNK_PTRS(c)                                                                                          \
  if (!lat) {                                                                                                  \
    const size_t key0 = (size_t)b * 256 + (c) * 64;                                                            \
    kb = p.P + key0 * 8192 + 512 + h * 64; kstride = 8192; kslab = 32 * 8192;                                  \
    vb = p.Vt + (size_t)(h * 64) * 8192 + key0; vstride = 8192; vslab = 32;                                    \
  } else if ((c) < 4) {                                                                                        \
    const size_t tok = 4096 + (size_t)b * 2048 + (row0 + (c) * 2) * 64 + band0;                                \
    kb = p.P + tok * 8192 + 512 + h * 64; kstride = 8192; kslab = 64 * 8192;                                   \
    vb = p.Vt + (size_t)(h * 64) * 8192 + tok; vstride = 8192; vslab = 64;                                     \
  } else {                                                                                                     \
    kb = p.ckb + ((size_t)(b * 4 + l) * 256 + ((c) - 4) * 64) * 512 + h * 64; kstride = 512; kslab = 32 * 512; \
    vb = p.cvT + (size_t)((b * 4 + l) * 8 + h) * 64 * 256 + ((c) - 4) * 64; vstride = 256; vslab = 32;         \
  }
  bf16x8 kf[8];
  CHUNK_PTRS(0);
#pragma unroll
  for (int mt = 0; mt < 4; ++mt) {
    const u16* kp = kb + (size_t)(mt >> 1) * kslab + (size_t)((fr >> 2) * 8 + (mt & 1) * 4 + (fr & 3)) * kstride + fq * 8;
    kf[2 * mt] = ld16(kp); kf[2 * mt + 1] = ld16(kp + 32);
  }
#pragma unroll 1
  for (int c = 0; c < nchunks; ++c) {
    const bool local = lat && c < 4;
    bf16x8 vf[8];
#pragma unroll
    for (int sl = 0; sl < 2; ++sl)
#pragma unroll
      for (int dt = 0; dt < 4; ++dt) vf[sl * 4 + dt] = ld16(vb + sl * vslab + (size_t)(dt * 16 + fr) * vstride + fq * 8);
    float bs[16];
    if (local) {
#pragma unroll
      for (int mt = 0; mt < 4; ++mt) {
        const int row_off = row0 + c * 2 + (mt >> 1) - r + 7;
#pragma unroll
        for (int jj = 0; jj < 4; ++jj) {
          const int kc = band0 + fq * 8 + (mt & 1) * 4 + jj;
          const int col_off = min(max(kc - qc, -15), 15) + 15;
          bs[mt * 4 + jj] = rpb[row_off * 31 + col_off];
        }
      }
    } else {
#pragma unroll
      for (int e = 0; e < 16; ++e) bs[e] = 0.f;
    }
    __builtin_amdgcn_sched_barrier(0);
    f32x4 s[4];
#pragma unroll
    for (int mt = 0; mt < 4; ++mt) {
      f32x4 z = f32x4{0.f, 0.f, 0.f, 0.f};
      z = __builtin_amdgcn_mfma_f32_16x16x32_bf16(kf[2 * mt], q0, z, 0, 0, 0);
      s[mt] = __builtin_amdgcn_mfma_f32_16x16x32_bf16(kf[2 * mt + 1], q1, z, 0, 0, 0);
    }
    __builtin_amdgcn_sched_barrier(0);
    if (c + 1 < nchunks) {
      CHUNK_PTRS(c + 1);
#pragma unroll
      for (int mt = 0; mt < 4; ++mt) {
        const u16* kp = kb + (size_t)(mt >> 1) * kslab + (size_t)((fr >> 2) * 8 + (mt & 1) * 4 + (fr & 3)) * kstride + fq * 8;
        kf[2 * mt] = ld16(kp); kf[2 * mt + 1] = ld16(kp + 32);
      }
    }
    __builtin_amdgcn_sched_barrier(0);
    float cmax = -1e30f;
#pragma unroll
    for (int mt = 0; mt < 4; ++mt)
#pragma unroll
      for (int jj = 0; jj < 4; ++jj) {
        float v = s[mt][jj] * 0.125f + bs[mt * 4 + jj];
        const int kc = band0 + fq * 8 + (mt & 1) * 4 + jj;
        const bool valid = !local || ((kc >= wst) && (kc < wst + 16));
        v = valid ? v : -1e30f;
        s[mt][jj] = v;
        cmax = fmaxf(cmax, v);
      }
    cmax = fmaxf(cmax, __shfl_xor(cmax, 16));
    cmax = fmaxf(cmax, __shfl_xor(cmax, 32));
    const float mnew = fmaxf(m, cmax);
    const float alpha = __expf(m - mnew);
    m = mnew;
    lsum *= alpha;
#pragma unroll
    for (int dt = 0; dt < 4; ++dt) o[dt] *= alpha;
#pragma unroll
    for (int mt = 0; mt < 4; ++mt)
#pragma unroll
      for (int jj = 0; jj < 4; ++jj) {
        float pv = __expf(s[mt][jj] - m);
        lsum += pv;
        s[mt][jj] = pv;
      }
#pragma unroll
    for (int sl = 0; sl < 2; ++sl) {
      u32x4 pw = {pack2(s[2 * sl][0], s[2 * sl][1]), pack2(s[2 * sl][2], s[2 * sl][3]),
                  pack2(s[2 * sl + 1][0], s[2 * sl + 1][1]), pack2(s[2 * sl + 1][2], s[2 * sl + 1][3])};
      bf16x8 pb = __builtin_bit_cast(bf16x8, pw);
#pragma unroll
      for (int dt = 0; dt < 4; ++dt) {
        o[dt] = __builtin_amdgcn_mfma_f32_16x16x32_bf16(vf[sl * 4 + dt], pb, o[dt], 0, 0, 0);
      }
    }
  }
#undef CHUNK_PTRS
  lsum += __shfl_xor(lsum, 16);
  lsum += __shfl_xor(lsum, 32);
  const float inv = 1.f / lsum;
  const size_t t = qtok0 + fr;
#pragma unroll
  for (int dt = 0; dt < 4; ++dt) {
    int d0 = h * 64 + dt * 16 + fq * 4;
    uint2 g = *(const uint2*)(p.P + t * 8192 + 1536 + d0);
    float y0 = o[dt][0] * inv * silu(lo16(g.x)), y1 = o[dt][1] * inv * silu(hi16(g.x));
    float y2 = o[dt][2] * inv * silu(lo16(g.y)), y3 = o[dt][3] * inv * silu(hi16(g.y));
    *(uint2*)(p.Ana + t * 512 + d0) = make_uint2(pack2(y0, y1), pack2(y2, y3));
  }
}

__device__ void lru_unit(const Params& p, int l, int unit, char* smem) {
  const int tid = otid(), lane = tid & 63, wave = tid >> 6, fr = lane & 15, fq = lane >> 4;
  const int blk = unit & 7, dir = (unit >> 3) & 1, cs = unit >> 4;
  const int t0 = cs * 64;
  int seq_lo, seq_hi;
  if (cs < 64) { seq_lo = (cs >> 2) * 256; seq_hi = seq_lo + 256; }
  else { seq_lo = 4096 + ((cs - 64) >> 5) * 2048; seq_hi = seq_lo + 2048; }
  u16* uraw = (u16*)smem;
  u16* udb = (u16*)(smem + 8704);
  float* sa = (float*)(smem + 8704 + 9216);
  float* sb = sa + 4096;
  float* stot = sb + 4096;
  const int wbase = dir ? t0 : t0 - 3;
#pragma unroll
  for (int i = 0; i < 3; ++i) {
    int row = (tid >> 3) + i * 32, ch8 = tid & 7;
    if (row < 67) {
      int t = wbase + row;
      uint4 v = make_uint4(0, 0, 0, 0);
      if (t >= seq_lo && t < seq_hi) v = *(const uint4*)(p.P + (size_t)t * 8192 + 2048 + blk * 64 + ch8 * 8);
      *(uint4*)(uraw + row * 64 + ch8 * 8) = v;
    }
  }
  __syncthreads();
  {
    const int ch = tid & 63, tg = tid >> 6;
    const int cw = blk * 64 + ch;
    const float* cwp = p.lru_conv_w + (size_t)((l * 2 + dir) * 4) * 512 + cw;
    const float w0 = cwp[0], w1 = cwp[512], w2 = cwp[1024], w3 = cwp[1536];
    const float cb = p.lru_conv_b[(l * 2 + dir) * 512 + cw];
    float uw[19];
#pragma unroll
    for (int q = 0; q < 19; ++q) uw[q] = bf2f(uraw[(tg * 16 + q) * 64 + ch]);
#pragma unroll
    for (int q = 0; q < 16; ++q) {
      const int t = tg * 16 + q;
      float ud = cb + w0 * uw[q] + w1 * uw[q + 1] + w2 * uw[q + 2] + w3 * uw[q + 3];
      sb[t * 64 + ch] = ud;
      udb[t * 72 + ch] = (u16)f2bf(ud);
    }
  }
  __syncthreads();
  {
    f32x4 ar[4], ai[4];
#pragma unroll
    for (int nt = 0; nt < 4; ++nt) { ar[nt] = f32x4{0.f, 0.f, 0.f, 0.f}; ai[nt] = f32x4{0.f, 0.f, 0.f, 0.f}; }
    const u16* wr = p.wgT + (size_t)(((l * 2 + dir) * 2 + 0) * 8 + blk) * 4096;
    const u16* wi = p.wgT + (size_t)(((l * 2 + dir) * 2 + 1) * 8 + blk) * 4096;
#pragma unroll
    for (int ks = 0; ks < 2; ++ks) {
      bf16x8 af = *(const bf16x8*)(udb + (wave * 16 + fr) * 72 + ks * 32 + fq * 8);
#pragma unroll
      for (int nt = 0; nt < 4; ++nt) {
        bf16x8 br = ld16(wr + (nt * 16 + fr) * 64 + ks * 32 + fq * 8);
        bf16x8 bi = ld16(wi + (nt * 16 + fr) * 64 + ks * 32 + fq * 8);
        ar[nt] = __builtin_amdgcn_mfma_f32_16x16x32_bf16(af, br, ar[nt], 0, 0, 0);
        ai[nt] = __builtin_amdgcn_mfma_f32_16x16x32_bf16(af, bi, ai[nt], 0, 0, 0);
      }
    }
#pragma unroll
    for (int nt = 0; nt < 4; ++nt) {
      const int k = nt * 16 + fr, cw = blk * 64 + k;
      const int pi = (l * 2 + dir) * 512 + cw;
      const float ba = p.lru_ba[pi], bx = p.lru_bx[pi];
      const float sp = p.sp8[pi];
#pragma unroll
      for (int jj = 0; jj < 4; ++jj) {
        const int t = wave * 16 + fq * 4 + jj;
        float rg = sigm(ar[nt][jj] + ba), ig = sigm(ai[nt][jj] + bx);
        float la = -rg * sp;
        float a = __expf(la);
        float ud = sb[t * 64 + k];
        float x2 = 2.f * la;
        float ser = -x2 * (1.f + x2 * (0.5f + x2 * (0.16666667f + x2 * (0.041666668f + x2 * (0.0083333338f + x2 * 0.0013888889f)))));
        float om = x2 > -0.5f ? ser : 1.f - a * a;
        float bb = __builtin_amdgcn_sqrtf(om) * (ig * ud);
        sa[t * 64 + k] = a;
        sb[t * 64 + k] = bb;
      }
    }
  }
  __syncthreads();
  {
    const int ch = tid & 63, sub = tid >> 6;
    float h = 0.f, ac = 1.f;
    float av[16], hv[16];
#pragma unroll
    for (int q = 0; q < 16; ++q) {
      const int pos = sub * 16 + q;
      const int t = dir ? 63 - pos : pos;
      av[q] = sa[t * 64 + ch]; hv[q] = sb[t * 64 + ch];
    }
#pragma unroll
    for (int q = 0; q < 16; ++q) {
      h = av[q] * h + hv[q];
      ac *= av[q];
      av[q] = ac; hv[q] = h;
    }
    stot[(sub * 64 + ch) * 2] = ac;
    stot[(sub * 64 + ch) * 2 + 1] = h;
    __syncthreads();
    float cA = 1.f, cH = 0.f;
    for (int s2 = 0; s2 < sub; ++s2) {
      float A2 = stot[(s2 * 64 + ch) * 2], H2 = stot[(s2 * 64 + ch) * 2 + 1];
      cH = A2 * cH + H2;
      cA *= A2;
    }
    u16* hl = p.hloc + ((size_t)dir * 8192 + t0) * 512 + blk * 64 + ch;
    u16* acp = p.acum + ((size_t)dir * 8192 + t0) * 512 + blk * 64 + ch;
    float hf = 0.f, af = 1.f;
#pragma unroll
    for (int q = 0; q < 16; ++q) {
      const int pos = sub * 16 + q;
      const int t = dir ? 63 - pos : pos;
      hf = hv[q] + av[q] * cH;
      af = av[q] * cA;
      hl[(size_t)t * 512] = (u16)f2bf(hf);
      acp[(size_t)t * 512] = (u16)f2bf(af);
    }
    if (sub == 3) {
      p.Atot[(size_t)(cs * 2 + dir) * 512 + blk * 64 + ch] = af;
      p.Htot[(size_t)(cs * 2 + dir) * 512 + blk * 64 + ch] = hf;
    }
  }
  __syncthreads();
}

__device__ void phaseB(const Params& p, int l, char* smem, int mode = 0) {
  const int wave = __builtin_amdgcn_readfirstlane(otid() >> 6);
  for (int it = vbid(); it < 3072; it += NVB) {
    if (it < 1024) { if (mode != 2) attn_unit(p, l, it * 4 + wave, smem); }
    else if (mode != 1) lru_unit(p, l, it - 1024, smem);
  }
}

__device__ __forceinline__ void unpack8(uint4 v, float (&f)[8]) {
  f[0] = lo16(v.x); f[1] = hi16(v.x); f[2] = lo16(v.y); f[3] = hi16(v.y);
  f[4] = lo16(v.z); f[5] = hi16(v.z); f[6] = lo16(v.w); f[7] = hi16(v.w);
}
__device__ void phaseB2(const Params& p, int l, char* smem) {
  const int tid = otid();
  float* scar = (float*)smem;
  float* new_state = p.out + 25165824;
  for (int u = vbid(); u < 512; u += NVB) {
    const int cs = u >> 2, quarter = u & 3;
    int first, c, nch, b, seq_lo, seq_hi;
    const bool lat = cs >= 64;
    if (!lat) { b = cs >> 2; c = cs & 3; nch = 4; first = b * 4; seq_lo = b * 256; seq_hi = seq_lo + 256; }
    else { b = (cs - 64) >> 5; c = (cs - 64) & 31; nch = 32; first = 64 + b * 32; seq_lo = 4096 + b * 2048; seq_hi = seq_lo + 2048; }
    {
      const int dir = tid >> 7, ch = quarter * 128 + (tid & 127);
      float carry = lat ? p.state_lru[(size_t)((b * 4 + l) * 2 + dir) * 512 + ch] : 0.f;
      const int nprev = dir ? (nch - 1 - c) : c;
      const int start = dir ? (nch - 1) : 0, step = dir ? -1 : 1;
      if (!lat) {
        float A_[3], H_[3];
#pragma unroll
        for (int s = 0; s < 3; ++s) {
          const int cc = min(max(start + step * s, 0), 3);
          const size_t ix = (size_t)((first + cc) * 2 + dir) * 512 + ch;
          A_[s] = p.Atot[ix]; H_[s] = p.Htot[ix];
        }
#pragma unroll
        for (int s = 0; s < 3; ++s) if (s < nprev) carry = A_[s] * carry + H_[s];
        const bool last = dir ? (c == 0) : (c == 3);
        if (last) {
          const size_t ix = (size_t)(cs * 2 + dir) * 512 + ch;
          new_state[(size_t)((b * 4 + l) * 2 + dir) * 512 + ch] = p.Atot[ix] * carry + p.Htot[ix];
        }
      } else {
        float A_[31], H_[31];
#pragma unroll
        for (int s = 0; s < 31; ++s) {
          const int cc = min(max(start + step * s, 0), 31);
          const size_t ix = (size_t)((first + cc) * 2 + dir) * 512 + ch;
          A_[s] = p.Atot[ix]; H_[s] = p.Htot[ix];
        }
#pragma unroll
        for (int s = 0; s < 31; ++s) if (s < nprev) carry = A_[s] * carry + H_[s];
      }
      scar[tid] = carry;
    }
    __syncthreads();
    {
      const int c8 = tid & 15, ch0 = quarter * 128 + c8 * 8;
      float cf[8], cb[8], w0[8], w1[8], w2[8];
#pragma unroll
      for (int e = 0; e < 8; ++e) {
        cf[e] = scar[c8 * 8 + e]; cb[e] = scar[128 + c8 * 8 + e];
        w0[e] = p.conv_w[(l * 3 + 0) * 512 + ch0 + e]; w1[e] = p.conv_w[(l * 3 + 1) * 512 + ch0 + e];
        w2[e] = p.conv_w[(l * 3 + 2) * 512 + ch0 + e];
      }
#pragma unroll 2
      for (int i = 0; i < 4; ++i) {
        const int t = cs * 64 + (tid >> 4) + i * 16;
        const u16* pr = p.P + (size_t)t * 8192 + ch0;
        const uint4 z4 = make_uint4(0u, 0u, 0u, 0u);
        uint4 hf4 = *(const uint4*)(p.hloc + (size_t)t * 512 + ch0), af4 = *(const uint4*)(p.acum + (size_t)t * 512 + ch0);
        uint4 hb4 = *(const uint4*)(p.hloc + ((size_t)8192 + t) * 512 + ch0), ab4 = *(const uint4*)(p.acum + ((size_t)8192 + t) * 512 + ch0);
        uint4 gl4 = *(const uint4*)(pr + 2560), cb4 = *(const uint4*)(pr + 3072), gc4 = *(const uint4*)(pr + 4608);
        uint4 cc1 = *(const uint4*)(pr + 3584), chh1 = *(const uint4*)(pr + 4096);
        uint4 cc0 = z4, chh0 = z4, cc2 = z4, chh2 = z4;
        if (t - 1 >= seq_lo) { cc0 = *(const uint4*)(pr - 8192 + 3584); chh0 = *(const uint4*)(pr - 8192 + 4096); }
        if (t + 1 < seq_hi) { cc2 = *(const uint4*)(pr + 8192 + 3584); chh2 = *(const uint4*)(pr + 8192 + 4096); }
        float hf[8], af[8], hb[8], ab[8], gl[8], cbv[8], gc[8], a0[8], b0[8], a1[8], b1[8], a2[8], b2[8], ol[8], oc[8];
        unpack8(hf4, hf); unpack8(af4, af); unpack8(hb4, hb); unpack8(ab4, ab); unpack8(gl4, gl); unpack8(cb4, cbv); unpack8(gc4, gc);
        unpack8(cc0, a0); unpack8(chh0, b0); unpack8(cc1, a1); unpack8(chh1, b1); unpack8(cc2, a2); unpack8(chh2, b2);
#pragma unroll
        for (int e = 0; e < 8; ++e) {
          float h = (hf[e] + af[e] * cf[e]) + (hb[e] + ab[e] * cb[e]);
          ol[e] = h * silu(gl[e]);
          float conv = w0[e] * (a0[e] * b0[e]) + w1[e] * (a1[e] * b1[e]) + w2[e] * (a2[e] * b2[e]);
          oc[e] = cbv[e] * conv * silu(gc[e]);
        }
        *(uint4*)(p.Alru + (size_t)t * 512 + ch0) = make_uint4(pack2(ol[0], ol[1]), pack2(ol[2], ol[3]), pack2(ol[4], ol[5]), pack2(ol[6], ol[7]));
        *(uint4*)(p.Aconv + (size_t)t * 512 + ch0) = make_uint4(pack2(oc[0], oc[1]), pack2(oc[2], oc[3]), pack2(oc[4], oc[5]), pack2(oc[6], oc[7]));
      }
    }
    __syncthreads();
  }
}

__device__ void phaseC1(const Params& p, int l, char* smem) {
  const int tid = otid512(), lane = tid & 63, wave = tid >> 6;
  const int wm = wave >> 1, wn = wave & 1, fr = lane & 15, fq = lane >> 4;
  for (int id = blockIdx.x; id < 256; id += gridDim.x) {
    const int xcd = id & 7, j_ = id >> 3;
    const int mt = xcd * 4 + (j_ >> 3), nt = j_ & 7;
    const int m0 = mt * 256, n0 = nt * 128;
    f32x4 tot[4][4];
    zero_acc<4, 4>(tot);
#pragma unroll 1
    for (int br = 0; br < 3; ++br) {
      f32x4 acc[4][4];
      zero_acc<4, 4>(acc);
      const u16* A = p.Ana + (size_t)br * 8192 * 512 + (size_t)m0 * 512;
      const u16* B = p.wt_br + (size_t)(l * 3 + br) * 1024 * 512 + (size_t)n0 * 512;
      gemm_mainloop<4, 4, 4, 2, true, false, true>(A, 512, B, 512, 512, acc, smem);
#pragma unroll
      for (int i = 0; i < 4; ++i) {
        const int t = m0 + wm * 64 + i * 16 + fr;
        const int col = n0 + wn * 64 + fq * 16;
        const u16* gp = p.P + (size_t)t * 8192 + 5120 + br * 1024 + col;
        uint4 g0 = *(const uint4*)gp, g1 = *(const uint4*)(gp + 8);
        tot[i][0][0] += sigm(lo16(g0.x)) * acc[i][0][0]; tot[i][0][1] += sigm(hi16(g0.x)) * acc[i][0][1];
        tot[i][0][2] += sigm(lo16(g0.y)) * acc[i][0][2]; tot[i][0][3] += sigm(hi16(g0.y)) * acc[i][0][3];
        tot[i][1][0] += sigm(lo16(g0.z)) * acc[i][1][0]; tot[i][1][1] += sigm(hi16(g0.z)) * acc[i][1][1];
        tot[i][1][2] += sigm(lo16(g0.w)) * acc[i][1][2]; tot[i][1][3] += sigm(hi16(g0.w)) * acc[i][1][3];
        tot[i][2][0] += sigm(lo16(g1.x)) * acc[i][2][0]; tot[i][2][1] += sigm(hi16(g1.x)) * acc[i][2][1];
        tot[i][2][2] += sigm(lo16(g1.y)) * acc[i][2][2]; tot[i][2][3] += sigm(hi16(g1.y)) * acc[i][2][3];
        tot[i][3][0] += sigm(lo16(g1.z)) * acc[i][3][0]; tot[i][3][1] += sigm(hi16(g1.z)) * acc[i][3][1];
        tot[i][3][2] += sigm(lo16(g1.w)) * acc[i][3][2]; tot[i][3][3] += sigm(hi16(g1.w)) * acc[i][3][3];
      }
    }
#pragma unroll
    for (int i = 0; i < 4; ++i) {
      const int t = m0 + wm * 64 + i * 16 + fr;
      const int col = n0 + wn * 64 + fq * 16;
      uint4 w0 = make_uint4(pack2(tot[i][0][0], tot[i][0][1]), pack2(tot[i][0][2], tot[i][0][3]),
                            pack2(tot[i][1][0], tot[i][1][1]), pack2(tot[i][1][2], tot[i][1][3]));
      uint4 w1 = make_uint4(pack2(tot[i][2][0], tot[i][2][1]), pack2(tot[i][2][2], tot[i][2][3]),
                            pack2(tot[i][3][0], tot[i][3][1]), pack2(tot[i][3][2], tot[i][3][3]));
      *(uint4*)(p.merged + (size_t)t * 1024 + col) = w0;
      *(uint4*)(p.merged + (size_t)t * 1024 + col + 8) = w1;
    }
  }
}

__device__ void phaseC2(const Params& p, int l, char* smem) {
  const int tid = otid512(), lane = tid & 63, wave = tid >> 6;
  const int wm = wave >> 1, wn = wave & 1, fr = lane & 15, fq = lane >> 4;
  for (int id = blockIdx.x; id < 256; id += gridDim.x) {
    const int xcd = id & 7, j_ = id >> 3;
    const int mt = xcd * 4 + (j_ >> 3), nt = j_ & 7;
    const int m0 = mt * 256, n0 = nt * 128;
    f32x4 acc[4][4];
    zero_acc<4, 4>(acc);
    gemm_mainloop<4, 4, 4, 2, true, false, true>(p.merged + (size_t)m0 * 1024, 1024,
                                                 p.wt_out + (size_t)l * 1024 * 1024 + (size_t)n0 * 1024, 1024, 1024, acc, smem);
#pragma unroll
    for (int i = 0; i < 4; ++i) {
      const int t = m0 + wm * 64 + i * 16 + fr;
      const int col = n0 + wn * 64 + fq * 16;
      const int cid = t < 4096 ? 0 : 1 + ((t - 4096) >> 11);
      const float* gt = p.mod + (size_t)(l * 3 + cid) * 3072 + 2048 + col;
      float* xr = p.xbuf + (size_t)t * 1024 + col;
#pragma unroll
      for (int j = 0; j < 4; ++j) {
        float4 g4 = *(const float4*)(gt + j * 4);
        float4 xo = *(const float4*)(xr + j * 4);
        *(float4*)(xr + j * 4) = make_float4(xo.x + g4.x * acc[i][j][0], xo.y + g4.y * acc[i][j][1],
                                             xo.z + g4.z * acc[i][j][2], xo.w + g4.w * acc[i][j][3]);
      }
    }
  }
}

#define XB_TMO      128
#define XB_XCNT(j)  (256  + 64 * (j))
#define XB_XSUB(j)  (1280 + 64 * (j))
#define XB_XGEN(j)  (2304 + 64 * (j))
#define XB_TOP      3328
#define XB_TOPGEN   3392
#define XCD_BAR_WORDS 3456
#define XB_SPIN_CAP (1u << 18)
#define LAS __attribute__((address_space(3)))
__device__ __forceinline__ unsigned xb_ld(unsigned* p) { return __hip_atomic_load(p, __ATOMIC_RELAXED, __HIP_MEMORY_SCOPE_AGENT); }
__device__ __forceinline__ unsigned xb_add(unsigned* p, unsigned v) { return __hip_atomic_fetch_add(p, v, __ATOMIC_RELAXED, __HIP_MEMORY_SCOPE_AGENT); }
__device__ __forceinline__ unsigned xb_xcc_id() { return (unsigned)__builtin_amdgcn_s_getreg((3 << 11) | 20) & 0xFu; }
#define XB_SPIN(cond, bar) do { unsigned _sp = 0; while (cond) { __builtin_amdgcn_s_sleep(1); \
    if ((++_sp & 255u) == 0u) { if (xb_ld(&(bar)[XB_TMO])) break; if (_sp > XB_SPIN_CAP) { atomicAdd(&(bar)[XB_TMO], 1u); break; } } } } while (0)
struct XcdBarrier { unsigned* bar; unsigned x; volatile LAS unsigned* st; };
__device__ __forceinline__ XcdBarrier xcd_barrier_post(unsigned* bar, volatile LAS unsigned* st) {
  XcdBarrier b; b.bar = bar; b.x = xb_xcc_id(); b.st = st;
  if (threadIdx.x == 0) (void)xb_add(&bar[XB_XCNT(b.x)], 1u);
  return b;
}
__device__ __forceinline__ void xcd_barrier_complete(unsigned* bar, unsigned x, unsigned& nloc, unsigned& nx) {
  const unsigned G = gridDim.x * gridDim.y * gridDim.z;
  unsigned sum, cnt, mine, sp = 0u;
  for (;;) {
    sum = 0u; cnt = 0u; mine = 0u;
#pragma unroll
    for (unsigned j = 0; j < 16; ++j) { const unsigned c = xb_ld(&bar[XB_XCNT(j)]); sum += c; cnt += (c > 0u) ? 1u : 0u; mine = (j == x) ? c : mine; }
    if (sum == G) break;
    __builtin_amdgcn_s_sleep(1);
    if ((++sp & 255u) == 0u) { if (xb_ld(&bar[XB_TMO])) break; if (sp > XB_SPIN_CAP) { atomicAdd(&bar[XB_TMO], 1u); break; } }
  }
  nloc = mine > 0u ? mine : 1u; nx = cnt > 0u ? cnt : 1u;
}
__device__ __forceinline__ void xcd_barrier(const XcdBarrier& b) {
  asm volatile("s_waitcnt vmcnt(0)" ::: "memory");
  __syncthreads();
  if (threadIdx.x == 0) {
    unsigned* bar = b.bar;
    __builtin_amdgcn_s_waitcnt(0);
    unsigned nloc = b.st[0], nx = b.st[1];
    if (nloc == 0u) { xcd_barrier_complete(bar, b.x, nloc, nx); b.st[0] = nloc; b.st[1] = nx; }
    const unsigned old = xb_add(&bar[XB_XSUB(b.x)], 1u);
    const unsigned gen = old / nloc;
    if (old + 1u == (gen + 1u) * nloc) {
      __builtin_amdgcn_fence(__ATOMIC_RELEASE, "agent");
      asm volatile("s_waitcnt vmcnt(0)" ::: "memory");
      const unsigned og = xb_add(&bar[XB_TOP], 1u);
      const unsigned tg = og / nx;
      if (og + 1u == (tg + 1u) * nx) xb_add(&bar[XB_TOPGEN], 1u);
      else XB_SPIN(xb_ld(&bar[XB_TOPGEN]) == tg, bar);
      __builtin_amdgcn_fence(__ATOMIC_ACQUIRE, "agent");
      xb_add(&bar[XB_XGEN(b.x)], 1u);
      asm volatile("s_waitcnt vmcnt(0)" ::: "memory");
    } else {
      XB_SPIN(xb_ld(&bar[XB_XGEN(b.x)]) == gen, bar);
      __builtin_amdgcn_fence(__ATOMIC_ACQUIRE, "agent");
      asm volatile("s_waitcnt vmcnt(0)" ::: "memory");
    }
  }
  __syncthreads();
}

#ifndef PROBE
#define PROBE 0
#endif
__global__ void __launch_bounds__(NTHREADS) mega(Params p) {
  extern __shared__ __attribute__((aligned(16))) char dsm[];
  char* smem = dsm;
  char* hsm = dsm + __builtin_amdgcn_readfirstlane((int)(threadIdx.x >> 8)) * 65536;
  cg::grid_group grid = cg::this_grid();
  if (threadIdx.x == 0) *(uint4*)(dsm + SMEM_BYTES) = make_uint4(0u, 0u, 0u, 0u);
  __syncthreads();
  XcdBarrier xb = xcd_barrier_post(p.bar, (volatile LAS unsigned*)(dsm + SMEM_BYTES));
  const int lo = p.phase_lo, hi = p.phase_hi;
  if (hi > 1000) grid.sync();
#define GRID_SYNC() xcd_barrier(xb)
#define RUN_PHASE(PH, CALL) { const int ph_ = (PH); if (ph_ >= lo && ph_ < hi) { CALL; if (ph_ + 1 < hi) GRID_SYNC(); } }
#define RUN_PHASE_REP(PID, PH, CALL) { RUN_PHASE(PH, CALL); if (PROBE == (PID)) { RUN_PHASE(PH, CALL); } }
  RUN_PHASE_REP(1, 0, phase0(p, hsm));
#pragma unroll 1
  for (int l = 0; l < 4; ++l) {
    RUN_PHASE_REP(2, 1 + l * 6, phaseN(p, l));
    RUN_PHASE_REP(3, 2 + l * 6, phaseA(p, l, smem));
    RUN_PHASE_REP(4, 3 + l * 6, phaseB(p, l, hsm));
    if (PROBE == 8) { phaseB(p, l, hsm, 1); GRID_SYNC(); }
    if (PROBE == 9) { phaseB(p, l, hsm, 2); GRID_SYNC(); }
    RUN_PHASE_REP(5, 4 + l * 6, phaseB2(p, l, hsm));
    RUN_PHASE_REP(6, 5 + l * 6, phaseC1(p, l, smem));
    RUN_PHASE(6 + l * 6, phaseC2(p, l, smem));
    if (PROBE == 7) { for (int e = 0; e < 6; ++e) GRID_SYNC(); }
  }
  RUN_PHASE(25, phaseF(p));
}

extern "C" void kernel_launch(void* const* d_in, const int* in_sizes, int n_in, void* d_out, int out_size, void* d_ws,
                              size_t ws_size, hipStream_t stream) {
  static int grid_blocks = 0;
  if (!grid_blocks) {
    int dev = 0, cus = 0, per_cu = 0;
    hipGetDevice(&dev);
    hipDeviceGetAttribute(&cus, hipDeviceAttributeMultiprocessorCount, dev);
    hipFuncSetAttribute((const void*)mega, hipFuncAttributeMaxDynamicSharedMemorySize, DYN_LDS);
    hipOccupancyMaxActiveBlocksPerMultiprocessor(&per_cu, mega, NTHREADS, DYN_LDS);
    if (per_cu > 1) per_cu = 1;
    if (per_cu < 1) per_cu = 1;
    grid_blocks = cus * per_cu;
  }
  Params p;
  memset(&p, 0, sizeof(p));
  const float** fp = (const float**)&p;
  for (int i = 0; i < 25; ++i) fp[i] = (const float*)d_in[i];
  p.out = (float*)d_out;
  char* w = (char*)d_ws;
  size_t off = 0;
  auto take = [&](size_t bytes) { char* r = w + off; off += (bytes + 255) & ~(size_t)255; return r; };
  p.wt_in = (u16*)take((size_t)4 * 8192 * 1024 * 2);
  p.wt_br = (u16*)take((size_t)4 * 3 * 1024 * 512 * 2);
  p.wt_out = (u16*)take((size_t)4 * 1024 * 1024 * 2);
  p.wgT = (u16*)take((size_t)128 * 4096 * 2);
  p.ckb = (u16*)take((size_t)2 * 4 * 256 * 512 * 2);
  p.cvT = (u16*)take((size_t)2 * 4 * 256 * 512 * 2);
  p.xm = (u16*)take((size_t)8192 * 1024 * 2);
  p.P = (u16*)take((size_t)8192 * 8192 * 2);
  p.Vt = (u16*)take((size_t)512 * 8192 * 2);
  p.Ana = (u16*)take((size_t)8192 * 512 * 2);
  p.Alru = (u16*)take((size_t)8192 * 512 * 2);
  p.Aconv = (u16*)take((size_t)8192 * 512 * 2);
  p.merged = (u16*)take((size_t)8192 * 1024 * 2);
  p.hloc = (u16*)take((size_t)2 * 8192 * 512 * 2);
  p.acum = (u16*)take((size_t)2 * 8192 * 512 * 2);
  p.mod = (float*)take((size_t)4 * 3 * 3072 * 4);
  p.xbuf = (float*)take((size_t)8192 * 1024 * 4);
  p.Atot = (float*)take((size_t)128 * 2 * 512 * 4);
  p.Htot = (float*)take((size_t)128 * 2 * 512 * 4);
  p.sp8 = (float*)take((size_t)4096 * 4);
  p.bar = (unsigned*)take((size_t)XCD_BAR_WORDS * 4);
  if (off > ws_size) { fprintf(stderr, "workspace too small: need %zu have %zu\n", off, ws_size); return; }
#ifdef MULTI_LAUNCH
  for (int ph = 0; ph < 26; ++ph) {
    p.phase_lo = ph; p.phase_hi = ph + 1;
    hipLaunchKernelGGL(mega, dim3(grid_blocks), dim3(NTHREADS), DYN_LDS, stream, p);
  }
#else
  p.phase_lo = 0; p.phase_hi = 26;
  hipMemsetAsync(p.bar, 0, (size_t)XCD_BAR_WORDS * 4, stream);
  void* args[] = {&p};
  hipError_t e = hipLaunchCooperativeKernel((void*)mega, dim3(grid_blocks), dim3(NTHREADS), args, DYN_LDS, stream);
  if (e != hipSuccess) fprintf(stderr, "cooperative launch failed: %s (grid %d)\n", hipGetErrorString(e), grid_blocks);
#endif
}
```

```cpp
#include <hip/hip_runtime.h>
#include <hip/hip_cooperative_groups.h>
#include <cstdio>
#include <cstring>
namespace cg = cooperative_groups;

typedef unsigned short u16;
using bf16x8 = __attribute__((ext_vector_type(8))) short;
using f32x4 = __attribute__((ext_vector_type(4))) float;
using u32x4 = __attribute__((ext_vector_type(4))) unsigned;

#ifndef PROBE
#define PROBE 0
#endif
#define NTHREADS 512
#define SMEM_BYTES 131072
#define DYN_LDS (SMEM_BYTES + 64)

struct Params {
  const float *x_prompt, *x_sample, *cache_k, *cache_v, *state_lru, *c, *c_ctx, *norm_g, *w_mod, *b_mod,
      *w_in, *na_rpb, *lru_conv_w, *lru_conv_b, *lru_wa, *lru_ba, *lru_wx, *lru_bx, *lru_lam, *conv_w,
      *w_br_na, *w_br_lru, *w_br_conv, *w_out, *final_g;
  float* out;
  u16 *wt_in, *wt_br, *wt_out, *wgT, *ckb, *cvT, *xm, *P, *Vt, *Ana, *Alru, *Aconv, *merged, *hloc, *acum;
  float *mod, *xbuf, *Atot, *Htot, *sp8;
  unsigned* bar;
  int phase_lo, phase_hi;
};

__device__ __forceinline__ int otid() { int t = threadIdx.x & 255; asm volatile("" : "+v"(t)); return t; }
__device__ __forceinline__ int otid512() { int t = threadIdx.x; asm volatile("" : "+v"(t)); return t; }
__device__ __forceinline__ int vbid() { return blockIdx.x * 2 + __builtin_amdgcn_readfirstlane((int)(threadIdx.x >> 8)); }
#define NVB ((int)gridDim.x * 2)
__device__ __forceinline__ unsigned f2bf(float f) {
  unsigned u = __float_as_uint(f);
  u += 0x7fffu + ((u >> 16) & 1u);
  return u >> 16;
}
__device__ __forceinline__ float bf2f(unsigned h) { return __uint_as_float(h << 16); }
__device__ __forceinline__ unsigned pack2(float a, float b) { return f2bf(a) | (f2bf(b) << 16); }
__device__ __forceinline__ float sigm(float x) { return __builtin_amdgcn_rcpf(1.f + __expf(-x)); }
__device__ __forceinline__ float silu(float x) { return x * __builtin_amdgcn_rcpf(1.f + __expf(-x)); }
__device__ __forceinline__ float lo16(unsigned w) { return __uint_as_float(w << 16); }
__device__ __forceinline__ float hi16(unsigned w) { return __uint_as_float(w & 0xffff0000u); }

__device__ void transpose_unit(const float* __restrict__ src, int N, u16* __restrict__ dst, int K, int k0, int n0,
                               float* sm) {
  const int tid = otid();
#pragma unroll
  for (int i = 0; i < 4; ++i) {
    int r = (tid >> 4) + i * 16, c4 = (tid & 15) * 4;
    float4 v = *(const float4*)(src + (size_t)(k0 + r) * N + n0 + c4);
    sm[r * 65 + c4 + 0] = v.x; sm[r * 65 + c4 + 1] = v.y; sm[r * 65 + c4 + 2] = v.z; sm[r * 65 + c4 + 3] = v.w;
  }
  __syncthreads();
  const int n = tid >> 2, kq = (tid & 3) * 16;
  unsigned w[8];
#pragma unroll
  for (int kk = 0; kk < 8; ++kk) w[kk] = pack2(sm[(kq + 2 * kk) * 65 + n], sm[(kq + 2 * kk + 1) * 65 + n]);
  uint4* d = (uint4*)(dst + (size_t)(n0 + n) * K + k0 + kq);
  d[0] = make_uint4(w[0], w[1], w[2], w[3]);
  d[1] = make_uint4(w[4], w[5], w[6], w[7]);
  __syncthreads();
}

__device__ void phase0(const Params& p, char* smem) {
  float* sm = (float*)smem;
  const int tid = otid();
  const int NU = 384 + 8192 + 1536 + 1024 + 512 + 512 + 128 + 2048;
  for (int u = vbid(); u < NU; u += NVB) {
    int v = u;
    if (v < 384) {
      int l = v / 96, cgp = v % 96;
      int c = cgp * 32 + (tid & 31), kg = tid >> 5;
      float a0 = 0.f, a1 = 0.f, a2 = 0.f;
      const float* w = p.w_mod + (size_t)l * 1024 * 3072 + c;
      for (int k = kg * 128; k < kg * 128 + 128; ++k) {
        float wv = w[(size_t)k * 3072];
        a0 += silu(p.c_ctx[k]) * wv; a1 += silu(p.c[k]) * wv; a2 += silu(p.c[1024 + k]) * wv;
      }
      sm[(kg * 3 + 0) * 32 + (tid & 31)] = a0;
      sm[(kg * 3 + 1) * 32 + (tid & 31)] = a1;
      sm[(kg * 3 + 2) * 32 + (tid & 31)] = a2;
      __syncthreads();
      if (tid < 96) {
        int cond = tid >> 5, cc = tid & 31;
        float s = p.b_mod[l * 3072 + cgp * 32 + cc];
#pragma unroll
        for (int g = 0; g < 8; ++g) s += sm[(g * 3 + cond) * 32 + cc];
        p.mod[(size_t)(l * 3 + cond) * 3072 + cgp * 32 + cc] = s;
      }
      __syncthreads();
      continue;
    }
    v -= 384;
    if (v < 8192) {
      int l = v >> 11, r = v & 2047, kt = r >> 7, nt = r & 127;
      transpose_unit(p.w_in + (size_t)l * 1024 * 8192, 8192, p.wt_in + (size_t)l * 8192 * 1024, 1024, kt * 64, nt * 64, sm);
      continue;
    }
    v -= 8192;
    if (v < 1536) {
      int l = v / 384, r = v % 384, br = r >> 7, q = r & 127, kt = q >> 4, nt = q & 15;
      u16* dst = p.wt_br + (size_t)(l * 3 + br) * 1024 * 512;
      if (br == 0) transpose_unit(p.w_br_na + (size_t)l * 512 * 1024, 1024, dst, 512, kt * 64, nt * 64, sm);
      else if (br == 1) transpose_unit(p.w_br_lru + (size_t)l * 512 * 1024, 1024, dst, 512, kt * 64, nt * 64, sm);
      else transpose_unit(p.w_br_conv + (size_t)l * 512 * 1024, 1024, dst, 512, kt * 64, nt * 64, sm);
      continue;
    }
    v -= 1536;
    if (v < 1024) {
      int l = v >> 8, r = v & 255, kt = r >> 4, nt = r & 15;
      transpose_unit(p.w_out + (size_t)l * 1024 * 1024, 1024, p.wt_out + (size_t)l * 1024 * 1024, 1024, kt * 64, nt * 64, sm);
      continue;
    }
    v -= 1024;
    if (v < 512) {
      size_t idx = ((size_t)v * 256 + tid) * 8;
      float4 a = *(const float4*)(p.cache_k + idx), b = *(const float4*)(p.cache_k + idx + 4);
      *(uint4*)(p.ckb + idx) = make_uint4(pack2(a.x, a.y), pack2(a.z, a.w), pack2(b.x, b.y), pack2(b.z, b.w));
      continue;
    }
    v -= 512;
    if (v < 512) {
      int g = v * 256 + tid;
      int d = g & 63, h = (g >> 6) & 7, kg = (g >> 9) & 31, bl = g >> 14;
      float f[8];
#pragma unroll
      for (int j = 0; j < 8; ++j) f[j] = p.cache_v[((size_t)(bl * 256 + kg * 8 + j) * 8 + h) * 64 + d];
      *(uint4*)(p.cvT + ((size_t)(bl * 8 + h) * 64 + d) * 256 + kg * 8) =
          make_uint4(pack2(f[0], f[1]), pack2(f[2], f[3]), pack2(f[4], f[5]), pack2(f[6], f[7]));
      continue;
    }
    v -= 512;
    if (v >= 128) {
      v -= 128;
      const size_t o = ((size_t)(v & 1023) * 256 + tid) * 16;
      if (v < 1024) {
#pragma unroll
        for (int i = 0; i < 4; ++i) *(float4*)(p.xbuf + o + i * 4) = *(const float4*)(p.x_prompt + o + i * 4);
      } else {
#pragma unroll
        for (int i = 0; i < 4; ++i) *(float4*)(p.xbuf + 4194304 + o + i * 4) = *(const float4*)(p.x_sample + o + i * 4);
      }
      continue;
    }
    {
      int blk = v & 7, gate = (v >> 3) & 1, dir = (v >> 4) & 1, l = v >> 5;
      if (v == 0) {
        for (int i = tid; i < 4096; i += 256) p.sp8[i] = 8.f * log1pf(expf(-p.lru_lam[i]));
      }
      const size_t so = (size_t)((l * 2 + dir) * 8 + blk) * 4096;
      u16* dst = p.wgT + (size_t)v * 4096;
      for (int idx = tid; idx < 4096; idx += 256) {
        int k = idx >> 6, j = idx & 63;
        float wv;
        if (gate) wv = p.lru_wx[so + j * 64 + k]; else wv = p.lru_wa[so + j * 64 + k];
        dst[idx] = (u16)f2bf(wv);
      }
    }
  }
}

__device__ __forceinline__ const float* xrow(const Params& p, int l, int t) {
  return p.xbuf + (size_t)t * 1024;
}
__device__ __forceinline__ float wave_sum(float v) {
#pragma unroll
  for (int o = 32; o >= 1; o >>= 1) v += __shfl_xor(v, o);
  return v;
}

__device__ void phaseN(const Params& p, int l) {
  const int lane = otid() & 63, wave = otid() >> 6;
  const float* g = p.norm_g + l * 1024;
  for (int t = vbid() * 4 + wave; t < 8192; t += NVB * 4) {
    const float* x = xrow(p, l, t);
    float4 v[4];
    float ss = 0.f;
#pragma unroll
    for (int i = 0; i < 4; ++i) {
      v[i] = *(const float4*)(x + i * 256 + lane * 4);
      ss += v[i].x * v[i].x + v[i].y * v[i].y + v[i].z * v[i].z + v[i].w * v[i].w;
    }
    ss = wave_sum(ss);
    float rstd = rsqrtf(ss * (1.f / 1024.f) + 1e-6f);
    int cid = t < 4096 ? 0 : 1 + ((t - 4096) >> 11);
    const float* md = p.mod + (size_t)(l * 3 + cid) * 3072;
#pragma unroll
    for (int i = 0; i < 4; ++i) {
      int c = i * 256 + lane * 4;
      float4 gg = *(const float4*)(g + c), sh = *(const float4*)(md + c), sc = *(const float4*)(md + 1024 + c);
      float y0 = v[i].x * rstd * gg.x * (1.f + sc.x) + sh.x;
      float y1 = v[i].y * rstd * gg.y * (1.f + sc.y) + sh.y;
      float y2 = v[i].z * rstd * gg.z * (1.f + sc.z) + sh.z;
      float y3 = v[i].w * rstd * gg.w * (1.f + sc.w) + sh.w;
      *(uint2*)(p.xm + (size_t)t * 1024 + c) = make_uint2(pack2(y0, y1), pack2(y2, y3));
    }
  }
}

__device__ void phaseF(const Params& p) {
  const int lane = otid() & 63, wave = otid() >> 6;
  for (int t = vbid() * 4 + wave; t < 8192; t += NVB * 4) {
    const float* x = p.xbuf + (size_t)t * 1024;
    float4 v[4];
    float ss = 0.f;
#pragma unroll
    for (int i = 0; i < 4; ++i) {
      v[i] = *(const float4*)(x + i * 256 + lane * 4);
      ss += v[i].x * v[i].x + v[i].y * v[i].y + v[i].z * v[i].z + v[i].w * v[i].w;
    }
    ss = wave_sum(ss);
    float rstd = rsqrtf(ss * (1.f / 1024.f) + 1e-6f);
#pragma unroll
    for (int i = 0; i < 4; ++i) {
      int c = i * 256 + lane * 4;
      float4 gg = *(const float4*)(p.final_g + c);
      *(float4*)(p.out + (size_t)t * 1024 + c) =
          make_float4(v[i].x * rstd * gg.x, v[i].y * rstd * gg.y, v[i].z * rstd * gg.z, v[i].w * rstd * gg.w);
    }
  }
}

__device__ __forceinline__ int perm64(int r) { return (r & 0x43) | ((r & 0x30) >> 2) | ((r & 0x0c) << 2); }

template <int MI, int NJ, int WM, int WN, bool SWAP, bool PERM_A, bool PERM_B>
__device__ __forceinline__ void gemm_mainloop64(const u16* __restrict__ A, int lda, const u16* __restrict__ B, int ldb,
                                              int K, f32x4 (&acc)[MI][NJ], char* smem) {
  constexpr int AR = WM * MI * 16, BR = WN * NJ * 16;
  constexpr int A_BYTES = AR * 128, STAGE = (AR + BR) * 128;
  const int tid = otid512(), lane = tid & 63, wave = tid >> 6;
  const int wm = wave / WN, wn = wave % WN, fr = lane & 15, fq = lane >> 4;
  const int lr = tid >> 3, lc = (tid & 7) ^ ((lr >> 1) & 7);
  const u16* ag = A + (size_t)(PERM_A ? perm64(lr) : lr) * lda + lc * 8;
  const u16* bg = B + (size_t)(PERM_B ? perm64(lr) : lr) * ldb + lc * 8;
  char* sA = smem + tid * 16;
  char* sB = smem + A_BYTES + tid * 16;
#define GLDS(gp, lp) __builtin_amdgcn_global_load_lds((const unsigned*)(gp), (unsigned*)(lp), 16, 0, 0)
#pragma unroll
  for (int i = 0; i < AR / 64; ++i) GLDS(ag + (size_t)i * 64 * lda, sA + i * 8192);
#pragma unroll
  for (int i = 0; i < BR / 64; ++i) GLDS(bg + (size_t)i * 64 * ldb, sB + i * 8192);
  asm volatile("s_waitcnt vmcnt(0)" ::: "memory");
  __syncthreads();
  const int swz_r = (fr >> 1) & 7;
  const int aoff = (wm * MI * 16 + fr) * 128, boff = A_BYTES + (wn * NJ * 16 + fr) * 128;
  const int nk = K >> 6;
  for (int kt = 0; kt < nk; ++kt) {
    const int cur = kt & 1;
    if (kt + 1 < nk) {
#pragma unroll
      for (int i = 0; i < AR / 64; ++i) GLDS(ag + (size_t)i * 64 * lda + (kt + 1) * 64, sA + (cur ^ 1) * STAGE + i * 8192);
#pragma unroll
      for (int i = 0; i < BR / 64; ++i) GLDS(bg + (size_t)i * 64 * ldb + (kt + 1) * 64, sB + (cur ^ 1) * STAGE + i * 8192);
    }
    __builtin_amdgcn_sched_barrier(0);
    const char* cA = smem + cur * STAGE + aoff;
    const char* cB = smem + cur * STAGE + boff;
    bf16x8 af[2][MI], bfr[2][NJ];
#pragma unroll
    for (int ks = 0; ks < 2; ++ks) {
      const int ch = ((ks * 4 + fq) ^ swz_r) << 4;
#pragma unroll
      for (int j = 0; j < NJ; ++j) bfr[ks][j] = *(const bf16x8*)(cB + j * 2048 + ch);
#pragma unroll
      for (int i = 0; i < MI; ++i) af[ks][i] = *(const bf16x8*)(cA + i * 2048 + ch);
    }
#pragma unroll
    for (int ks = 0; ks < 2; ++ks)
#pragma unroll
      for (int i = 0; i < MI; ++i)
#pragma unroll
        for (int j = 0; j < NJ; ++j) {
          if (SWAP) acc[i][j] = __builtin_amdgcn_mfma_f32_16x16x32_bf16(bfr[ks][j], af[ks][i], acc[i][j], 0, 0, 0);
          else acc[i][j] = __builtin_amdgcn_mfma_f32_16x16x32_bf16(af[ks][i], bfr[ks][j], acc[i][j], 0, 0, 0);
        }
    __builtin_amdgcn_sched_group_barrier(0x100, 8, 0);
#pragma unroll
    for (int g = 0; g < 2 * (MI + NJ) - 8; ++g) {
      __builtin_amdgcn_sched_group_barrier(0x008, 2, 0);
      __builtin_amdgcn_sched_group_barrier(0x100, 1, 0);
    }
    __builtin_amdgcn_sched_group_barrier(0x008, 2 * MI * NJ - 2 * (2 * (MI + NJ) - 8), 0);
    __builtin_amdgcn_sched_barrier(0);
    asm volatile("s_waitcnt vmcnt(0)" ::: "memory");
    __builtin_amdgcn_s_barrier();
    asm volatile("" ::: "memory");
  }
#undef GLDS
}

template <int N> __device__ __forceinline__ void wait_vmcnt() {
  if (N == 0) asm volatile("s_waitcnt vmcnt(0)" ::: "memory");
  else if (N == 3) asm volatile("s_waitcnt vmcnt(3)" ::: "memory");
  else if (N == 4) asm volatile("s_waitcnt vmcnt(4)" ::: "memory");
  else if (N == 6) asm volatile("s_waitcnt vmcnt(6)" ::: "memory");
  else if (N == 8) asm volatile("s_waitcnt vmcnt(8)" ::: "memory");
  else asm volatile("s_waitcnt vmcnt(0)" ::: "memory");
}

template <int MI, int NJ, int WM, int WN, bool SWAP, bool PERM_A, bool PERM_B>
__device__ __forceinline__ void gemm_mainloop(const u16* __restrict__ A, int lda, const u16* __restrict__ B, int ldb,
                                              int K, f32x4 (&acc)[MI][NJ], char* smem) {
  constexpr int AR = WM * MI * 16, BR = WN * NJ * 16;
  constexpr int A_BYTES = AR * 64, STAGE = (AR + BR) * 64;
  constexpr int LA = AR / 128, LB = BR / 128, NL = LA + LB;
  const int tid = otid512(), lane = tid & 63, wave = tid >> 6;
  const int wm = wave / WN, wn = wave % WN, fr = lane & 15, fq = lane >> 4;
  const int lr = tid >> 2, lc = (tid & 3) ^ ((4 - ((lr >> 2) & 3)) & 3);
  const u16* ag = A + (size_t)(PERM_A ? perm64(lr) : lr) * lda + lc * 8;
  const u16* bg = B + (size_t)(PERM_B ? perm64(lr) : lr) * ldb + lc * 8;
  char* sA = smem + tid * 16;
  char* sB = smem + A_BYTES + tid * 16;
#define GLDS(gp, lp) __builtin_amdgcn_global_load_lds((const unsigned*)(gp), (unsigned*)(lp), 16, 0, 0)
#define ISSUE_TILE(kt_, st_)                                                                         \
  {                                                                                                  \
    _Pragma("unroll") for (int i = 0; i < LA; ++i)                                                   \
        GLDS(ag + (size_t)i * 128 * lda + (kt_) * 32, sA + (st_) * STAGE + i * 8192);                \
    _Pragma("unroll") for (int i = 0; i < LB; ++i)                                                   \
        GLDS(bg + (size_t)i * 128 * ldb + (kt_) * 32, sB + (st_) * STAGE + i * 8192);                \
  }
  const int nk = K >> 5;
  ISSUE_TILE(0, 0);
  ISSUE_TILE(1, 1);
  ISSUE_TILE(2, 2);
  const int rch = (fq ^ ((4 - ((fr >> 2) & 3)) & 3)) << 4;
  const int aoff = (wm * MI * 16 + fr) * 64 + rch, boff = A_BYTES + (wn * NJ * 16 + fr) * 64 + rch;
  for (int kt = 0; kt < nk; ++kt) {
    if (kt + 2 < nk) wait_vmcnt<2 * NL>();
    else if (kt + 1 < nk) wait_vmcnt<NL>();
    else wait_vmcnt<0>();
    __builtin_amdgcn_s_barrier();
    asm volatile("" ::: "memory");
    if (kt + 3 < nk) ISSUE_TILE(kt + 3, (kt + 3) & 3);
    const char* cA = smem + (kt & 3) * STAGE + aoff;
    const char* cB = smem + (kt & 3) * STAGE + boff;
    bf16x8 af[MI], bfr[NJ];
#pragma unroll
    for (int j = 0; j < NJ; ++j) bfr[j] = *(const bf16x8*)(cB + j * 1024);
#pragma unroll
    for (int i = 0; i < MI; ++i) af[i] = *(const bf16x8*)(cA + i * 1024);
#pragma unroll
    for (int i = 0; i < MI; ++i)
#pragma unroll
      for (int j = 0; j < NJ; ++j) {
        if (SWAP) acc[i][j] = __builtin_amdgcn_mfma_f32_16x16x32_bf16(bfr[j], af[i], acc[i][j], 0, 0, 0);
        else acc[i][j] = __builtin_amdgcn_mfma_f32_16x16x32_bf16(af[i], bfr[j], acc[i][j], 0, 0, 0);
      }
  }
  __syncthreads();
#undef ISSUE_TILE
#undef GLDS
}

template <int MI, int NJ>
__device__ __forceinline__ void zero_acc(f32x4 (&acc)[MI][NJ]) {
#pragma unroll
  for (int i = 0; i < MI; ++i)
#pragma unroll
    for (int j = 0; j < NJ; ++j) acc[i][j] = f32x4{0.f, 0.f, 0.f, 0.f};
}

__device__ void phaseA(const Params& p, int l, char* smem) {
  const int tid = otid512(), lane = tid & 63, wave = tid >> 6;
  const int wm = wave >> 2, wn = wave & 3, fr = lane & 15, fq = lane >> 4;
  const u16* W = p.wt_in + (size_t)l * 8192 * 1024;
  float* newk = p.out + 8388608;
  float* newv = p.out + 16777216;
  for (int id = blockIdx.x; id < 1024; id += gridDim.x) {
    const int xcd = id & 7, j_ = id >> 3;
    const int mt = xcd * 4 + (j_ & 3), nt = (j_ >> 5) * 8 + ((j_ >> 2) & 7);
    const int m0 = mt * 256, n0 = nt * 256;
    f32x4 acc[8][4];
    zero_acc<8, 4>(acc);
    const u16* A = p.xm + (size_t)m0 * 1024;
    const u16* B = W + (size_t)n0 * 1024;
    if (n0 >= 1024 && n0 < 1536) {
      gemm_mainloop64<8, 4, 2, 4, false, true, false>(A, 1024, B, 1024, 1024, acc, smem);
#pragma unroll
      for (int g = 0; g < 2; ++g)
#pragma unroll
        for (int j = 0; j < 4; ++j) {
          const int tok0 = m0 + wm * 128 + g * 64 + fq * 16;
          const int vc = n0 + wn * 64 + j * 16 + fr - 1024;
          uint4 w0 = make_uint4(pack2(acc[g * 4 + 0][j][0], acc[g * 4 + 0][j][1]), pack2(acc[g * 4 + 0][j][2], acc[g * 4 + 0][j][3]),
                                pack2(acc[g * 4 + 1][j][0], acc[g * 4 + 1][j][1]), pack2(acc[g * 4 + 1][j][2], acc[g * 4 + 1][j][3]));
          uint4 w1 = make_uint4(pack2(acc[g * 4 + 2][j][0], acc[g * 4 + 2][j][1]), pack2(acc[g * 4 + 2][j][2], acc[g * 4 + 2][j][3]),
                                pack2(acc[g * 4 + 3][j][0], acc[g * 4 + 3][j][1]), pack2(acc[g * 4 + 3][j][2], acc[g * 4 + 3][j][3]));
          *(uint4*)(p.Vt + (size_t)vc * 8192 + tok0) = w0;
          *(uint4*)(p.Vt + (size_t)vc * 8192 + tok0 + 8) = w1;
          if (tok0 < 4096) {
#pragma unroll
            for (int i4 = 0; i4 < 4; ++i4)
#pragma unroll
              for (int jj = 0; jj < 4; ++jj) {
                const int t = tok0 + i4 * 4 + jj;
                newv[((size_t)((t >> 8) * 4 + l) * 256 + (t & 255)) * 512 + vc] = acc[g * 4 + i4][j][jj];
              }
          }
        }
    } else {
      gemm_mainloop64<8, 4, 2, 4, true, false, true>(A, 1024, B, 1024, 1024, acc, smem);
      const bool isK = (n0 >= 512 && n0 < 1024);
#pragma unroll
      for (int i = 0; i < 8; ++i) {
        const int t = m0 + wm * 128 + i * 16 + fr;
        const int col = n0 + wn * 64 + fq * 16;
        uint4 w0 = make_uint4(pack2(acc[i][0][0], acc[i][0][1]), pack2(acc[i][0][2], acc[i][0][3]),
                              pack2(acc[i][1][0], acc[i][1][1]), pack2(acc[i][1][2], acc[i][1][3]));
        uint4 w1 = make_uint4(pack2(acc[i][2][0], acc[i][2][1]), pack2(acc[i][2][2], acc[i][2][3]),
                              pack2(acc[i][3][0], acc[i][3][1]), pack2(acc[i][3][2], acc[i][3][3]));
        *(uint4*)(p.P + (size_t)t * 8192 + col) = w0;
        *(uint4*)(p.P + (size_t)t * 8192 + col + 8) = w1;
        if (isK && t < 4096) {
          float* dst = newk + ((size_t)((t >> 8) * 4 + l) * 256 + (t & 255)) * 512 + (col - 512);
#pragma unroll
          for (int j = 0; j < 4; ++j) *(float4*)(dst + j * 4) = make_float4(acc[i][j][0], acc[i][j][1], acc[i][j][2], acc[i][j][3]);
        }
      }
    }
  }
}

__device__ __forceinline__ bf16x8 ld16(const u16* ptr) { return *(const bf16x8*)ptr; }

__device__ void attn_unit(const Params& p, int l, int unit, char* smem) {
  const int lane = otid() & 63, fr = lane & 15, fq = lane >> 4;
  const bool lat = unit >= 2048;
  int b, h, qtok0, r = 0, n = 0, row0 = 0, band0 = 0;
  if (!lat) {
    b = unit >> 7; h = (unit >> 4) & 7;
    qtok0 = b * 256 + (unit & 15) * 16;
  } else {
    int u = unit - 2048;
    b = u >> 10; r = (u >> 5) & 31; n = (u >> 3) & 3; h = u & 7;
    qtok0 = 4096 + b * 2048 + r * 64 + n * 16;
    row0 = min(max(r - 4, 0), 24);
    band0 = min(max(16 * n - 8, 0), 32);
  }
  const u16* qp = p.P + (size_t)(qtok0 + fr) * 8192 + h * 64 + fq * 8;
  const bf16x8 q0 = ld16(qp), q1 = ld16(qp + 32);
  f32x4 o[4];
#pragma unroll
  for (int dt = 0; dt < 4; ++dt) o[dt] = f32x4{0.f, 0.f, 0.f, 0.f};
  float m = -1e30f, lsum = 0.f;
  float* rpb = (float*)(smem + 57344 + __builtin_amdgcn_readfirstlane(otid() >> 6) * 2048);
  if (lat) {
    const float* rg = p.na_rpb + (size_t)(l * 8 + h) * 15 * 31;
#pragma unroll
    for (int i = 0; i < 8; ++i) {
      const int idx = lane + 64 * i;
      if (idx < 465) rpb[idx] = rg[idx];
    }
    asm volatile("s_waitcnt vmcnt(0) lgkmcnt(0)" ::: "memory");
  }
  const int qc = 16 * n + fr;
  const int wst = min(max(qc - 8, 0), 48);
  const int nchunks = lat ? 8 : 4;
  const u16 *kb, *vb;
  int kstride, kslab, vstride, vslab;
#define CHUNK_PTRS(c)                                                                                          \
  if (!lat) {                                                                                                  \
    const size_t key0 = (size_t)b * 256 + (c) * 64;                                                            \
    kb = p.P + key0 * 8192 + 512 + h * 64; kstride = 8192; kslab = 32 * 8192;                                  \
    vb = p.Vt + (size_t)(h * 64) * 8192 + key0; vstride = 8192; vslab = 32;                                    \
  } else if ((c) < 4) {                                                                                        \
    const size_t tok = 4096 + (size_t)b * 2048 + (row0 + (c) * 2) * 64 + band0;                                \
    kb = p.P + tok * 8192 + 512 + h * 64; kstride = 8192; kslab = 64 * 8192;                                   \
    vb = p.Vt + (size_t)(h * 64) * 8192 + tok; vstride = 8192; vslab = 64;                                     \
  } else {                                                                                                     \
    kb = p.ckb + ((size_t)(b * 4 + l) * 256 + ((c) - 4) * 64) * 512 + h * 64; kstride = 512; kslab = 32 * 512; \
    vb = p.cvT + (size_t)((b * 4 + l) * 8 + h) * 64 * 256 + ((c) - 4) * 64; vstride = 256; vslab = 32;         \
  }
  bf16x8 kf[8];
  CHUNK_PTRS(0);
#pragma unroll
  for (int mt = 0; mt < 4; ++mt) {
    const u16* kp = kb + (size_t)(mt >> 1) * kslab + (size_t)((fr >> 2) * 8 + (mt & 1) * 4 + (fr & 3)) * kstride + fq * 8;
    kf[2 * mt] = ld16(kp); kf[2 * mt + 1] = ld16(kp + 32);
  }
#pragma unroll 1
  for (int c = 0; c < nchunks; ++c) {
    const bool local = lat && c < 4;
    bf16x8 vf[8];
#pragma unroll
    for (int sl = 0; sl < 2; ++sl)
#pragma unroll
      for (int dt = 0; dt < 4; ++dt) vf[sl * 4 + dt] = ld16(vb + sl * vslab + (size_t)(dt * 16 + fr) * vstride + fq * 8);
    float bs[16];
    if (local) {
#pragma unroll
      for (int mt = 0; mt < 4; ++mt) {
        const int row_off = row0 + c * 2 + (mt >> 1) - r + 7;
#pragma unroll
        for (int jj = 0; jj < 4; ++jj) {
          const int kc = band0 + fq * 8 + (mt & 1) * 4 + jj;
          const int col_off = min(max(kc - qc, -15), 15) + 15;
          bs[mt * 4 + jj] = rpb[row_off * 31 + col_off];
        }
      }
    } else {
#pragma unroll
      for (int e = 0; e < 16; ++e) bs[e] = 0.f;
    }
    __builtin_amdgcn_sched_barrier(0);
    f32x4 s[4];
#pragma unroll
    for (int mt = 0; mt < 4; ++mt) {
      f32x4 z = f32x4{0.f, 0.f, 0.f, 0.f};
      z = __builtin_amdgcn_mfma_f32_16x16x32_bf16(kf[2 * mt], q0, z, 0, 0, 0);
      s[mt] = __builtin_amdgcn_mfma_f32_16x16x32_bf16(kf[2 * mt + 1], q1, z, 0, 0, 0);
    }
    __builtin_amdgcn_sched_barrier(0);
    if (c + 1 < nchunks) {
      CHUNK_PTRS(c + 1);
#pragma unroll
      for (int mt = 0; mt < 4; ++mt) {
        const u16* kp = kb + (size_t)(mt >> 1) * kslab + (size_t)((fr >> 2) * 8 + (mt & 1) * 4 + (fr & 3)) * kstride + fq * 8;
        kf[2 * mt] = ld16(kp); kf[2 * mt + 1] = ld16(kp + 32);
      }
    }
    __builtin_amdgcn_sched_barrier(0);
    float cmax = -1e30f;
#pragma unroll
    for (int mt = 0; mt < 4; ++mt)
#pragma unroll
      for (int jj = 0; jj < 4; ++jj) {
        float v = s[mt][jj] * 0.125f + bs[mt * 4 + jj];
        const int kc = band0 + fq * 8 + (mt & 1) * 4 + jj;
        const bool valid = !local || ((kc >= wst) && (kc < wst + 16));
        v = valid ? v : -1e30f;
        s[mt][jj] = v;
        cmax = fmaxf(cmax, v);
      }
    cmax = fmaxf(cmax, __shfl_xor(cmax, 16));
    cmax = fmaxf(cmax, __shfl_xor(cmax, 32));
    const float mnew = fmaxf(m, cmax);
    const float alpha = __expf(m - mnew);
    m = mnew;
    lsum *= alpha;
#pragma unroll
    for (int dt = 0; dt < 4; ++dt) o[dt] *= alpha;
#pragma unroll
    for (int mt = 0; mt < 4; ++mt)
#pragma unroll
      for (int jj = 0; jj < 4; ++jj) {
        float pv = __expf(s[mt][jj] - m);
        lsum += pv;
        s[mt][jj] = pv;
      }
#pragma unroll
    for (int sl = 0; sl < 2; ++sl) {
      u32x4 pw = {pack2(s[2 * sl][0], s[2 * sl][1]), pack2(s[2 * sl][2], s[2 * sl][3]),
                  pack2(s[2 * sl + 1][0], s[2 * sl + 1][1]), pack2(s[2 * sl + 1][2], s[2 * sl + 1][3])};
      bf16x8 pb = __builtin_bit_cast(bf16x8, pw);
#pragma unroll
      for (int dt = 0; dt < 4; ++dt) {
        o[dt] = __builtin_amdgcn_mfma_f32_16x16x32_bf16(vf[sl * 4 + dt], pb, o[dt], 0, 0, 0);
      }
    }
  }
#undef CHUNK_PTRS
  lsum += __shfl_xor(lsum, 16);
  lsum += __shfl_xor(lsum, 32);
  const float inv = 1.f / lsum;
  const size_t t = qtok0 + fr;
#pragma unroll
  for (int dt = 0; dt < 4; ++dt) {
    int d0 = h * 64 + dt * 16 + fq * 4;
    uint2 g = *(const uint2*)(p.P + t * 8192 + 1536 + d0);
    float y0 = o[dt][0] * inv * silu(lo16(g.x)), y1 = o[dt][1] * inv * silu(hi16(g.x));
    float y2 = o[dt][2] * inv * silu(lo16(g.y)), y3 = o[dt][3] * inv * silu(hi16(g.y));
    *(uint2*)(p.Ana + t * 512 + d0) = make_uint2(pack2(y0, y1), pack2(y2, y3));
  }
}

__device__ void lru_unit(const Params& p, int l, int unit, char* smem) {
  const int tid = otid(), lane = tid & 63, wave = tid >> 6, fr = lane & 15, fq = lane >> 4;
  const int blk = unit & 7, dir = (unit >> 3) & 1, cs = unit >> 4;
  const int t0 = cs * 64;
  int seq_lo, seq_hi;
  if (cs < 64) { seq_lo = (cs >> 2) * 256; seq_hi = seq_lo + 256; }
  else { seq_lo = 4096 + ((cs - 64) >> 5) * 2048; seq_hi = seq_lo + 2048; }
  u16* uraw = (u16*)smem;
  u16* udb = (u16*)(smem + 8704);
  float* sa = (float*)(smem + 8704 + 9216);
  float* sb = sa + 4096;
  float* stot = sb + 4096;
  const int wbase = dir ? t0 : t0 - 3;
#pragma unroll
  for (int i = 0; i < 3; ++i) {
    int row = (tid >> 3) + i * 32, ch8 = tid & 7;
    if (row < 67) {
      int t = wbase + row;
      uint4 v = make_uint4(0, 0, 0, 0);
      if (t >= seq_lo && t < seq_hi) v = *(const uint4*)(p.P + (size_t)t * 8192 + 2048 + blk * 64 + ch8 * 8);
      *(uint4*)(uraw + row * 64 + ch8 * 8) = v;
    }
  }
  __syncthreads();
  {
    const int ch = tid & 63, tg = tid >> 6;
    const int cw = blk * 64 + ch;
    const float* cwp = p.lru_conv_w + (size_t)((l * 2 + dir) * 4) * 512 + cw;
    const float w0 = cwp[0], w1 = cwp[512], w2 = cwp[1024], w3 = cwp[1536];
    const float cb = p.lru_conv_b[(l * 2 + dir) * 512 + cw];
    float uw[19];
#pragma unroll
    for (int q = 0; q < 19; ++q) uw[q] = bf2f(uraw[(tg * 16 + q) * 64 + ch]);
#pragma unroll
    for (int q = 0; q < 16; ++q) {
      const int t = tg * 16 + q;
      float ud = cb + w0 * uw[q] + w1 * uw[q + 1] + w2 * uw[q + 2] + w3 * uw[q + 3];
      sb[t * 64 + ch] = ud;
      udb[t * 72 + ch] = (u16)f2bf(ud);
    }
  }
  __syncthreads();
  {
    f32x4 ar[4], ai[4];
#pragma unroll
    for (int nt = 0; nt < 4; ++nt) { ar[nt] = f32x4{0.f, 0.f, 0.f, 0.f}; ai[nt] = f32x4{0.f, 0.f, 0.f, 0.f}; }
    const u16* wr = p.wgT + (size_t)(((l * 2 + dir) * 2 + 0) * 8 + blk) * 4096;
    const u16* wi = p.wgT + (size_t)(((l * 2 + dir) * 2 + 1) * 8 + blk) * 4096;
#pragma unroll
    for (int ks = 0; ks < 2; ++ks) {
      bf16x8 af = *(const bf16x8*)(udb + (wave * 16 + fr) * 72 + ks * 32 + fq * 8);
#pragma unroll
      for (int nt = 0; nt < 4; ++nt) {
        bf16x8 br = ld16(wr + (nt * 16 + fr) * 64 + ks * 32 + fq * 8);
        bf16x8 bi = ld16(wi + (nt * 16 + fr) * 64 + ks * 32 + fq * 8);
        ar[nt] = __builtin_amdgcn_mfma_f32_16x16x32_bf16(af, br, ar[nt], 0, 0, 0);
        ai[nt] = __builtin_amdgcn_mfma_f32_16x16x32_bf16(af, bi, ai[nt], 0, 0, 0);
      }
    }
#pragma unroll
    for (int nt = 0; nt < 4; ++nt) {
      const int k = nt * 16 + fr, cw = blk * 64 + k;
      const int pi = (l * 2 + dir) * 512 + cw;
      const float ba = p.lru_ba[pi], bx = p.lru_bx[pi];
      const float sp = p.sp8[pi];
#pragma unroll
      for (int jj = 0; jj < 4; ++jj) {
        const int t = wave * 16 + fq * 4 + jj;
        float rg = sigm(ar[nt][jj] + ba), ig = sigm(ai[nt][jj] + bx);
        float la = -rg * sp;
        float a = __expf(la);
        float ud = sb[t * 64 + k];
        float x2 = 2.f * la;
        float ser = -x2 * (1.f + x2 * (0.5f + x2 * (0.16666667f + x2 * (0.041666668f + x2 * (0.0083333338f + x2 * 0.0013888889f)))));
        float om = x2 > -0.5f ? ser : 1.f - a * a;
        float bb = __builtin_amdgcn_sqrtf(om) * (ig * ud);
        sa[t * 64 + k] = a;
        sb[t * 64 + k] = bb;
      }
    }
  }
  __syncthreads();
  {
    const int ch = tid & 63, sub = tid >> 6;
    float h = 0.f, ac = 1.f;
    float av[16], hv[16];
#pragma unroll
    for (int q = 0; q < 16; ++q) {
      const int pos = sub * 16 + q;
      const int t = dir ? 63 - pos : pos;
      av[q] = sa[t * 64 + ch]; hv[q] = sb[t * 64 + ch];
    }
#pragma unroll
    for (int q = 0; q < 16; ++q) {
      h = av[q] * h + hv[q];
      ac *= av[q];
      av[q] = ac; hv[q] = h;
    }
    stot[(sub * 64 + ch) * 2] = ac;
    stot[(sub * 64 + ch) * 2 + 1] = h;
    __syncthreads();
    float cA = 1.f, cH = 0.f;
    for (int s2 = 0; s2 < sub; ++s2) {
      float A2 = stot[(s2 * 64 + ch) * 2], H2 = stot[(s2 * 64 + ch) * 2 + 1];
      cH = A2 * cH + H2;
      cA *= A2;
    }
    u16* hl = p.hloc + ((size_t)dir * 8192 + t0) * 512 + blk * 64 + ch;
    u16* acp = p.acum + ((size_t)dir * 8192 + t0) * 512 + blk * 64 + ch;
    float hf = 0.f, af = 1.f;
#pragma unroll
    for (int q = 0; q < 16; ++q) {
      const int pos = sub * 16 + q;
      const int t = dir ? 63 - pos : pos;
      hf = hv[q] + av[q] * cH;
      af = av[q] * cA;
      hl[(size_t)t * 512] = (u16)f2bf(hf);
      acp[(size_t)t * 512] = (u16)f2bf(af);
    }
    if (sub == 3) {
      p.Atot[(size_t)(cs * 2 + dir) * 512 + blk * 64 + ch] = af;
      p.Htot[(size_t)(cs * 2 + dir) * 512 + blk * 64 + ch] = hf;
    }
  }
  __syncthreads();
}

__device__ void phaseB(const Params& p, int l, char* smem, int mode = 0) {
  const int wave = __builtin_amdgcn_readfirstlane(otid() >> 6);
  for (int it = vbid(); it < 3072; it += NVB) {
    if (it < 1024) { if (mode != 2) attn_unit(p, l, it * 4 + wave, smem); }
    else if (mode != 1) lru_unit(p, l, it - 1024, smem);
  }
}

__device__ __forceinline__ void unpack8(uint4 v, float (&f)[8]) {
  f[0] = lo16(v.x); f[1] = hi16(v.x); f[2] = lo16(v.y); f[3] = hi16(v.y);
  f[4] = lo16(v.z); f[5] = hi16(v.z); f[6] = lo16(v.w); f[7] = hi16(v.w);
}
__device__ void phaseB2(const Params& p, int l, char* smem) {
  const int tid = otid();
  float* scar = (float*)smem;
  float* new_state = p.out + 25165824;
  for (int u = vbid(); u < 512; u += NVB) {
    const int cs = u >> 2, quarter = u & 3;
    int first, c, nch, b, seq_lo, seq_hi;
    const bool lat = cs >= 64;
    if (!lat) { b = cs >> 2; c = cs & 3; nch = 4; first = b * 4; seq_lo = b * 256; seq_hi = seq_lo + 256; }
    else { b = (cs - 64) >> 5; c = (cs - 64) & 31; nch = 32; first = 64 + b * 32; seq_lo = 4096 + b * 2048; seq_hi = seq_lo + 2048; }
    {
      const int dir = tid >> 7, ch = quarter * 128 + (tid & 127);
      float carry = lat ? p.state_lru[(size_t)((b * 4 + l) * 2 + dir) * 512 + ch] : 0.f;
      const int nprev = dir ? (nch - 1 - c) : c;
      const int start = dir ? (nch - 1) : 0, step = dir ? -1 : 1;
      if (!lat) {
        float A_[3], H_[3];
#pragma unroll
        for (int s = 0; s < 3; ++s) {
          const int cc = min(max(start + step * s, 0), 3);
          const size_t ix = (size_t)((first + cc) * 2 + dir) * 512 + ch;
          A_[s] = p.Atot[ix]; H_[s] = p.Htot[ix];
        }
#pragma unroll
        for (int s = 0; s < 3; ++s) if (s < nprev) carry = A_[s] * carry + H_[s];
        const bool last = dir ? (c == 0) : (c == 3);
        if (last) {
          const size_t ix = (size_t)(cs * 2 + dir) * 512 + ch;
          new_state[(size_t)((b * 4 + l) * 2 + dir) * 512 + ch] = p.Atot[ix] * carry + p.Htot[ix];
        }
      } else {
        float A_[31], H_[31];
#pragma unroll
        for (int s = 0; s < 31; ++s) {
          const int cc = min(max(start + step * s, 0), 31);
          const size_t ix = (size_t)((first + cc) * 2 + dir) * 512 + ch;
          A_[s] = p.Atot[ix]; H_[s] = p.Htot[ix];
        }
#pragma unroll
        for (int s = 0; s < 31; ++s) if (s < nprev) carry = A_[s] * carry + H_[s];
      }
      scar[tid] = carry;
    }
    __syncthreads();
    {
      const int c8 = tid & 15, ch0 = quarter * 128 + c8 * 8;
      float cf[8], cb[8], w0[8], w1[8], w2[8];
#pragma unroll
      for (int e = 0; e < 8; ++e) {
        cf[e] = scar[c8 * 8 + e]; cb[e] = scar[128 + c8 * 8 + e];
        w0[e] = p.conv_w[(l * 3 + 0) * 512 + ch0 + e]; w1[e] = p.conv_w[(l * 3 + 1) * 512 + ch0 + e];
        w2[e] = p.conv_w[(l * 3 + 2) * 512 + ch0 + e];
      }
#pragma unroll 2
      for (int i = 0; i < 4; ++i) {
        const int t = cs * 64 + (tid >> 4) + i * 16;
        const u16* pr = p.P + (size_t)t * 8192 + ch0;
        const uint4 z4 = make_uint4(0u, 0u, 0u, 0u);
        uint4 hf4 = *(const uint4*)(p.hloc + (size_t)t * 512 + ch0), af4 = *(const uint4*)(p.acum + (size_t)t * 512 + ch0);
        uint4 hb4 = *(const uint4*)(p.hloc + ((size_t)8192 + t) * 512 + ch0), ab4 = *(const uint4*)(p.acum + ((size_t)8192 + t) * 512 + ch0);
        uint4 gl4 = *(const uint4*)(pr + 2560), cb4 = *(const uint4*)(pr + 3072), gc4 = *(const uint4*)(pr + 4608);
        uint4 cc1 = *(const uint4*)(pr + 3584), chh1 = *(const uint4*)(pr + 4096);
        uint4 cc0 = z4, chh0 = z4, cc2 = z4, chh2 = z4;
        if (t - 1 >= seq_lo) { cc0 = *(const uint4*)(pr - 8192 + 3584); chh0 = *(const uint4*)(pr - 8192 + 4096); }
        if (t + 1 < seq_hi) { cc2 = *(const uint4*)(pr + 8192 + 3584); chh2 = *(const uint4*)(pr + 8192 + 4096); }
        float hf[8], af[8], hb[8], ab[8], gl[8], cbv[8], gc[8], a0[8], b0[8], a1[8], b1[8], a2[8], b2[8], ol[8], oc[8];
        unpack8(hf4, hf); unpack8(af4, af); unpack8(hb4, hb); unpack8(ab4, ab); unpack8(gl4, gl); unpack8(cb4, cbv); unpack8(gc4, gc);
        unpack8(cc0, a0); unpack8(chh0, b0); unpack8(cc1, a1); unpack8(chh1, b1); unpack8(cc2, a2); unpack8(chh2, b2);
#pragma unroll
        for (int e = 0; e < 8; ++e) {
          float h = (hf[e] + af[e] * cf[e]) + (hb[e] + ab[e] * cb[e]);
          ol[e] = h * silu(gl[e]);
          float conv = w0[e] * (a0[e] * b0[e]) + w1[e] * (a1[e] * b1[e]) + w2[e] * (a2[e] * b2[e]);
          oc[e] = cbv[e] * conv * silu(gc[e]);
        }
        *(uint4*)(p.Alru + (size_t)t * 512 + ch0) = make_uint4(pack2(ol[0], ol[1]), pack2(ol[2], ol[3]), pack2(ol[4], ol[5]), pack2(ol[6], ol[7]));
        *(uint4*)(p.Aconv + (size_t)t * 512 + ch0) = make_uint4(pack2(oc[0], oc[1]), pack2(oc[2], oc[3]), pack2(oc[4], oc[5]), pack2(oc[6], oc[7]));
      }
    }
    __syncthreads();
  }
}

__device__ void phaseC1(const Params& p, int l, char* smem) {
  const int tid = otid512(), lane = tid & 63, wave = tid >> 6;
  const int wm = wave >> 1, wn = wave & 1, fr = lane & 15, fq = lane >> 4;
  for (int id = blockIdx.x; id < 256; id += gridDim.x) {
    const int xcd = id & 7, j_ = id >> 3;
    const int mt = xcd * 4 + (j_ >> 3), nt = j_ & 7;
    const int m0 = mt * 256, n0 = nt * 128;
    f32x4 tot[4][4];
    zero_acc<4, 4>(tot);
#pragma unroll 1
    for (int br = 0; br < 3; ++br) {
      f32x4 acc[4][4];
      zero_acc<4, 4>(acc);
      const u16* A = p.Ana + (size_t)br * 8192 * 512 + (size_t)m0 * 512;
      const u16* B = p.wt_br + (size_t)(l * 3 + br) * 1024 * 512 + (size_t)n0 * 512;
      gemm_mainloop<4, 4, 4, 2, true, false, true>(A, 512, B, 512, 512, acc, smem);
#pragma unroll
      for (int i = 0; i < 4; ++i) {
        const int t = m0 + wm * 64 + i * 16 + fr;
        const int col = n0 + wn * 64 + fq * 16;
        const u16* gp = p.P + (size_t)t * 8192 + 5120 + br * 1024 + col;
        uint4 g0 = *(const uint4*)gp, g1 = *(const uint4*)(gp + 8);
        tot[i][0][0] += sigm(lo16(g0.x)) * acc[i][0][0]; tot[i][0][1] += sigm(hi16(g0.x)) * acc[i][0][1];
        tot[i][0][2] += sigm(lo16(g0.y)) * acc[i][0][2]; tot[i][0][3] += sigm(hi16(g0.y)) * acc[i][0][3];
        tot[i][1][0] += sigm(lo16(g0.z)) * acc[i][1][0]; tot[i][1][1] += sigm(hi16(g0.z)) * acc[i][1][1];
        tot[i][1][2] += sigm(lo16(g0.w)) * acc[i][1][2]; tot[i][1][3] += sigm(hi16(g0.w)) * acc[i][1][3];
        tot[i][2][0] += sigm(lo16(g1.x)) * acc[i][2][0]; tot[i][2][1] += sigm(hi16(g1.x)) * acc[i][2][1];
        tot[i][2][2] += sigm(lo16(g1.y)) * acc[i][2][2]; tot[i][2][3] += sigm(hi16(g1.y)) * acc[i][2][3];
        tot[i][3][0] += sigm(lo16(g1.z)) * acc[i][3][0]; tot[i][3][1] += sigm(hi16(g1.z)) * acc[i][3][1];
        tot[i][3][2] += sigm(lo16(g1.w)) * acc[i][3][2]; tot[i][3][3] += sigm(hi16(g1.w)) * acc[i][3][3];
      }
    }
#pragma unroll
    for (int i = 0; i < 4; ++i) {
      const int t = m0 + wm * 64 + i * 16 + fr;
      const int col = n0 + wn * 64 + fq * 16;
      uint4 w0 = make_uint4(pack2(tot[i][0][0], tot[i][0][1]), pack2(tot[i][0][2], tot[i][0][3]),
                            pack2(tot[i][1][0], tot[i][1][1]), pack2(tot[i][1][2], tot[i][1][3]));
      uint4 w1 = make_uint4(pack2(tot[i][2][0], tot[i][2][1]), pack2(tot[i][2][2], tot[i][2][3]),
                            pack2(tot[i][3][0], tot[i][3][1]), pack2(tot[i][3][2], tot[i][3][3]));
      *(uint4*)(p.merged + (size_t)t * 1024 + col) = w0;
      *(uint4*)(p.merged + (size_t)t * 1024 + col + 8) = w1;
    }
  }
}

__device__ void phaseC2(const Params& p, int l, char* smem) {
  const int tid = otid512(), lane = tid & 63, wave = tid >> 6;
  const int wm = wave >> 1, wn = wave & 1, fr = lane & 15, fq = lane >> 4;
  for (int id = blockIdx.x; id < 256; id += gridDim.x) {
    const int xcd = id & 7, j_ = id >> 3;
    const int mt = xcd * 4 + (j_ >> 3), nt = j_ & 7;
    const int m0 = mt * 256, n0 = nt * 128;
    f32x4 acc[4][4];
    zero_acc<4, 4>(acc);
    gemm_mainloop<4, 4, 4, 2, true, false, true>(p.merged + (size_t)m0 * 1024, 1024,
                                                 p.wt_out + (size_t)l * 1024 * 1024 + (size_t)n0 * 1024, 1024, 1024, acc, smem);
    if (PROBE == 10) {
      gemm_mainloop<4, 4, 4, 2, true, false, true>(p.merged + (size_t)m0 * 1024, 1024,
                                                   p.wt_out + (size_t)l * 1024 * 1024 + (size_t)n0 * 1024, 1024, 1024, acc, smem);
#pragma unroll
      for (int i = 0; i < 4; ++i)
#pragma unroll
        for (int j = 0; j < 4; ++j) acc[i][j] *= 0.5f;
    }
#pragma unroll
    for (int i = 0; i < 4; ++i) {
      const int t = m0 + wm * 64 + i * 16 + fr;
      const int col = n0 + wn * 64 + fq * 16;
      const int cid = t < 4096 ? 0 : 1 + ((t - 4096) >> 11);
      const float* gt = p.mod + (size_t)(l * 3 + cid) * 3072 + 2048 + col;
      float* xr = p.xbuf + (size_t)t * 1024 + col;
#pragma unroll
      for (int j = 0; j < 4; ++j) {
        float4 g4 = *(const float4*)(gt + j * 4);
        float4 xo = *(const float4*)(xr + j * 4);
        *(float4*)(xr + j * 4) = make_float4(xo.x + g4.x * acc[i][j][0], xo.y + g4.y * acc[i][j][1],
                                             xo.z + g4.z * acc[i][j][2], xo.w + g4.w * acc[i][j][3]);
      }
    }
  }
}

#define XB_TMO      128
#define XB_XCNT(j)  (256  + 64 * (j))
#define XB_XSUB(j)  (1280 + 64 * (j))
#define XB_XGEN(j)  (2304 + 64 * (j))
#define XB_TOP      3328
#define XB_TOPGEN   3392
#define XCD_BAR_WORDS 3456
#define XB_SPIN_CAP (1u << 18)
#define LAS __attribute__((address_space(3)))
__device__ __forceinline__ unsigned xb_ld(unsigned* p) { return __hip_atomic_load(p, __ATOMIC_RELAXED, __HIP_MEMORY_SCOPE_AGENT); }
__device__ __forceinline__ unsigned xb_add(unsigned* p, unsigned v) { return __hip_atomic_fetch_add(p, v, __ATOMIC_RELAXED, __HIP_MEMORY_SCOPE_AGENT); }
__device__ __forceinline__ unsigned xb_xcc_id() { return (unsigned)__builtin_amdgcn_s_getreg((3 << 11) | 20) & 0xFu; }
#define XB_SPIN(cond, bar) do { unsigned _sp = 0; while (cond) { __builtin_amdgcn_s_sleep(1); \
    if ((++_sp & 255u) == 0u) { if (xb_ld(&(bar)[XB_TMO])) break; if (_sp > XB_SPIN_CAP) { atomicAdd(&(bar)[XB_TMO], 1u); break; } } } } while (0)
struct XcdBarrier { unsigned* bar; unsigned x; volatile LAS unsigned* st; };
__device__ __forceinline__ XcdBarrier xcd_barrier_post(unsigned* bar, volatile LAS unsigned* st) {
  XcdBarrier b; b.bar = bar; b.x = xb_xcc_id(); b.st = st;
  if (threadIdx.x == 0) (void)xb_add(&bar[XB_XCNT(b.x)], 1u);
  return b;
}
__device__ __forceinline__ void xcd_barrier_complete(unsigned* bar, unsigned x, unsigned& nloc, unsigned& nx) {
  const unsigned G = gridDim.x * gridDim.y * gridDim.z;
  unsigned sum, cnt, mine, sp = 0u;
  for (;;) {
    sum = 0u; cnt = 0u; mine = 0u;
#pragma unroll
    for (unsigned j = 0; j < 16; ++j) { const unsigned c = xb_ld(&bar[XB_XCNT(j)]); sum += c; cnt += (c > 0u) ? 1u : 0u; mine = (j == x) ? c : mine; }
    if (sum == G) break;
    __builtin_amdgcn_s_sleep(1);
    if ((++sp & 255u) == 0u) { if (xb_ld(&bar[XB_TMO])) break; if (sp > XB_SPIN_CAP) { atomicAdd(&bar[XB_TMO], 1u); break; } }
  }
  nloc = mine > 0u ? mine : 1u; nx = cnt > 0u ? cnt : 1u;
}
__device__ __forceinline__ void xcd_barrier(const XcdBarrier& b) {
  asm volatile("s_waitcnt vmcnt(0)" ::: "memory");
  __syncthreads();
  if (threadIdx.x == 0) {
    unsigned* bar = b.bar;
    __builtin_amdgcn_s_waitcnt(0);
    unsigned nloc = b.st[0], nx = b.st[1];
    if (nloc == 0u) { xcd_barrier_complete(bar, b.x, nloc, nx); b.st[0] = nloc; b.st[1] = nx; }
    const unsigned old = xb_add(&bar[XB_XSUB(b.x)], 1u);
    const unsigned gen = old / nloc;
    if (old + 1u == (gen + 1u) * nloc) {
      __builtin_amdgcn_fence(__ATOMIC_RELEASE, "agent");
      asm volatile("s_waitcnt vmcnt(0)" ::: "memory");
      const unsigned og = xb_add(&bar[XB_TOP], 1u);
      const unsigned tg = og / nx;
      if (og + 1u == (tg + 1u) * nx) xb_add(&bar[XB_TOPGEN], 1u);
      else XB_SPIN(xb_ld(&bar[XB_TOPGEN]) == tg, bar);
      __builtin_amdgcn_fence(__ATOMIC_ACQUIRE, "agent");
      xb_add(&bar[XB_XGEN(b.x)], 1u);
      asm volatile("s_waitcnt vmcnt(0)" ::: "memory");
    } else {
      XB_SPIN(xb_ld(&bar[XB_XGEN(b.x)]) == gen, bar);
      __builtin_amdgcn_fence(__ATOMIC_ACQUIRE, "agent");
      asm volatile("s_waitcnt vmcnt(0)" ::: "memory");
    }
  }
  __syncthreads();
}

__global__ void __launch_bounds__(NTHREADS) mega(Params p) {
  extern __shared__ __attribute__((aligned(16))) char dsm[];
  char* smem = dsm;
  char* hsm = dsm + __builtin_amdgcn_readfirstlane((int)(threadIdx.x >> 8)) * 65536;
  cg::grid_group grid = cg::this_grid();
  if (threadIdx.x == 0) *(uint4*)(dsm + SMEM_BYTES) = make_uint4(0u, 0u, 0u, 0u);
  __syncthreads();
  XcdBarrier xb = xcd_barrier_post(p.bar, (volatile LAS unsigned*)(dsm + SMEM_BYTES));
  const int lo = p.phase_lo, hi = p.phase_hi;
  if (hi > 1000) grid.sync();
#define GRID_SYNC() xcd_barrier(xb)
#define RUN_PHASE(PH, CALL) { const int ph_ = (PH); if (ph_ >= lo && ph_ < hi) { CALL; if (ph_ + 1 < hi) GRID_SYNC(); } }
#define RUN_PHASE_REP(PID, PH, CALL) { RUN_PHASE(PH, CALL); if (PROBE == (PID)) { RUN_PHASE(PH, CALL); } }
  RUN_PHASE_REP(1, 0, phase0(p, hsm));
#pragma unroll 1
  for (int l = 0; l < 4; ++l) {
    RUN_PHASE_REP(2, 1 + l * 6, phaseN(p, l));
    RUN_PHASE_REP(3, 2 + l * 6, phaseA(p, l, smem));
    RUN_PHASE_REP(4, 3 + l * 6, phaseB(p, l, hsm));
    if (PROBE == 8) { phaseB(p, l, hsm, 1); GRID_SYNC(); }
    if (PROBE == 9) { phaseB(p, l, hsm, 2); GRID_SYNC(); }
    RUN_PHASE_REP(5, 4 + l * 6, phaseB2(p, l, hsm));
    RUN_PHASE_REP(6, 5 + l * 6, phaseC1(p, l, smem));
    RUN_PHASE(6 + l * 6, phaseC2(p, l, smem));
    if (PROBE == 7) { for (int e = 0; e < 6; ++e) GRID_SYNC(); }
  }
  RUN_PHASE(25, phaseF(p));
}

extern "C" void kernel_launch(void* const* d_in, const int* in_sizes, int n_in, void* d_out, int out_size, void* d_ws,
                              size_t ws_size, hipStream_t stream) {
  static int grid_blocks = 0;
  if (!grid_blocks) {
    int dev = 0, cus = 0, per_cu = 0;
    hipGetDevice(&dev);
    hipDeviceGetAttribute(&cus, hipDeviceAttributeMultiprocessorCount, dev);
    hipFuncSetAttribute((const void*)mega, hipFuncAttributeMaxDynamicSharedMemorySize, DYN_LDS);
    hipOccupancyMaxActiveBlocksPerMultiprocessor(&per_cu, mega, NTHREADS, DYN_LDS);
    if (per_cu > 1) per_cu = 1;
    if (per_cu < 1) per_cu = 1;
    grid_blocks = cus * per_cu;
  }
  Params p;
  memset(&p, 0, sizeof(p));
  const float** fp = (const float**)&p;
  for (int i = 0; i < 25; ++i) fp[i] = (const float*)d_in[i];
  p.out = (float*)d_out;
  char* w = (char*)d_ws;
  size_t off = 0;
  auto take = [&](size_t bytes) { char* r = w + off; off += (bytes + 255) & ~(size_t)255; return r; };
  p.wt_in = (u16*)take((size_t)4 * 8192 * 1024 * 2);
  p.wt_br = (u16*)take((size_t)4 * 3 * 1024 * 512 * 2);
  p.wt_out = (u16*)take((size_t)4 * 1024 * 1024 * 2);
  p.wgT = (u16*)take((size_t)128 * 4096 * 2);
  p.ckb = (u16*)take((size_t)2 * 4 * 256 * 512 * 2);
  p.cvT = (u16*)take((size_t)2 * 4 * 256 * 512 * 2);
  p.xm = (u16*)take((size_t)8192 * 1024 * 2);
  p.P = (u16*)take((size_t)8192 * 8192 * 2);
  p.Vt = (u16*)take((size_t)512 * 8192 * 2);
  p.Ana = (u16*)take((size_t)8192 * 512 * 2);
  p.Alru = (u16*)take((size_t)8192 * 512 * 2);
  p.Aconv = (u16*)take((size_t)8192 * 512 * 2);
  p.merged = (u16*)take((size_t)8192 * 1024 * 2);
  p.hloc = (u16*)take((size_t)2 * 8192 * 512 * 2);
  p.acum = (u16*)take((size_t)2 * 8192 * 512 * 2);
  p.mod = (float*)take((size_t)4 * 3 * 3072 * 4);
  p.xbuf = (float*)take((size_t)8192 * 1024 * 4);
  p.Atot = (float*)take((size_t)128 * 2 * 512 * 4);
  p.Htot = (float*)take((size_t)128 * 2 * 512 * 4);
  p.sp8 = (float*)take((size_t)4096 * 4);
  p.bar = (unsigned*)take((size_t)XCD_BAR_WORDS * 4);
  if (off > ws_size) { fprintf(stderr, "workspace too small: need %zu have %zu\n", off, ws_size); return; }
#ifdef MULTI_LAUNCH
  for (int ph = 0; ph < 26; ++ph) {
    p.phase_lo = ph; p.phase_hi = ph + 1;
    hipLaunchKernelGGL(mega, dim3(grid_blocks), dim3(NTHREADS), DYN_LDS, stream, p);
  }
#else
  p.phase_lo = 0; p.phase_hi = 26;
  hipMemsetAsync(p.bar, 0, (size_t)XCD_BAR_WORDS * 4, stream);
  void* args[] = {&p};
  hipError_t e = hipLaunchCooperativeKernel((void*)mega, dim3(grid_blocks), dim3(NTHREADS), args, DYN_LDS, stream);
  if (e != hipSuccess) fprintf(stderr, "cooperative launch failed: %s (grid %d)\n", hipGetErrorString(e), grid_blocks);
#endif
}
```

```cpp
#include <hip/hip_runtime.h>
#include <hip/hip_cooperative_groups.h>
#include <cstdio>
#include <cstring>
namespace cg = cooperative_groups;

typedef unsigned short u16;
using bf16x8 = __attribute__((ext_vector_type(8))) short;
using f32x4 = __attribute__((ext_vector_type(4))) float;
using u32x4 = __attribute__((ext_vector_type(4))) unsigned;

#ifndef PROBE
#define PROBE 0
#endif
#define NTHREADS 512
#define SMEM_BYTES 131072
#define DYN_LDS (SMEM_BYTES + 64)

struct Params {
  const float *x_prompt, *x_sample, *cache_k, *cache_v, *state_lru, *c, *c_ctx, *norm_g, *w_mod, *b_mod,
      *w_in, *na_rpb, *lru_conv_w, *lru_conv_b, *lru_wa, *lru_ba, *lru_wx, *lru_bx, *lru_lam, *conv_w,
      *w_br_na, *w_br_lru, *w_br_conv, *w_out, *final_g;
  float* out;
  u16 *wt_in, *wt_br, *wt_out, *wgT, *ckb, *cvT, *xm, *P, *Vt, *Ana, *Alru, *Aconv, *merged, *hloc, *acum;
  float *mod, *xbuf, *Atot, *Htot, *sp8;
  unsigned* bar;
  int phase_lo, phase_hi;
};

__device__ __forceinline__ int otid() { int t = threadIdx.x & 255; asm volatile("" : "+v"(t)); return t; }
__device__ __forceinline__ int otid512() { int t = threadIdx.x; asm volatile("" : "+v"(t)); return t; }
__device__ __forceinline__ int vbid() { return blockIdx.x * 2 + __builtin_amdgcn_readfirstlane((int)(threadIdx.x >> 8)); }
#define NVB ((int)gridDim.x * 2)
__device__ __forceinline__ unsigned f2bf(float f) {
  unsigned u = __float_as_uint(f);
  u += 0x7fffu + ((u >> 16) & 1u);
  return u >> 16;
}
__device__ __forceinline__ float bf2f(unsigned h) { return __uint_as_float(h << 16); }
__device__ __forceinline__ unsigned pack2(float a, float b) { return f2bf(a) | (f2bf(b) << 16); }
__device__ __forceinline__ float sigm(float x) { return __builtin_amdgcn_rcpf(1.f + __expf(-x)); }
__device__ __forceinline__ float silu(float x) { return x * __builtin_amdgcn_rcpf(1.f + __expf(-x)); }
__device__ __forceinline__ float lo16(unsigned w) { return __uint_as_float(w << 16); }
__device__ __forceinline__ float hi16(unsigned w) { return __uint_as_float(w & 0xffff0000u); }

__device__ void transpose_unit(const float* __restrict__ src, int N, u16* __restrict__ dst, int K, int k0, int n0,
                               float* sm) {
  const int tid = otid();
#pragma unroll
  for (int i = 0; i < 4; ++i) {
    int r = (tid >> 4) + i * 16, c4 = (tid & 15) * 4;
    float4 v = *(const float4*)(src + (size_t)(k0 + r) * N + n0 + c4);
    sm[r * 65 + c4 + 0] = v.x; sm[r * 65 + c4 + 1] = v.y; sm[r * 65 + c4 + 2] = v.z; sm[r * 65 + c4 + 3] = v.w;
  }
  __syncthreads();
  const int n = tid >> 2, kq = (tid & 3) * 16;
  unsigned w[8];
#pragma unroll
  for (int kk = 0; kk < 8; ++kk) w[kk] = pack2(sm[(kq + 2 * kk) * 65 + n], sm[(kq + 2 * kk + 1) * 65 + n]);
  uint4* d = (uint4*)(dst + (size_t)(n0 + n) * K + k0 + kq);
  d[0] = make_uint4(w[0], w[1], w[2], w[3]);
  d[1] = make_uint4(w[4], w[5], w[6], w[7]);
  __syncthreads();
}

__device__ void phase0(const Params& p, char* smem) {
  float* sm = (float*)smem;
  const int tid = otid();
  const int NU = 384 + 8192 + 1536 + 1024 + 512 + 512 + 128 + 2048;
  for (int u = vbid(); u < NU; u += NVB) {
    int v = u;
    if (v < 384) {
      int l = v / 96, cgp = v % 96;
      int c = cgp * 32 + (tid & 31), kg = tid >> 5;
      float a0 = 0.f, a1 = 0.f, a2 = 0.f;
      const float* w = p.w_mod + (size_t)l * 1024 * 3072 + c;
      for (int k = kg * 128; k < kg * 128 + 128; ++k) {
        float wv = w[(size_t)k * 3072];
        a0 += silu(p.c_ctx[k]) * wv; a1 += silu(p.c[k]) * wv; a2 += silu(p.c[1024 + k]) * wv;
      }
      sm[(kg * 3 + 0) * 32 + (tid & 31)] = a0;
      sm[(kg * 3 + 1) * 32 + (tid & 31)] = a1;
      sm[(kg * 3 + 2) * 32 + (tid & 31)] = a2;
      __syncthreads();
      if (tid < 96) {
        int cond = tid >> 5, cc = tid & 31;
        float s = p.b_mod[l * 3072 + cgp * 32 + cc];
#pragma unroll
        for (int g = 0; g < 8; ++g) s += sm[(g * 3 + cond) * 32 + cc];
        p.mod[(size_t)(l * 3 + cond) * 3072 + cgp * 32 + cc] = s;
      }
      __syncthreads();
      continue;
    }
    v -= 384;
    if (v < 8192) {
      int l = v >> 11, r = v & 2047, kt = r >> 7, nt = r & 127;
      transpose_unit(p.w_in + (size_t)l * 1024 * 8192, 8192, p.wt_in + (size_t)l * 8192 * 1024, 1024, kt * 64, nt * 64, sm);
      continue;
    }
    v -= 8192;
    if (v < 1536) {
      int l = v / 384, r = v % 384, br = r >> 7, q = r & 127, kt = q >> 4, nt = q & 15;
      u16* dst = p.wt_br + (size_t)(l * 3 + br) * 1024 * 512;
      if (br == 0) transpose_unit(p.w_br_na + (size_t)l * 512 * 1024, 1024, dst, 512, kt * 64, nt * 64, sm);
      else if (br == 1) transpose_unit(p.w_br_lru + (size_t)l * 512 * 1024, 1024, dst, 512, kt * 64, nt * 64, sm);
      else transpose_unit(p.w_br_conv + (size_t)l * 512 * 1024, 1024, dst, 512, kt * 64, nt * 64, sm);
      continue;
    }
    v -= 1536;
    if (v < 1024) {
      int l = v >> 8, r = v & 255, kt = r >> 4, nt = r & 15;
      transpose_unit(p.w_out + (size_t)l * 1024 * 1024, 1024, p.wt_out + (size_t)l * 1024 * 1024, 1024, kt * 64, nt * 64, sm);
      continue;
    }
    v -= 1024;
    if (v < 512) {
      size_t idx = ((size_t)v * 256 + tid) * 8;
      float4 a = *(const float4*)(p.cache_k + idx), b = *(const float4*)(p.cache_k + idx + 4);
      *(uint4*)(p.ckb + idx) = make_uint4(pack2(a.x, a.y), pack2(a.z, a.w), pack2(b.x, b.y), pack2(b.z, b.w));
      continue;
    }
    v -= 512;
    if (v < 512) {
      int g = v * 256 + tid;
      int d = g & 63, h = (g >> 6) & 7, kg = (g >> 9) & 31, bl = g >> 14;
      float f[8];
#pragma unroll
      for (int j = 0; j < 8; ++j) f[j] = p.cache_v[((size_t)(bl * 256 + kg * 8 + j) * 8 + h) * 64 + d];
      *(uint4*)(p.cvT + ((size_t)(bl * 8 + h) * 64 + d) * 256 + kg * 8) =
          make_uint4(pack2(f[0], f[1]), pack2(f[2], f[3]), pack2(f[4], f[5]), pack2(f[6], f[7]));
      continue;
    }
    v -= 512;
    if (v >= 128) {
      v -= 128;
      const size_t o = ((size_t)(v & 1023) * 256 + tid) * 16;
      if (v < 1024) {
#pragma unroll
        for (int i = 0; i < 4; ++i) *(float4*)(p.xbuf + o + i * 4) = *(const float4*)(p.x_prompt + o + i * 4);
      } else {
#pragma unroll
        for (int i = 0; i < 4; ++i) *(float4*)(p.xbuf + 4194304 + o + i * 4) = *(const float4*)(p.x_sample + o + i * 4);
      }
      continue;
    }
    {
      int blk = v & 7, gate = (v >> 3) & 1, dir = (v >> 4) & 1, l = v >> 5;
      if (v == 0) {
        for (int i = tid; i < 4096; i += 256) p.sp8[i] = 8.f * log1pf(expf(-p.lru_lam[i]));
      }
      const size_t so = (size_t)((l * 2 + dir) * 8 + blk) * 4096;
      u16* dst = p.wgT + (size_t)v * 4096;
      for (int idx = tid; idx < 4096; idx += 256) {
        int k = idx >> 6, j = idx & 63;
        float wv;
        if (gate) wv = p.lru_wx[so + j * 64 + k]; else wv = p.lru_wa[so + j * 64 + k];
        dst[idx] = (u16)f2bf(wv);
      }
    }
  }
}

__device__ __forceinline__ const float* xrow(const Params& p, int l, int t) {
  return p.xbuf + (size_t)t * 1024;
}
__device__ __forceinline__ float wave_sum(float v) {
#pragma unroll
  for (int o = 32; o >= 1; o >>= 1) v += __shfl_xor(v, o);
  return v;
}

__device__ void phaseN(const Params& p, int l) {
  const int lane = otid() & 63, wave = otid() >> 6;
  const float* g = p.norm_g + l * 1024;
  for (int t = vbid() * 4 + wave; t < 8192; t += NVB * 4) {
    const float* x = xrow(p, l, t);
    float4 v[4];
    float ss = 0.f;
#pragma unroll
    for (int i = 0; i < 4; ++i) {
      v[i] = *(const float4*)(x + i * 256 + lane * 4);
      ss += v[i].x * v[i].x + v[i].y * v[i].y + v[i].z * v[i].z + v[i].w * v[i].w;
    }
    ss = wave_sum(ss);
    float rstd = rsqrtf(ss * (1.f / 1024.f) + 1e-6f);
    int cid = t < 4096 ? 0 : 1 + ((t - 4096) >> 11);
    const float* md = p.mod + (size_t)(l * 3 + cid) * 3072;
#pragma unroll
    for (int i = 0; i < 4; ++i) {
      int c = i * 256 + lane * 4;
      float4 gg = *(const float4*)(g + c), sh = *(const float4*)(md + c), sc = *(const float4*)(md + 1024 + c);
      float y0 = v[i].x * rstd * gg.x * (1.f + sc.x) + sh.x;
      float y1 = v[i].y * rstd * gg.y * (1.f + sc.y) + sh.y;
      float y2 = v[i].z * rstd * gg.z * (1.f + sc.z) + sh.z;
      float y3 = v[i].w * rstd * gg.w * (1.f + sc.w) + sh.w;
      *(uint2*)(p.xm + (size_t)t * 1024 + c) = make_uint2(pack2(y0, y1), pack2(y2, y3));
    }
  }
}

__device__ void phaseF(const Params& p) {
  const int lane = otid() & 63, wave = otid() >> 6;
  for (int t = vbid() * 4 + wave; t < 8192; t += NVB * 4) {
    const float* x = p.xbuf + (size_t)t * 1024;
    float4 v[4];
    float ss = 0.f;
#pragma unroll
    for (int i = 0; i < 4; ++i) {
      v[i] = *(const float4*)(x + i * 256 + lane * 4);
      ss += v[i].x * v[i].x + v[i].y * v[i].y + v[i].z * v[i].z + v[i].w * v[i].w;
    }
    ss = wave_sum(ss);
    float rstd = rsqrtf(ss * (1.f / 1024.f) + 1e-6f);
#pragma unroll
    for (int i = 0; i < 4; ++i) {
      int c = i * 256 + lane * 4;
      float4 gg = *(const float4*)(p.final_g + c);
      *(float4*)(p.out + (size_t)t * 1024 + c) =
          make_float4(v[i].x * rstd * gg.x, v[i].y * rstd * gg.y, v[i].z * rstd * gg.z, v[i].w * rstd * gg.w);
    }
  }
}

__device__ __forceinline__ int perm64(int r) { return (r & 0x43) | ((r & 0x30) >> 2) | ((r & 0x0c) << 2); }

template <int MI, int NJ, int WM, int WN, bool SWAP, bool PERM_A, bool PERM_B>
__device__ __forceinline__ void gemm_mainloop64(const u16* __restrict__ A, int lda, const u16* __restrict__ B, int ldb,
                                              int K, f32x4 (&acc)[MI][NJ], char* smem) {
  constexpr int AR = WM * MI * 16, BR = WN * NJ * 16;
  constexpr int A_BYTES = AR * 128, STAGE = (AR + BR) * 128;
  const int tid = otid512(), lane = tid & 63, wave = tid >> 6;
  const int wm = wave / WN, wn = wave % WN, fr = lane & 15, fq = lane >> 4;
  const int lr = tid >> 3, lc = (tid & 7) ^ ((lr >> 1) & 7);
  const u16* ag = A + (size_t)(PERM_A ? perm64(lr) : lr) * lda + lc * 8;
  const u16* bg = B + (size_t)(PERM_B ? perm64(lr) : lr) * ldb + lc * 8;
  char* sA = smem + tid * 16;
  char* sB = smem + A_BYTES + tid * 16;
#define GLDS(gp, lp) __builtin_amdgcn_global_load_lds((const unsigned*)(gp), (unsigned*)(lp), 16, 0, 0)
#pragma unroll
  for (int i = 0; i < AR / 64; ++i) GLDS(ag + (size_t)i * 64 * lda, sA + i * 8192);
#pragma unroll
  for (int i = 0; i < BR / 64; ++i) GLDS(bg + (size_t)i * 64 * ldb, sB + i * 8192);
  asm volatile("s_waitcnt vmcnt(0)" ::: "memory");
  __syncthreads();
  const int swz_r = (fr >> 1) & 7;
  const int aoff = (wm * MI * 16 + fr) * 128, boff = A_BYTES + (wn * NJ * 16 + fr) * 128;
  const int nk = K >> 6;
  for (int kt = 0; kt < nk; ++kt) {
    const int cur = kt & 1;
    if (kt + 1 < nk) {
#pragma unroll
      for (int i = 0; i < AR / 64; ++i) GLDS(ag + (size_t)i * 64 * lda + (kt + 1) * 64, sA + (cur ^ 1) * STAGE + i * 8192);
#pragma unroll
      for (int i = 0; i < BR / 64; ++i) GLDS(bg + (size_t)i * 64 * ldb + (kt + 1) * 64, sB + (cur ^ 1) * STAGE + i * 8192);
    }
    __builtin_amdgcn_sched_barrier(0);
    const char* cA = smem + cur * STAGE + aoff;
    const char* cB = smem + cur * STAGE + boff;
    bf16x8 af[2][MI], bfr[2][NJ];
#pragma unroll
    for (int ks = 0; ks < 2; ++ks) {
      const int ch = ((ks * 4 + fq) ^ swz_r) << 4;
#pragma unroll
      for (int j = 0; j < NJ; ++j) bfr[ks][j] = *(const bf16x8*)(cB + j * 2048 + ch);
#pragma unroll
      for (int i = 0; i < MI; ++i) af[ks][i] = *(const bf16x8*)(cA + i * 2048 + ch);
    }
#pragma unroll
    for (int ks = 0; ks < 2; ++ks)
#pragma unroll
      for (int i = 0; i < MI; ++i)
#pragma unroll
        for (int j = 0; j < NJ; ++j) {
          if (SWAP) acc[i][j] = __builtin_amdgcn_mfma_f32_16x16x32_bf16(bfr[ks][j], af[ks][i], acc[i][j], 0, 0, 0);
          else acc[i][j] = __builtin_amdgcn_mfma_f32_16x16x32_bf16(af[ks][i], bfr[ks][j], acc[i][j], 0, 0, 0);
        }
    __builtin_amdgcn_sched_group_barrier(0x100, 8, 0);
#pragma unroll
    for (int g = 0; g < 2 * (MI + NJ) - 8; ++g) {
      __builtin_amdgcn_sched_group_barrier(0x008, 2, 0);
      __builtin_amdgcn_sched_group_barrier(0x100, 1, 0);
    }
    __builtin_amdgcn_sched_group_barrier(0x008, 2 * MI * NJ - 2 * (2 * (MI + NJ) - 8), 0);
    __builtin_amdgcn_sched_barrier(0);
    asm volatile("s_waitcnt vmcnt(0)" ::: "memory");
    __builtin_amdgcn_s_barrier();
    asm volatile("" ::: "memory");
  }
#undef GLDS
}

template <int N> __device__ __forceinline__ void wait_vmcnt() {
  if (N == 0) asm volatile("s_waitcnt vmcnt(0)" ::: "memory");
  else if (N == 3) asm volatile("s_waitcnt vmcnt(3)" ::: "memory");
  else if (N == 4) asm volatile("s_waitcnt vmcnt(4)" ::: "memory");
  else if (N == 6) asm volatile("s_waitcnt vmcnt(6)" ::: "memory");
  else if (N == 8) asm volatile("s_waitcnt vmcnt(8)" ::: "memory");
  else asm volatile("s_waitcnt vmcnt(0)" ::: "memory");
}

template <int MI, int NJ, int WM, int WN, bool SWAP, bool PERM_A, bool PERM_B>
__device__ __forceinline__ void gemm_mainloop(const u16* __restrict__ A, int lda, const u16* __restrict__ B, int ldb,
                                              int K, f32x4 (&acc)[MI][NJ], char* smem) {
  constexpr int AR = WM * MI * 16, BR = WN * NJ * 16;
  constexpr int A_BYTES = AR * 64, STAGE = (AR + BR) * 64;
  constexpr int LA = AR / 128, LB = BR / 128, NL = LA + LB;
  const int tid = otid512(), lane = tid & 63, wave = tid >> 6;
  const int wm = wave / WN, wn = wave % WN, fr = lane & 15, fq = lane >> 4;
  const int lr = tid >> 2, lc = (tid & 3) ^ ((4 - ((lr >> 2) & 3)) & 3);
  const u16* ag = A + (size_t)(PERM_A ? perm64(lr) : lr) * lda + lc * 8;
  const u16* bg = B + (size_t)(PERM_B ? perm64(lr) : lr) * ldb + lc * 8;
  char* sA = smem + tid * 16;
  char* sB = smem + A_BYTES + tid * 16;
#define GLDS(gp, lp) __builtin_amdgcn_global_load_lds((const unsigned*)(gp), (unsigned*)(lp), 16, 0, 0)
#define ISSUE_TILE(kt_, st_)                                                                         \
  {                                                                                                  \
    _Pragma("unroll") for (int i = 0; i < LA; ++i)                                                   \
        GLDS(ag + (size_t)i * 128 * lda + (kt_) * 32, sA + (st_) * STAGE + i * 8192);                \
    _Pragma("unroll") for (int i = 0; i < LB; ++i)                                                   \
        GLDS(bg + (size_t)i * 128 * ldb + (kt_) * 32, sB + (st_) * STAGE + i * 8192);                \
  }
  const int nk = K >> 5;
  ISSUE_TILE(0, 0);
  ISSUE_TILE(1, 1);
  ISSUE_TILE(2, 2);
  const int rch = (fq ^ ((4 - ((fr >> 2) & 3)) & 3)) << 4;
  const int aoff = (wm * MI * 16 + fr) * 64 + rch, boff = A_BYTES + (wn * NJ * 16 + fr) * 64 + rch;
  for (int kt = 0; kt < nk; ++kt) {
    if (kt + 2 < nk) wait_vmcnt<2 * NL>();
    else if (kt + 1 < nk) wait_vmcnt<NL>();
    else wait_vmcnt<0>();
    __builtin_amdgcn_s_barrier();
    asm volatile("" ::: "memory");
    if (kt + 3 < nk) ISSUE_TILE(kt + 3, (kt + 3) & 3);
    const char* cA = smem + (kt & 3) * STAGE + aoff;
    const char* cB = smem + (kt & 3) * STAGE + boff;
    bf16x8 af[MI], bfr[NJ];
#pragma unroll
    for (int j = 0; j < NJ; ++j) bfr[j] = *(const bf16x8*)(cB + j * 1024);
#pragma unroll
    for (int i = 0; i < MI; ++i) af[i] = *(const bf16x8*)(cA + i * 1024);
#pragma unroll
    for (int i = 0; i < MI; ++i)
#pragma unroll
      for (int j = 0; j < NJ; ++j) {
        if (SWAP) acc[i][j] = __builtin_amdgcn_mfma_f32_16x16x32_bf16(bfr[j], af[i], acc[i][j], 0, 0, 0);
        else acc[i][j] = __builtin_amdgcn_mfma_f32_16x16x32_bf16(af[i], bfr[j], acc[i][j], 0, 0, 0);
      }
  }
  __syncthreads();
#undef ISSUE_TILE
#undef GLDS
}

template <int MI, int NJ>
__device__ __forceinline__ void zero_acc(f32x4 (&acc)[MI][NJ]) {
#pragma unroll
  for (int i = 0; i < MI; ++i)
#pragma unroll
    for (int j = 0; j < NJ; ++j) acc[i][j] = f32x4{0.f, 0.f, 0.f, 0.f};
}

__device__ void phaseA(const Params& p, int l, char* smem) {
  const int tid = otid512(), lane = tid & 63, wave = tid >> 6;
  const int wm = wave >> 2, wn = wave & 3, fr = lane & 15, fq = lane >> 4;
  const u16* W = p.wt_in + (size_t)l * 8192 * 1024;
  float* newk = p.out + 8388608;
  float* newv = p.out + 16777216;
  for (int id = blockIdx.x; id < 1024; id += gridDim.x) {
    const int xcd = id & 7, j_ = id >> 3;
    const int mt = xcd * 4 + (j_ & 3), nt = (j_ >> 5) * 8 + ((j_ >> 2) & 7);
    const int m0 = mt * 256, n0 = nt * 256;
    f32x4 acc[8][4];
    zero_acc<8, 4>(acc);
    const u16* A = p.xm + (size_t)m0 * 1024;
    const u16* B = W + (size_t)n0 * 1024;
    if (n0 >= 1024 && n0 < 1536) {
      gemm_mainloop64<8, 4, 2, 4, false, true, false>(A, 1024, B, 1024, 1024, acc, smem);
#pragma unroll
      for (int g = 0; g < 2; ++g)
#pragma unroll
        for (int j = 0; j < 4; ++j) {
          const int tok0 = m0 + wm * 128 + g * 64 + fq * 16;
          const int vc = n0 + wn * 64 + j * 16 + fr - 1024;
          uint4 w0 = make_uint4(pack2(acc[g * 4 + 0][j][0], acc[g * 4 + 0][j][1]), pack2(acc[g * 4 + 0][j][2], acc[g * 4 + 0][j][3]),
                                pack2(acc[g * 4 + 1][j][0], acc[g * 4 + 1][j][1]), pack2(acc[g * 4 + 1][j][2], acc[g * 4 + 1][j][3]));
          uint4 w1 = make_uint4(pack2(acc[g * 4 + 2][j][0], acc[g * 4 + 2][j][1]), pack2(acc[g * 4 + 2][j][2], acc[g * 4 + 2][j][3]),
                                pack2(acc[g * 4 + 3][j][0], acc[g * 4 + 3][j][1]), pack2(acc[g * 4 + 3][j][2], acc[g * 4 + 3][j][3]));
          *(uint4*)(p.Vt + (size_t)vc * 8192 + tok0) = w0;
          *(uint4*)(p.Vt + (size_t)vc * 8192 + tok0 + 8) = w1;
          if (tok0 < 4096) {
#pragma unroll
            for (int i4 = 0; i4 < 4; ++i4)
#pragma unroll
              for (int jj = 0; jj < 4; ++jj) {
                const int t = tok0 + i4 * 4 + jj;
                newv[((size_t)((t >> 8) * 4 + l) * 256 + (t & 255)) * 512 + vc] = acc[g * 4 + i4][j][jj];
              }
          }
        }
    } else {
      gemm_mainloop64<8, 4, 2, 4, true, false, true>(A, 1024, B, 1024, 1024, acc, smem);
      const bool isK = (n0 >= 512 && n0 < 1024);
#pragma unroll
      for (int i = 0; i < 8; ++i) {
        const int t = m0 + wm * 128 + i * 16 + fr;
        const int col = n0 + wn * 64 + fq * 16;
        uint4 w0 = make_uint4(pack2(acc[i][0][0], acc[i][0][1]), pack2(acc[i][0][2], acc[i][0][3]),
                              pack2(acc[i][1][0], acc[i][1][1]), pack2(acc[i][1][2], acc[i][1][3]));
        uint4 w1 = make_uint4(pack2(acc[i][2][0], acc[i][2][1]), pack2(acc[i][2][2], acc[i][2][3]),
                              pack2(acc[i][3][0], acc[i][3][1]), pack2(acc[i][3][2], acc[i][3][3]));
        *(uint4*)(p.P + (size_t)t * 8192 + col) = w0;
        *(uint4*)(p.P + (size_t)t * 8192 + col + 8) = w1;
        if (isK && t < 4096) {
          float* dst = newk + ((size_t)((t >> 8) * 4 + l) * 256 + (t & 255)) * 512 + (col - 512);
#pragma unroll
          for (int j = 0; j < 4; ++j) *(float4*)(dst + j * 4) = make_float4(acc[i][j][0], acc[i][j][1], acc[i][j][2], acc[i][j][3]);
        }
      }
    }
  }
}

__device__ __forceinline__ bf16x8 ld16(const u16* ptr) { return *(const bf16x8*)ptr; }

__device__ void attn_item(const Params& p, int l, int item, char* smem) {
  const int tid = otid(), lane = tid & 63, fr = lane & 15, fq = lane >> 4;
  const int wave = __builtin_amdgcn_readfirstlane(tid >> 6);
  const bool lat = item >= 512;
  int b, h, qtok0, r = 0, n = 0, row0 = 0, band0 = 0;
  if (!lat) {
    const int unit = item * 4 + wave;
    b = unit >> 7; h = (unit >> 4) & 7;
    qtok0 = b * 256 + (unit & 15) * 16;
  } else {
    const int u = (item - 512) * 4 + wave;
    b = u >> 10; r = (u >> 5) & 31; h = (u >> 2) & 7; n = u & 3;
    qtok0 = 4096 + b * 2048 + r * 64 + n * 16;
    row0 = min(max(r - 4, 0), 24);
    band0 = min(max(16 * n - 8, 0), 32);
  }
  float* rpb = (float*)(smem + 57344 + wave * 2048);
  if (lat) {
    const float* rg = p.na_rpb + (size_t)(l * 8 + h) * 15 * 31;
#pragma unroll
    for (int i = 0; i < 8; ++i) {
      const int idx = lane + 64 * i;
      if (idx < 465) rpb[idx] = rg[idx];
    }
  }
  const u16* qp = p.P + (size_t)(qtok0 + fr) * 8192 + h * 64 + fq * 8;
  const bf16x8 q0 = ld16(qp), q1 = ld16(qp + 32);
  f32x4 o[4];
#pragma unroll
  for (int dt = 0; dt < 4; ++dt) o[dt] = f32x4{0.f, 0.f, 0.f, 0.f};
  float m = -1e30f, lsum = 0.f;
  const int qc = 16 * n + fr;
  const int wst = min(max(qc - 8, 0), 48);
  const int nch = lat ? 12 : 4;
  const int lrow = tid >> 3, lpc = tid & 7;
  const int klc = lpc ^ (((lrow >> 1) & 1) | (((lrow >> 3) & 3) << 1));
  const int vlc = lpc ^ ((lrow >> 1) & 7);
#define GLDS(gp, lp) __builtin_amdgcn_global_load_lds((const unsigned*)(gp), (unsigned*)(lp), 16, 0, 0)
#define ISSUE_CHUNK(c)                                                                                           \
  {                                                                                                              \
    const u16 *kb_, *vb_; size_t ks_, vs_;                                                                       \
    if (!lat) {                                                                                                  \
      const size_t key0 = (size_t)b * 256 + (c) * 64;                                                            \
      kb_ = p.P + key0 * 8192 + 512 + h * 64; ks_ = 8192;                                                        \
      vb_ = p.Vt + (size_t)(h * 64) * 8192 + key0; vs_ = 8192;                                                   \
    } else if ((c) < 8) {                                                                                        \
      const size_t tok = 4096 + (size_t)b * 2048 + (row0 + (c)) * 64;                                            \
      kb_ = p.P + tok * 8192 + 512 + h * 64; ks_ = 8192;                                                         \
      vb_ = p.Vt + (size_t)(h * 64) * 8192 + tok; vs_ = 8192;                                                    \
    } else {                                                                                                     \
      kb_ = p.ckb + ((size_t)(b * 4 + l) * 256 + ((c) - 8) * 64) * 512 + h * 64; ks_ = 512;                      \
      vb_ = p.cvT + (size_t)((b * 4 + l) * 8 + h) * 64 * 256 + ((c) - 8) * 64; vs_ = 256;                        \
    }                                                                                                            \
    char* dst_ = smem + ((c) & 1) * 16384 + tid * 16;                                                            \
    GLDS(kb_ + (size_t)lrow * ks_ + klc * 8, dst_);                                                              \
    GLDS(kb_ + (size_t)(lrow + 32) * ks_ + klc * 8, dst_ + 4096);                                                \
    GLDS(vb_ + (size_t)lrow * vs_ + vlc * 8, dst_ + 8192);                                                       \
    GLDS(vb_ + (size_t)(lrow + 32) * vs_ + vlc * 8, dst_ + 12288);                                               \
  }
  ISSUE_CHUNK(0);
#pragma unroll 1
  for (int c = 0; c < nch; ++c) {
    asm volatile("s_waitcnt vmcnt(0) lgkmcnt(0)" ::: "memory");
    __syncthreads();
    if (c + 1 < nch) ISSUE_CHUNK(c + 1);
    const char* kbuf = smem + (c & 1) * 16384;
    const char* vbuf = kbuf + 8192;
    const bool local = lat && c < 8;
    const int nsl = local ? 1 : 2;
    const int row_off = row0 + c - r + 7;
#pragma unroll 1
    for (int sl = 0; sl < nsl; ++sl) {
      const int koff = local ? band0 : sl * 32;
      f32x4 s[2];
#pragma unroll
      for (int e = 0; e < 2; ++e) {
        const int krow = koff + (fr >> 2) * 8 + e * 4 + (fr & 3);
        const int fk = ((krow >> 1) & 1) | (((krow >> 3) & 3) << 1);
        const bf16x8 a0 = *(const bf16x8*)(kbuf + krow * 128 + ((fq ^ fk) << 4));
        const bf16x8 a1 = *(const bf16x8*)(kbuf + krow * 128 + (((4 + fq) ^ fk) << 4));
        f32x4 z = f32x4{0.f, 0.f, 0.f, 0.f};
        z = __builtin_amdgcn_mfma_f32_16x16x32_bf16(a0, q0, z, 0, 0, 0);
        s[e] = __builtin_amdgcn_mfma_f32_16x16x32_bf16(a1, q1, z, 0, 0, 0);
      }
      bf16x8 vf[4];
#pragma unroll
      for (int dt = 0; dt < 4; ++dt) {
        const int drow = dt * 16 + fr;
        vf[dt] = *(const bf16x8*)(vbuf + drow * 128 + ((((koff >> 3) + fq) ^ ((drow >> 1) & 7)) << 4));
      }
      float cmax = -1e30f;
#pragma unroll
      for (int e = 0; e < 2; ++e)
#pragma unroll
        for (int jj = 0; jj < 4; ++jj) {
          float v = s[e][jj] * 0.125f;
          if (local) {
            const int kc = band0 + fq * 8 + e * 4 + jj;
            const int col_off = min(max(kc - qc, -15), 15) + 15;
            const bool valid = (kc >= wst) && (kc < wst + 16);
            v = valid ? v + rpb[row_off * 31 + col_off] : -1e30f;
          }
          s[e][jj] = v;
          cmax = fmaxf(cmax, v);
        }
      cmax = fmaxf(cmax, __shfl_xor(cmax, 16));
      cmax = fmaxf(cmax, __shfl_xor(cmax, 32));
      const float mnew = fmaxf(m, cmax);
      const float alpha = __expf(m - mnew);
      m = mnew;
      lsum *= alpha;
#pragma unroll
      for (int dt = 0; dt < 4; ++dt) o[dt] *= alpha;
#pragma unroll
      for (int e = 0; e < 2; ++e)
#pragma unroll
        for (int jj = 0; jj < 4; ++jj) {
          const float pv = __expf(s[e][jj] - m);
          lsum += pv;
          s[e][jj] = pv;
        }
      u32x4 pw = {pack2(s[0][0], s[0][1]), pack2(s[0][2], s[0][3]), pack2(s[1][0], s[1][1]), pack2(s[1][2], s[1][3])};
      const bf16x8 pb = __builtin_bit_cast(bf16x8, pw);
#pragma unroll
      for (int dt = 0; dt < 4; ++dt) o[dt] = __builtin_amdgcn_mfma_f32_16x16x32_bf16(vf[dt], pb, o[dt], 0, 0, 0);
    }
  }
#undef ISSUE_CHUNK
#undef GLDS
  lsum += __shfl_xor(lsum, 16);
  lsum += __shfl_xor(lsum, 32);
  const float inv = 1.f / lsum;
  const size_t t = qtok0 + fr;
#pragma unroll
  for (int dt = 0; dt < 4; ++dt) {
    int d0 = h * 64 + dt * 16 + fq * 4;
    uint2 g = *(const uint2*)(p.P + t * 8192 + 1536 + d0);
    float y0 = o[dt][0] * inv * silu(lo16(g.x)), y1 = o[dt][1] * inv * silu(hi16(g.x));
    float y2 = o[dt][2] * inv * silu(lo16(g.y)), y3 = o[dt][3] * inv * silu(hi16(g.y));
    *(uint2*)(p.Ana + t * 512 + d0) = make_uint2(pack2(y0, y1), pack2(y2, y3));
  }
  __syncthreads();
}

__device__ void lru_unit(const Params& p, int l, int unit, char* smem) {
  const int tid = otid(), lane = tid & 63, wave = tid >> 6, fr = lane & 15, fq = lane >> 4;
  const int blk = unit & 7, dir = (unit >> 3) & 1, cs = unit >> 4;
  const int t0 = cs * 64;
  int seq_lo, seq_hi;
  if (cs < 64) { seq_lo = (cs >> 2) * 256; seq_hi = seq_lo + 256; }
  else { seq_lo = 4096 + ((cs - 64) >> 5) * 2048; seq_hi = seq_lo + 2048; }
  u16* uraw = (u16*)smem;
  u16* udb = (u16*)(smem + 8704);
  float* sa = (float*)(smem + 8704 + 9216);
  float* sb = sa + 4096;
  float* stot = sb + 4096;
  const int wbase = dir ? t0 : t0 - 3;
#pragma unroll
  for (int i = 0; i < 3; ++i) {
    int row = (tid >> 3) + i * 32, ch8 = tid & 7;
    if (row < 67) {
      int t = wbase + row;
      uint4 v = make_uint4(0, 0, 0, 0);
      if (t >= seq_lo && t < seq_hi) v = *(const uint4*)(p.P + (size_t)t * 8192 + 2048 + blk * 64 + ch8 * 8);
      *(uint4*)(uraw + row * 64 + ch8 * 8) = v;
    }
  }
  __syncthreads();
  {
    const int ch = tid & 63, tg = tid >> 6;
    const int cw = blk * 64 + ch;
    const float* cwp = p.lru_conv_w + (size_t)((l * 2 + dir) * 4) * 512 + cw;
    const float w0 = cwp[0], w1 = cwp[512], w2 = cwp[1024], w3 = cwp[1536];
    const float cb = p.lru_conv_b[(l * 2 + dir) * 512 + cw];
    float uw[19];
#pragma unroll
    for (int q = 0; q < 19; ++q) uw[q] = bf2f(uraw[(tg * 16 + q) * 64 + ch]);
#pragma unroll
    for (int q = 0; q < 16; ++q) {
      const int t = tg * 16 + q;
      float ud = cb + w0 * uw[q] + w1 * uw[q + 1] + w2 * uw[q + 2] + w3 * uw[q + 3];
      sb[t * 64 + ch] = ud;
      udb[t * 72 + ch] = (u16)f2bf(ud);
    }
  }
  __syncthreads();
  {
    f32x4 ar[4], ai[4];
#pragma unroll
    for (int nt = 0; nt < 4; ++nt) { ar[nt] = f32x4{0.f, 0.f, 0.f, 0.f}; ai[nt] = f32x4{0.f, 0.f, 0.f, 0.f}; }
    const u16* wr = p.wgT + (size_t)(((l * 2 + dir) * 2 + 0) * 8 + blk) * 4096;
    const u16* wi = p.wgT + (size_t)(((l * 2 + dir) * 2 + 1) * 8 + blk) * 4096;
#pragma unroll
    for (int ks = 0; ks < 2; ++ks) {
      bf16x8 af = *(const bf16x8*)(udb + (wave * 16 + fr) * 72 + ks * 32 + fq * 8);
#pragma unroll
      for (int nt = 0; nt < 4; ++nt) {
        bf16x8 br = ld16(wr + (nt * 16 + fr) * 64 + ks * 32 + fq * 8);
        bf16x8 bi = ld16(wi + (nt * 16 + fr) * 64 + ks * 32 + fq * 8);
        ar[nt] = __builtin_amdgcn_mfma_f32_16x16x32_bf16(af, br, ar[nt], 0, 0, 0);
        ai[nt] = __builtin_amdgcn_mfma_f32_16x16x32_bf16(af, bi, ai[nt], 0, 0, 0);
      }
    }
#pragma unroll
    for (int nt = 0; nt < 4; ++nt) {
      const int k = nt * 16 + fr, cw = blk * 64 + k;
      const int pi = (l * 2 + dir) * 512 + cw;
      const float ba = p.lru_ba[pi], bx = p.lru_bx[pi];
      const float sp = p.sp8[pi];
#pragma unroll
      for (int jj = 0; jj < 4; ++jj) {
        const int t = wave * 16 + fq * 4 + jj;
        float rg = sigm(ar[nt][jj] + ba), ig = sigm(ai[nt][jj] + bx);
        float la = -rg * sp;
        float a = __expf(la);
        float ud = sb[t * 64 + k];
        float x2 = 2.f * la;
        float ser = -x2 * (1.f + x2 * (0.5f + x2 * (0.16666667f + x2 * (0.041666668f + x2 * (0.0083333338f + x2 * 0.0013888889f)))));
        float om = x2 > -0.5f ? ser : 1.f - a * a;
        float bb = __builtin_amdgcn_sqrtf(om) * (ig * ud);
        sa[t * 64 + k] = a;
        sb[t * 64 + k] = bb;
      }
    }
  }
  __syncthreads();
  {
    const int ch = tid & 63, sub = tid >> 6;
    float h = 0.f, ac = 1.f;
    float av[16], hv[16];
#pragma unroll
    for (int q = 0; q < 16; ++q) {
      const int pos = sub * 16 + q;
      const int t = dir ? 63 - pos : pos;
      av[q] = sa[t * 64 + ch]; hv[q] = sb[t * 64 + ch];
    }
#pragma unroll
    for (int q = 0; q < 16; ++q) {
      h = av[q] * h + hv[q];
      ac *= av[q];
      av[q] = ac; hv[q] = h;
    }
    stot[(sub * 64 + ch) * 2] = ac;
    stot[(sub * 64 + ch) * 2 + 1] = h;
    __syncthreads();
    float cA = 1.f, cH = 0.f;
    for (int s2 = 0; s2 < sub; ++s2) {
      float A2 = stot[(s2 * 64 + ch) * 2], H2 = stot[(s2 * 64 + ch) * 2 + 1];
      cH = A2 * cH + H2;
      cA *= A2;
    }
    u16* hl = p.hloc + ((size_t)dir * 8192 + t0) * 512 + blk * 64 + ch;
    u16* acp = p.acum + ((size_t)dir * 8192 + t0) * 512 + blk * 64 + ch;
    float hf = 0.f, af = 1.f;
#pragma unroll
    for (int q = 0; q < 16; ++q) {
      const int pos = sub * 16 + q;
      const int t = dir ? 63 - pos : pos;
      hf = hv[q] + av[q] * cH;
      af = av[q] * cA;
      hl[(size_t)t * 512] = (u16)f2bf(hf);
      acp[(size_t)t * 512] = (u16)f2bf(af);
    }
    if (sub == 3) {
      p.Atot[(size_t)(cs * 2 + dir) * 512 + blk * 64 + ch] = af;
      p.Htot[(size_t)(cs * 2 + dir) * 512 + blk * 64 + ch] = hf;
    }
  }
  __syncthreads();
}

__device__ void phaseB(const Params& p, int l, char* smem, int mode = 0) {
  const int wave = __builtin_amdgcn_readfirstlane(otid() >> 6);
  for (int it = vbid(); it < 3072; it += NVB) {
    if (it < 1024) { if (mode != 2) attn_item(p, l, it, smem); }
    else if (mode != 1) lru_unit(p, l, it - 1024, smem);
  }
}

__device__ __forceinline__ void unpack8(uint4 v, float (&f)[8]) {
  f[0] = lo16(v.x); f[1] = hi16(v.x); f[2] = lo16(v.y); f[3] = hi16(v.y);
  f[4] = lo16(v.z); f[5] = hi16(v.z); f[6] = lo16(v.w); f[7] = hi16(v.w);
}
__device__ void phaseB2(const Params& p, int l, char* smem) {
  const int tid = otid();
  float* scar = (float*)smem;
  float* new_state = p.out + 25165824;
  for (int u = vbid(); u < 512; u += NVB) {
    const int cs = u >> 2, quarter = u & 3;
    int first, c, nch, b, seq_lo, seq_hi;
    const bool lat = cs >= 64;
    if (!lat) { b = cs >> 2; c = cs & 3; nch = 4; first = b * 4; seq_lo = b * 256; seq_hi = seq_lo + 256; }
    else { b = (cs - 64) >> 5; c = (cs - 64) & 31; nch = 32; first = 64 + b * 32; seq_lo = 4096 + b * 2048; seq_hi = seq_lo + 2048; }
    {
      const int dir = tid >> 7, ch = quarter * 128 + (tid & 127);
      float carry = lat ? p.state_lru[(size_t)((b * 4 + l) * 2 + dir) * 512 + ch] : 0.f;
      const int nprev = dir ? (nch - 1 - c) : c;
      const int start = dir ? (nch - 1) : 0, step = dir ? -1 : 1;
      if (!lat) {
        float A_[3], H_[3];
#pragma unroll
        for (int s = 0; s < 3; ++s) {
          const int cc = min(max(start + step * s, 0), 3);
          const size_t ix = (size_t)((first + cc) * 2 + dir) * 512 + ch;
          A_[s] = p.Atot[ix]; H_[s] = p.Htot[ix];
        }
#pragma unroll
        for (int s = 0; s < 3; ++s) if (s < nprev) carry = A_[s] * carry + H_[s];
        const bool last = dir ? (c == 0) : (c == 3);
        if (last) {
          const size_t ix = (size_t)(cs * 2 + dir) * 512 + ch;
          new_state[(size_t)((b * 4 + l) * 2 + dir) * 512 + ch] = p.Atot[ix] * carry + p.Htot[ix];
        }
      } else {
        float A_[31], H_[31];
#pragma unroll
        for (int s = 0; s < 31; ++s) {
          const int cc = min(max(start + step * s, 0), 31);
          const size_t ix = (size_t)((first + cc) * 2 + dir) * 512 + ch;
          A_[s] = p.Atot[ix]; H_[s] = p.Htot[ix];
        }
#pragma unroll
        for (int s = 0; s < 31; ++s) if (s < nprev) carry = A_[s] * carry + H_[s];
      }
      scar[tid] = carry;
    }
    __syncthreads();
    {
      const int c8 = tid & 15, ch0 = quarter * 128 + c8 * 8;
      float cf[8], cb[8], w0[8], w1[8], w2[8];
#pragma unroll
      for (int e = 0; e < 8; ++e) {
        cf[e] = scar[c8 * 8 + e]; cb[e] = scar[128 + c8 * 8 + e];
        w0[e] = p.conv_w[(l * 3 + 0) * 512 + ch0 + e]; w1[e] = p.conv_w[(l * 3 + 1) * 512 + ch0 + e];
        w2[e] = p.conv_w[(l * 3 + 2) * 512 + ch0 + e];
      }
#pragma unroll 2
      for (int i = 0; i < 4; ++i) {
        const int t = cs * 64 + (tid >> 4) + i * 16;
        const u16* pr = p.P + (size_t)t * 8192 + ch0;
        const uint4 z4 = make_uint4(0u, 0u, 0u, 0u);
        uint4 hf4 = *(const uint4*)(p.hloc + (size_t)t * 512 + ch0), af4 = *(const uint4*)(p.acum + (size_t)t * 512 + ch0);
        uint4 hb4 = *(const uint4*)(p.hloc + ((size_t)8192 + t) * 512 + ch0), ab4 = *(const uint4*)(p.acum + ((size_t)8192 + t) * 512 + ch0);
        uint4 gl4 = *(const uint4*)(pr + 2560), cb4 = *(const uint4*)(pr + 3072), gc4 = *(const uint4*)(pr + 4608);
        uint4 cc1 = *(const uint4*)(pr + 3584), chh1 = *(const uint4*)(pr + 4096);
        uint4 cc0 = z4, chh0 = z4, cc2 = z4, chh2 = z4;
        if (t - 1 >= seq_lo) { cc0 = *(const uint4*)(pr - 8192 + 3584); chh0 = *(const uint4*)(pr - 8192 + 4096); }
        if (t + 1 < seq_hi) { cc2 = *(const uint4*)(pr + 8192 + 3584); chh2 = *(const uint4*)(pr + 8192 + 4096); }
        float hf[8], af[8], hb[8], ab[8], gl[8], cbv[8], gc[8], a0[8], b0[8], a1[8], b1[8], a2[8], b2[8], ol[8], oc[8];
        unpack8(hf4, hf); unpack8(af4, af); unpack8(hb4, hb); unpack8(ab4, ab); unpack8(gl4, gl); unpack8(cb4, cbv); unpack8(gc4, gc);
        unpack8(cc0, a0); unpack8(chh0, b0); unpack8(cc1, a1); unpack8(chh1, b1); unpack8(cc2, a2); unpack8(chh2, b2);
#pragma unroll
        for (int e = 0; e < 8; ++e) {
          float h = (hf[e] + af[e] * cf[e]) + (hb[e] + ab[e] * cb[e]);
          ol[e] = h * silu(gl[e]);
          float conv = w0[e] * (a0[e] * b0[e]) + w1[e] * (a1[e] * b1[e]) + w2[e] * (a2[e] * b2[e]);
          oc[e] = cbv[e] * conv * silu(gc[e]);
        }
        *(uint4*)(p.Alru + (size_t)t * 512 + ch0) = make_uint4(pack2(ol[0], ol[1]), pack2(ol[2], ol[3]), pack2(ol[4], ol[5]), pack2(ol[6], ol[7]));
        *(uint4*)(p.Aconv + (size_t)t * 512 + ch0) = make_uint4(pack2(oc[0], oc[1]), pack2(oc[2], oc[3]), pack2(oc[4], oc[5]), pack2(oc[6], oc[7]));
      }
    }
    __syncthreads();
  }
}

__device__ void phaseC1(const Params& p, int l, char* smem) {
  const int tid = otid512(), lane = tid & 63, wave = tid >> 6;
  const int wm = wave >> 1, wn = wave & 1, fr = lane & 15, fq = lane >> 4;
  for (int id = blockIdx.x; id < 256; id += gridDim.x) {
    const int xcd = id & 7, j_ = id >> 3;
    const int mt = xcd * 4 + (j_ >> 3), nt = j_ & 7;
    const int m0 = mt * 256, n0 = nt * 128;
    f32x4 tot[4][4];
    zero_acc<4, 4>(tot);
#pragma unroll 1
    for (int br = 0; br < 3; ++br) {
      f32x4 acc[4][4];
      zero_acc<4, 4>(acc);
      const u16* A = p.Ana + (size_t)br * 8192 * 512 + (size_t)m0 * 512;
      const u16* B = p.wt_br + (size_t)(l * 3 + br) * 1024 * 512 + (size_t)n0 * 512;
      gemm_mainloop<4, 4, 4, 2, true, false, true>(A, 512, B, 512, 512, acc, smem);
#pragma unroll
      for (int i = 0; i < 4; ++i) {
        const int t = m0 + wm * 64 + i * 16 + fr;
        const int col = n0 + wn * 64 + fq * 16;
        const u16* gp = p.P + (size_t)t * 8192 + 5120 + br * 1024 + col;
        uint4 g0 = *(const uint4*)gp, g1 = *(const uint4*)(gp + 8);
        tot[i][0][0] += sigm(lo16(g0.x)) * acc[i][0][0]; tot[i][0][1] += sigm(hi16(g0.x)) * acc[i][0][1];
        tot[i][0][2] += sigm(lo16(g0.y)) * acc[i][0][2]; tot[i][0][3] += sigm(hi16(g0.y)) * acc[i][0][3];
        tot[i][1][0] += sigm(lo16(g0.z)) * acc[i][1][0]; tot[i][1][1] += sigm(hi16(g0.z)) * acc[i][1][1];
        tot[i][1][2] += sigm(lo16(g0.w)) * acc[i][1][2]; tot[i][1][3] += sigm(hi16(g0.w)) * acc[i][1][3];
        tot[i][2][0] += sigm(lo16(g1.x)) * acc[i][2][0]; tot[i][2][1] += sigm(hi16(g1.x)) * acc[i][2][1];
        tot[i][2][2] += sigm(lo16(g1.y)) * acc[i][2][2]; tot[i][2][3] += sigm(hi16(g1.y)) * acc[i][2][3];
        tot[i][3][0] += sigm(lo16(g1.z)) * acc[i][3][0]; tot[i][3][1] += sigm(hi16(g1.z)) * acc[i][3][1];
        tot[i][3][2] += sigm(lo16(g1.w)) * acc[i][3][2]; tot[i][3][3] += sigm(hi16(g1.w)) * acc[i][3][3];
      }
    }
#pragma unroll
    for (int i = 0; i < 4; ++i) {
      const int t = m0 + wm * 64 + i * 16 + fr;
      const int col = n0 + wn * 64 + fq * 16;
      uint4 w0 = make_uint4(pack2(tot[i][0][0], tot[i][0][1]), pack2(tot[i][0][2], tot[i][0][3]),
                            pack2(tot[i][1][0], tot[i][1][1]), pack2(tot[i][1][2], tot[i][1][3]));
      uint4 w1 = make_uint4(pack2(tot[i][2][0], tot[i][2][1]), pack2(tot[i][2][2], tot[i][2][3]),
                            pack2(tot[i][3][0], tot[i][3][1]), pack2(tot[i][3][2], tot[i][3][3]));
      *(uint4*)(p.merged + (size_t)t * 1024 + col) = w0;
      *(uint4*)(p.merged + (size_t)t * 1024 + col + 8) = w1;
    }
  }
}

__device__ void phaseC2(const Params& p, int l, char* smem) {
  const int tid = otid512(), lane = tid & 63, wave = tid >> 6;
  const int wm = wave >> 1, wn = wave & 1, fr = lane & 15, fq = lane >> 4;
  for (int id = blockIdx.x; id < 256; id += gridDim.x) {
    const int xcd = id & 7, j_ = id >> 3;
    const int mt = xcd * 4 + (j_ >> 3), nt = j_ & 7;
    const int m0 = mt * 256, n0 = nt * 128;
    f32x4 acc[4][4];
    zero_acc<4, 4>(acc);
    gemm_mainloop<4, 4, 4, 2, true, false, true>(p.merged + (size_t)m0 * 1024, 1024,
                                                 p.wt_out + (size_t)l * 1024 * 1024 + (size_t)n0 * 1024, 1024, 1024, acc, smem);
    if (PROBE == 10) {
      gemm_mainloop<4, 4, 4, 2, true, false, true>(p.merged + (size_t)m0 * 1024, 1024,
                                                   p.wt_out + (size_t)l * 1024 * 1024 + (size_t)n0 * 1024, 1024, 1024, acc, smem);
#pragma unroll
      for (int i = 0; i < 4; ++i)
#pragma unroll
        for (int j = 0; j < 4; ++j) acc[i][j] *= 0.5f;
    }
#pragma unroll
    for (int i = 0; i < 4; ++i) {
      const int t = m0 + wm * 64 + i * 16 + fr;
      const int col = n0 + wn * 64 + fq * 16;
      const int cid = t < 4096 ? 0 : 1 + ((t - 4096) >> 11);
      const float* gt = p.mod + (size_t)(l * 3 + cid) * 3072 + 2048 + col;
      float* xr = p.xbuf + (size_t)t * 1024 + col;
#pragma unroll
      for (int j = 0; j < 4; ++j) {
        float4 g4 = *(const float4*)(gt + j * 4);
        float4 xo = *(const float4*)(xr + j * 4);
        *(float4*)(xr + j * 4) = make_float4(xo.x + g4.x * acc[i][j][0], xo.y + g4.y * acc[i][j][1],
                                             xo.z + g4.z * acc[i][j][2], xo.w + g4.w * acc[i][j][3]);
      }
    }
  }
}

#define XB_TMO      128
#define XB_XCNT(j)  (256  + 64 * (j))
#define XB_XSUB(j)  (1280 + 64 * (j))
#define XB_XGEN(j)  (2304 + 64 * (j))
#define XB_TOP      3328
#define XB_TOPGEN   3392
#define XCD_BAR_WORDS 3456
#define XB_SPIN_CAP (1u << 18)
#define LAS __attribute__((address_space(3)))
__device__ __forceinline__ unsigned xb_ld(unsigned* p) { return __hip_atomic_load(p, __ATOMIC_RELAXED, __HIP_MEMORY_SCOPE_AGENT); }
__device__ __forceinline__ unsigned xb_add(unsigned* p, unsigned v) { return __hip_atomic_fetch_add(p, v, __ATOMIC_RELAXED, __HIP_MEMORY_SCOPE_AGENT); }
__device__ __forceinline__ unsigned xb_xcc_id() { return (unsigned)__builtin_amdgcn_s_getreg((3 << 11) | 20) & 0xFu; }
#define XB_SPIN(cond, bar) do { unsigned _sp = 0; while (cond) { __builtin_amdgcn_s_sleep(1); \
    if ((++_sp & 255u) == 0u) { if (xb_ld(&(bar)[XB_TMO])) break; if (_sp > XB_SPIN_CAP) { atomicAdd(&(bar)[XB_TMO], 1u); break; } } } } while (0)
struct XcdBarrier { unsigned* bar; unsigned x; volatile LAS unsigned* st; };
__device__ __forceinline__ XcdBarrier xcd_barrier_post(unsigned* bar, volatile LAS unsigned* st) {
  XcdBarrier b; b.bar = bar; b.x = xb_xcc_id(); b.st = st;
  if (threadIdx.x == 0) (void)xb_add(&bar[XB_XCNT(b.x)], 1u);
  return b;
}
__device__ __forceinline__ void xcd_barrier_complete(unsigned* bar, unsigned x, unsigned& nloc, unsigned& nx) {
  const unsigned G = gridDim.x * gridDim.y * gridDim.z;
  unsigned sum, cnt, mine, sp = 0u;
  for (;;) {
    sum = 0u; cnt = 0u; mine = 0u;
#pragma unroll
    for (unsigned j = 0; j < 16; ++j) { const unsigned c = xb_ld(&bar[XB_XCNT(j)]); sum += c; cnt += (c > 0u) ? 1u : 0u; mine = (j == x) ? c : mine; }
    if (sum == G) break;
    __builtin_amdgcn_s_sleep(1);
    if ((++sp & 255u) == 0u) { if (xb_ld(&bar[XB_TMO])) break; if (sp > XB_SPIN_CAP) { atomicAdd(&bar[XB_TMO], 1u); break; } }
  }
  nloc = mine > 0u ? mine : 1u; nx = cnt > 0u ? cnt : 1u;
}
__device__ __forceinline__ void xcd_barrier(const XcdBarrier& b) {
  asm volatile("s_waitcnt vmcnt(0)" ::: "memory");
  __syncthreads();
  if (threadIdx.x == 0) {
    unsigned* bar = b.bar;
    __builtin_amdgcn_s_waitcnt(0);
    unsigned nloc = b.st[0], nx = b.st[1];
    if (nloc == 0u) { xcd_barrier_complete(bar, b.x, nloc, nx); b.st[0] = nloc; b.st[1] = nx; }
    const unsigned old = xb_add(&bar[XB_XSUB(b.x)], 1u);
    const unsigned gen = old / nloc;
    if (old + 1u == (gen + 1u) * nloc) {
      __builtin_amdgcn_fence(__ATOMIC_RELEASE, "agent");
      asm volatile("s_waitcnt vmcnt(0)" ::: "memory");
      const unsigned og = xb_add(&bar[XB_TOP], 1u);
      const unsigned tg = og / nx;
      if (og + 1u == (tg + 1u) * nx) xb_add(&bar[XB_TOPGEN], 1u);
      else XB_SPIN(xb_ld(&bar[XB_TOPGEN]) == tg, bar);
      __builtin_amdgcn_fence(__ATOMIC_ACQUIRE, "agent");
      xb_add(&bar[XB_XGEN(b.x)], 1u);
      asm volatile("s_waitcnt vmcnt(0)" ::: "memory");
    } else {
      XB_SPIN(xb_ld(&bar[XB_XGEN(b.x)]) == gen, bar);
      __builtin_amdgcn_fence(__ATOMIC_ACQUIRE, "agent");
      asm volatile("s_waitcnt vmcnt(0)" ::: "memory");
    }
  }
  __syncthreads();
}

__global__ void __launch_bounds__(NTHREADS) mega(Params p) {
  extern __shared__ __attribute__((aligned(16))) char dsm[];
  char* smem = dsm;
  char* hsm = dsm + __builtin_amdgcn_readfirstlane((int)(threadIdx.x >> 8)) * 65536;
  cg::grid_group grid = cg::this_grid();
  if (threadIdx.x == 0) *(uint4*)(dsm + SMEM_BYTES) = make_uint4(0u, 0u, 0u, 0u);
  __syncthreads();
  XcdBarrier xb = xcd_barrier_post(p.bar, (volatile LAS unsigned*)(dsm + SMEM_BYTES));
  const int lo = p.phase_lo, hi = p.phase_hi;
  if (hi > 1000) grid.sync();
#define GRID_SYNC() xcd_barrier(xb)
#define RUN_PHASE(PH, CALL) { const int ph_ = (PH); if (ph_ >= lo && ph_ < hi) { CALL; if (ph_ + 1 < hi) GRID_SYNC(); } }
#define RUN_PHASE_REP(PID, PH, CALL) { RUN_PHASE(PH, CALL); if (PROBE == (PID)) { RUN_PHASE(PH, CALL); } }
  RUN_PHASE_REP(1, 0, phase0(p, hsm));
#pragma unroll 1
  for (int l = 0; l < 4; ++l) {
    RUN_PHASE_REP(2, 1 + l * 6, phaseN(p, l));
    RUN_PHASE_REP(3, 2 + l * 6, phaseA(p, l, smem));
    RUN_PHASE_REP(4, 3 + l * 6, phaseB(p, l, hsm));
    if (PROBE == 8) { phaseB(p, l, hsm, 1); GRID_SYNC(); }
    if (PROBE == 9) { phaseB(p, l, hsm, 2); GRID_SYNC(); }
    RUN_PHASE_REP(5, 4 + l * 6, phaseB2(p, l, hsm));
    RUN_PHASE_REP(6, 5 + l * 6, phaseC1(p, l, smem));
    RUN_PHASE(6 + l * 6, phaseC2(p, l, smem));
    if (PROBE == 7) { for (int e = 0; e < 6; ++e) GRID_SYNC(); }
  }
  RUN_PHASE(25, phaseF(p));
}

extern "C" void kernel_launch(void* const* d_in, const int* in_sizes, int n_in, void* d_out, int out_size, void* d_ws,
                              size_t ws_size, hipStream_t stream) {
  static int grid_blocks = 0;
  if (!grid_blocks) {
    int dev = 0, cus = 0, per_cu = 0;
    hipGetDevice(&dev);
    hipDeviceGetAttribute(&cus, hipDeviceAttributeMultiprocessorCount, dev);
    hipFuncSetAttribute((const void*)mega, hipFuncAttributeMaxDynamicSharedMemorySize, DYN_LDS);
    hipOccupancyMaxActiveBlocksPerMultiprocessor(&per_cu, mega, NTHREADS, DYN_LDS);
    if (per_cu > 1) per_cu = 1;
    if (per_cu < 1) per_cu = 1;
    grid_blocks = cus * per_cu;
  }
  Params p;
  memset(&p, 0, sizeof(p));
  const float** fp = (const float**)&p;
  for (int i = 0; i < 25; ++i) fp[i] = (const float*)d_in[i];
  p.out = (float*)d_out;
  char* w = (char*)d_ws;
  size_t off = 0;
  auto take = [&](size_t bytes) { char* r = w + off; off += (bytes + 255) & ~(size_t)255; return r; };
  p.wt_in = (u16*)take((size_t)4 * 8192 * 1024 * 2);
  p.wt_br = (u16*)take((size_t)4 * 3 * 1024 * 512 * 2);
  p.wt_out = (u16*)take((size_t)4 * 1024 * 1024 * 2);
  p.wgT = (u16*)take((size_t)128 * 4096 * 2);
  p.ckb = (u16*)take((size_t)2 * 4 * 256 * 512 * 2);
  p.cvT = (u16*)take((size_t)2 * 4 * 256 * 512 * 2);
  p.xm = (u16*)take((size_t)8192 * 1024 * 2);
  p.P = (u16*)take((size_t)8192 * 8192 * 2);
  p.Vt = (u16*)take((size_t)512 * 8192 * 2);
  p.Ana = (u16*)take((size_t)8192 * 512 * 2);
  p.Alru = (u16*)take((size_t)8192 * 512 * 2);
  p.Aconv = (u16*)take((size_t)8192 * 512 * 2);
  p.merged = (u16*)take((size_t)8192 * 1024 * 2);
  p.hloc = (u16*)take((size_t)2 * 8192 * 512 * 2);
  p.acum = (u16*)take((size_t)2 * 8192 * 512 * 2);
  p.mod = (float*)take((size_t)4 * 3 * 3072 * 4);
  p.xbuf = (float*)take((size_t)8192 * 1024 * 4);
  p.Atot = (float*)take((size_t)128 * 2 * 512 * 4);
  p.Htot = (float*)take((size_t)128 * 2 * 512 * 4);
  p.sp8 = (float*)take((size_t)4096 * 4);
  p.bar = (unsigned*)take((size_t)XCD_BAR_WORDS * 4);
  if (off > ws_size) { fprintf(stderr, "workspace too small: need %zu have %zu\n", off, ws_size); return; }
#ifdef MULTI_LAUNCH
  for (int ph = 0; ph < 26; ++ph) {
    p.phase_lo = ph; p.phase_hi = ph + 1;
    hipLaunchKernelGGL(mega, dim3(grid_blocks), dim3(NTHREADS), DYN_LDS, stream, p);
  }
#else
  p.phase_lo = 0; p.phase_hi = 26;
  hipMemsetAsync(p.bar, 0, (size_t)XCD_BAR_WORDS * 4, stream);
  void* args[] = {&p};
  hipError_t e = hipLaunchCooperativeKernel((void*)mega, dim3(grid_blocks), dim3(NTHREADS), args, DYN_LDS, stream);
  if (e != hipSuccess) fprintf(stderr, "cooperative launch failed: %s (grid %d)\n", hipGetErrorString(e), grid_blocks);
#endif
}
```

```cpp
#include <hip/hip_runtime.h>
#include <hip/hip_cooperative_groups.h>
#include <cstdio>
#include <cstring>
namespace cg = cooperative_groups;

typedef unsigned short u16;
using bf16x8 = __attribute__((ext_vector_type(8))) short;
using f32x4 = __attribute__((ext_vector_type(4))) float;
using u32x4 = __attribute__((ext_vector_type(4))) unsigned;

#define NTHREADS 512
#define SMEM_BYTES 131072
#define DYN_LDS (SMEM_BYTES + 64)

struct Params {
  const float *x_prompt, *x_sample, *cache_k, *cache_v, *state_lru, *c, *c_ctx, *norm_g, *w_mod, *b_mod,
      *w_in, *na_rpb, *lru_conv_w, *lru_conv_b, *lru_wa, *lru_ba, *lru_wx, *lru_bx, *lru_lam, *conv_w,
      *w_br_na, *w_br_lru, *w_br_conv, *w_out, *final_g;
  float* out;
  u16 *wt_in, *wt_br, *wt_out, *wgT, *ckb, *cvT, *xm, *P, *Vt, *Ana, *Alru, *Aconv, *merged, *hloc, *acum;
  float *mod, *xbuf, *Atot, *Htot, *sp8, *rowss, *sW;
  unsigned* bar;
  int phase_lo, phase_hi;
};

__device__ __forceinline__ int otid() { int t = threadIdx.x & 255; asm volatile("" : "+v"(t)); return t; }
__device__ __forceinline__ int otid512() { int t = threadIdx.x; asm volatile("" : "+v"(t)); return t; }
__device__ __forceinline__ int vbid() { return blockIdx.x * 2 + __builtin_amdgcn_readfirstlane((int)(threadIdx.x >> 8)); }
#define NVB ((int)gridDim.x * 2)
__device__ __forceinline__ unsigned f2bf(float f) {
  unsigned r;
  asm("v_cvt_pk_bf16_f32 %0, %1, %1" : "=v"(r) : "v"(f));
  return r & 0xffffu;
}
__device__ __forceinline__ float bf2f(unsigned h) { return __uint_as_float(h << 16); }
__device__ __forceinline__ unsigned pack2(float a, float b) {
  unsigned r;
  asm("v_cvt_pk_bf16_f32 %0, %1, %2" : "=v"(r) : "v"(a), "v"(b));
  return r;
}
__device__ __forceinline__ float sigm(float x) { return __builtin_amdgcn_rcpf(1.f + __expf(-x)); }
__device__ __forceinline__ float silu(float x) { return x * __builtin_amdgcn_rcpf(1.f + __expf(-x)); }
__device__ __forceinline__ float lo16(unsigned w) { return __uint_as_float(w << 16); }
__device__ __forceinline__ float hi16(unsigned w) { return __uint_as_float(w & 0xffff0000u); }

__device__ __forceinline__ size_t blk1024(int row, int k) {
  return ((size_t)(row >> 8) * 16 + (k >> 6)) * 16384 + (size_t)(row & 255) * 64 + (k & 63);
}
struct VbBar;
template <bool VB> __device__ __forceinline__ void item_barrier(VbBar* vb);
template <bool VB>
__device__ void transpose_unit(const float* __restrict__ src, int N, u16* __restrict__ dst, int K, int k0, int n0,
                               float* sm, VbBar* vb, bool blocked = false) {
  const int tid = otid();
  float4 v[8];
#pragma unroll
  for (int i = 0; i < 4; ++i) {
    const int r = (tid >> 4) + i * 16, c4 = (tid & 15) * 4;
    { const f32x4 t_ = __builtin_nontemporal_load((const f32x4*)(src + (size_t)(k0 + r) * N + n0 + c4)); v[i] = make_float4(t_[0], t_[1], t_[2], t_[3]); }
    { const f32x4 t_ = __builtin_nontemporal_load((const f32x4*)(src + (size_t)(k0 + r) * N + n0 + 64 + c4)); v[4 + i] = make_float4(t_[0], t_[1], t_[2], t_[3]); }
  }
#pragma unroll
  for (int i = 0; i < 4; ++i) {
    const int r = (tid >> 4) + i * 16, c4 = (tid & 15) * 4;
    float* s0 = sm + r * 65 + c4;
    float* s1 = sm + 4160 + r * 65 + c4;
    s0[0] = v[i].x; s0[1] = v[i].y; s0[2] = v[i].z; s0[3] = v[i].w;
    s1[0] = v[4 + i].x; s1[1] = v[4 + i].y; s1[2] = v[4 + i].z; s1[3] = v[4 + i].w;
  }
  item_barrier<VB>(vb);
  const int n = tid >> 2, kq = (tid & 3) * 16;
#pragma unroll
  for (int h = 0; h < 2; ++h) {
    const float* sh = sm + h * 4160;
    unsigned w[8];
#pragma unroll
    for (int kk = 0; kk < 8; ++kk) w[kk] = pack2(sh[(kq + 2 * kk) * 65 + n], sh[(kq + 2 * kk + 1) * 65 + n]);
    const int nn = n0 + h * 64 + n;
    uint4* d = (uint4*)(blocked ? dst + blk1024(nn, k0 + kq) : dst + (size_t)nn * K + k0 + kq);
    d[0] = make_uint4(w[0], w[1], w[2], w[3]);
    d[1] = make_uint4(w[4], w[5], w[6], w[7]);
  }
  item_barrier<VB>(vb);
}

template <bool VB>
__device__ void weight_unit(const Params& p, int l, int idx, float* sm, VbBar* vb) {
  if (idx < 1024) {
    const int kt = idx >> 6, nt = (idx & 63) * 2;
    transpose_unit<VB>(p.w_in + (size_t)l * 1024 * 8192, 8192, p.wt_in + (size_t)l * 8192 * 1024, 1024, kt * 64, nt * 64, sm, vb, true);
  } else if (idx < 1216) {
    const int r = idx - 1024, br = r >> 6, q = r & 63, kt = q >> 3, nt = (q & 7) * 2;
    u16* dst = p.wt_br + (size_t)(l * 3 + br) * 1024 * 512;
    if (br == 0) transpose_unit<VB>(p.w_br_na + (size_t)l * 512 * 1024, 1024, dst, 512, kt * 64, nt * 64, sm, vb);
    else if (br == 1) transpose_unit<VB>(p.w_br_lru + (size_t)l * 512 * 1024, 1024, dst, 512, kt * 64, nt * 64, sm, vb);
    else transpose_unit<VB>(p.w_br_conv + (size_t)l * 512 * 1024, 1024, dst, 512, kt * 64, nt * 64, sm, vb);
  } else {
    const int r = idx - 1216, kt = r >> 3, nt = (r & 7) * 2;
    transpose_unit<VB>(p.w_out + (size_t)l * 1024 * 1024, 1024, p.wt_out + (size_t)l * 1024 * 1024, 1024, kt * 64, nt * 64, sm, vb);
  }
}

__device__ void phase0(const Params& p, char* smem) {
  float* sm = (float*)smem;
  const int tid = otid();
  const int NU = 384 + 1344 + 512 + 512 + 128;
  for (int u = vbid(); u < NU; u += NVB) {
    int v = u;
    if (v < 384) {
      int l = v / 96, cgp = v % 96;
      int c = cgp * 32 + (tid & 31), kg = tid >> 5;
      for (int k = tid; k < 1024; k += 256) {
        sm[k] = silu(p.c_ctx[k]); sm[1024 + k] = silu(p.c[k]); sm[2048 + k] = silu(p.c[1024 + k]);
      }
      __syncthreads();
      float a0 = 0.f, a1 = 0.f, a2 = 0.f;
      const float* w = p.w_mod + (size_t)l * 1024 * 3072 + c;
#pragma unroll 1
      for (int kb = kg * 128; kb < kg * 128 + 128; kb += 16) {
        float wv[16];
#pragma unroll
        for (int j = 0; j < 16; ++j) wv[j] = __builtin_nontemporal_load(w + (size_t)(kb + j) * 3072);
#pragma unroll
        for (int j = 0; j < 16; ++j) { a0 += sm[kb + j] * wv[j]; a1 += sm[1024 + kb + j] * wv[j]; a2 += sm[2048 + kb + j] * wv[j]; }
      }
      __syncthreads();
      sm[(kg * 3 + 0) * 32 + (tid & 31)] = a0;
      sm[(kg * 3 + 1) * 32 + (tid & 31)] = a1;
      sm[(kg * 3 + 2) * 32 + (tid & 31)] = a2;
      __syncthreads();
      if (tid < 96) {
        int cond = tid >> 5, cc = tid & 31;
        float s = p.b_mod[l * 3072 + cgp * 32 + cc];
#pragma unroll
        for (int g = 0; g < 8; ++g) s += sm[(g * 3 + cond) * 32 + cc];
        p.mod[(size_t)(l * 3 + cond) * 3072 + cgp * 32 + cc] = s;
      }
      __syncthreads();
      continue;
    }
    v -= 384;
    if (v < 1344) { weight_unit<false>(p, 0, v, sm, nullptr); continue; }
    v -= 1344;
    if (v < 512) {
      size_t idx = ((size_t)v * 256 + tid) * 8;
      float4 a = *(const float4*)(p.cache_k + idx), b = *(const float4*)(p.cache_k + idx + 4);
      *(uint4*)(p.ckb + idx) = make_uint4(pack2(a.x, a.y), pack2(a.z, a.w), pack2(b.x, b.y), pack2(b.z, b.w));
      continue;
    }
    v -= 512;
    if (v < 512) {
      int g = v * 256 + tid;
      int d = g & 63, h = (g >> 6) & 7, kg = (g >> 9) & 31, bl = g >> 14;
      float f[8];
#pragma unroll
      for (int j = 0; j < 8; ++j) f[j] = p.cache_v[((size_t)(bl * 256 + kg * 8 + j) * 8 + h) * 64 + d];
      *(uint4*)(p.cvT + ((size_t)(bl * 8 + h) * 64 + d) * 256 + kg * 8) =
          make_uint4(pack2(f[0], f[1]), pack2(f[2], f[3]), pack2(f[4], f[5]), pack2(f[6], f[7]));
      continue;
    }
    v -= 512;
    {
      int blk = v & 7, gate = (v >> 3) & 1, dir = (v >> 4) & 1, l = v >> 5;
      if (tid < 192) p.rowss[8192 + v * 192 + tid] = 0.f;
      if (tid < 32) {
        const int i = v * 32 + tid;
        p.sp8[i] = 8.f * log1pf(expf(-p.lru_lam[i]));
      }
      const size_t so = (size_t)((l * 2 + dir) * 8 + blk) * 4096;
      u16* dst = p.wgT + (size_t)v * 4096;
      for (int idx = tid; idx < 4096; idx += 256) {
        int k = idx >> 6, j = idx & 63;
        float wv;
        if (gate) wv = p.lru_wx[so + j * 64 + k]; else wv = p.lru_wa[so + j * 64 + k];
        dst[idx] = (u16)f2bf(wv);
      }
    }
  }
}

__device__ __forceinline__ const float* xrow(const Params& p, int l, int t) {
  if (l == 0) {
    const float* a = p.x_prompt;
    const float* b = p.x_sample;
    asm volatile("" : "+s"(a));
    asm volatile("" : "+s"(b));
    return t < 4096 ? a + (size_t)t * 1024 : b + (size_t)(t - 4096) * 1024;
  }
  return p.xbuf + (size_t)t * 1024;
}
__device__ __forceinline__ float xrow16_max(float x) {
  auto s = __builtin_amdgcn_permlane16_swap(__float_as_uint(x), __float_as_uint(x), false, false);
  x = fmaxf(__uint_as_float(s[0]), __uint_as_float(s[1]));
  auto t = __builtin_amdgcn_permlane32_swap(__float_as_uint(x), __float_as_uint(x), false, false);
  return fmaxf(__uint_as_float(t[0]), __uint_as_float(t[1]));
}
__device__ __forceinline__ uint4 ldnt16(const u16* ptr) {
  const u32x4 t = __builtin_nontemporal_load((const u32x4*)ptr);
  return make_uint4(t[0], t[1], t[2], t[3]);
}
__device__ __forceinline__ void stnt4(float* ptr, float a, float b, float c, float d) {
  __builtin_nontemporal_store(f32x4{a, b, c, d}, (f32x4*)ptr);
}
__device__ __forceinline__ float wave_sum(float v) {
#pragma unroll
  for (int o = 32; o >= 1; o >>= 1) v += __shfl_xor(v, o);
  return v;
}

template <bool VB>
__device__ void sw_item(const Params& p, int l, int ng, char* smem, VbBar* vb) {
  const int tid = otid();
  float* sm = (float*)smem;
  const int n = ng * 16 + (tid & 15), kp = tid >> 4;
  for (int i = tid; i < 3072; i += 256) sm[i] = p.mod[(size_t)(l * 3 + (i >> 10)) * 3072 + (i & 1023)];
  item_barrier<VB>(vb);
  const u16* wp = p.wt_in + (size_t)l * 8192 * 1024 + blk1024(n, kp * 64);
  float a0 = 0.f, a1 = 0.f, a2 = 0.f;
#pragma unroll
  for (int j = 0; j < 8; ++j) {
    const uint4 wv = *(const uint4*)(wp + j * 8);
    float w[8];
    w[0] = lo16(wv.x); w[1] = hi16(wv.x); w[2] = lo16(wv.y); w[3] = hi16(wv.y);
    w[4] = lo16(wv.z); w[5] = hi16(wv.z); w[6] = lo16(wv.w); w[7] = hi16(wv.w);
#pragma unroll
    for (int e = 0; e < 8; ++e) {
      const int k = kp * 64 + j * 8 + e;
      a0 += sm[k] * w[e]; a1 += sm[1024 + k] * w[e]; a2 += sm[2048 + k] * w[e];
    }
  }
  item_barrier<VB>(vb);
  sm[(kp * 3 + 0) * 16 + (tid & 15)] = a0;
  sm[(kp * 3 + 1) * 16 + (tid & 15)] = a1;
  sm[(kp * 3 + 2) * 16 + (tid & 15)] = a2;
  item_barrier<VB>(vb);
  if (tid < 48) {
    const int cond = tid >> 4, nl = tid & 15;
    float s = 0.f;
#pragma unroll
    for (int q = 0; q < 16; ++q) s += sm[(q * 3 + cond) * 16 + nl];
    p.sW[(size_t)(l * 3 + cond) * 8192 + ng * 16 + nl] = s;
  }
  item_barrier<VB>(vb);
}

__device__ void phaseN0(const Params& p, char* smem) {
  const int tid = otid(), lane = tid & 63, wave = tid >> 6;
  const float* g = p.norm_g;
  for (int t = vbid() * 4 + wave; t < 8192; t += NVB * 4) {
    const float* x = xrow(p, 0, t);
    float4 v[4];
    float ss = 0.f;
#pragma unroll
    for (int i = 0; i < 4; ++i) {
      v[i] = *(const float4*)(x + i * 256 + lane * 4);
      ss += v[i].x * v[i].x + v[i].y * v[i].y + v[i].z * v[i].z + v[i].w * v[i].w;
    }
    ss = wave_sum(ss);
    if (lane == 0) p.rowss[t] = ss;
    const int cid = t < 4096 ? 0 : 1 + ((t - 4096) >> 11);
    const float* md = p.mod + (size_t)cid * 3072;
#pragma unroll
    for (int i = 0; i < 4; ++i) {
      const int c = i * 256 + lane * 4;
      const float4 gg = *(const float4*)(g + c), sc = *(const float4*)(md + 1024 + c);
      *(uint2*)(p.xm + blk1024(t, c)) = make_uint2(pack2(v[i].x * gg.x * (1.f + sc.x), v[i].y * gg.y * (1.f + sc.y)),
                                                   pack2(v[i].z * gg.z * (1.f + sc.z), v[i].w * gg.w * (1.f + sc.w)));
    }
  }
  for (int it = vbid(); it < 512; it += NVB) sw_item<false>(p, 0, it, smem, nullptr);
}

__device__ void phaseF(const Params& p) {
  const int lane = otid() & 63, wave = otid() >> 6;
  for (int t = vbid() * 4 + wave; t < 8192; t += NVB * 4) {
    const float* x = p.xbuf + (size_t)t * 1024;
    float4 v[4];
    float ss = 0.f;
#pragma unroll
    for (int i = 0; i < 4; ++i) {
      v[i] = *(const float4*)(x + i * 256 + lane * 4);
      ss += v[i].x * v[i].x + v[i].y * v[i].y + v[i].z * v[i].z + v[i].w * v[i].w;
    }
    ss = wave_sum(ss);
    float rstd = rsqrtf(ss * (1.f / 1024.f) + 1e-6f);
#pragma unroll
    for (int i = 0; i < 4; ++i) {
      int c = i * 256 + lane * 4;
      float4 gg = *(const float4*)(p.final_g + c);
      stnt4(p.out + (size_t)t * 1024 + c, v[i].x * rstd * gg.x, v[i].y * rstd * gg.y, v[i].z * rstd * gg.z, v[i].w * rstd * gg.w);
    }
  }
}

__device__ __forceinline__ int perm64(int r) { return (r & 0x43) | ((r & 0x30) >> 2) | ((r & 0x0c) << 2); }

template <int MI, int NJ, int WM, int WN, bool PERM_A, bool PERM_B>
__device__ __forceinline__ void gemm64_prologue(const u16* __restrict__ A, int lda, const u16* __restrict__ B, int ldb, char* smem) {
  constexpr int AR = WM * MI * 16, BR = WN * NJ * 16;
  constexpr int A_BYTES = AR * 128;
  const int tid = otid512();
  const int lr = tid >> 3, lc = (tid & 7) ^ ((lr >> 1) & 7);
  const u16* ag = A + (size_t)(PERM_A ? perm64(lr) : lr) * lda + lc * 8;
  const u16* bg = B + (size_t)(PERM_B ? perm64(lr) : lr) * ldb + lc * 8;
  char* sA = smem + tid * 16;
  char* sB = smem + A_BYTES + tid * 16;
#pragma unroll
  for (int i = 0; i < AR / 64; ++i) __builtin_amdgcn_global_load_lds((const unsigned*)(ag + (size_t)i * 64 * lda), (unsigned*)(sA + i * 8192), 16, 0, 0);
#pragma unroll
  for (int i = 0; i < BR / 64; ++i) __builtin_amdgcn_global_load_lds((const unsigned*)(bg + (size_t)i * 64 * ldb), (unsigned*)(sB + i * 8192), 16, 0, 0);
}

template <int MI, int NJ, int WM, int WN, bool SWAP, bool PERM_A, bool PERM_B, bool SKIP_PRO = false>
__device__ __forceinline__ void gemm_mainloop64(const u16* __restrict__ A, int lda, const u16* __restrict__ B, int ldb,
                                              int K, f32x4 (&acc)[MI][NJ], char* smem, int kts = 64) {
  constexpr int AR = WM * MI * 16, BR = WN * NJ * 16;
  constexpr int A_BYTES = AR * 128, STAGE = (AR + BR) * 128;
  const int tid = otid512(), lane = tid & 63, wave = tid >> 6;
  const int wm = wave / WN, wn = wave % WN, fr = lane & 15, fq = lane >> 4;
  const int lr = tid >> 3, lc = (tid & 7) ^ ((lr >> 1) & 7);
  const u16* ag = A + (size_t)(PERM_A ? perm64(lr) : lr) * lda + lc * 8;
  const u16* bg = B + (size_t)(PERM_B ? perm64(lr) : lr) * ldb + lc * 8;
  char* sA = smem + tid * 16;
  char* sB = smem + A_BYTES + tid * 16;
#define GLDS(gp, lp) __builtin_amdgcn_global_load_lds((const unsigned*)(gp), (unsigned*)(lp), 16, 0, 0)
  if (!SKIP_PRO) {
#pragma unroll
    for (int i = 0; i < AR / 64; ++i) GLDS(ag + (size_t)i * 64 * lda, sA + i * 8192);
#pragma unroll
    for (int i = 0; i < BR / 64; ++i) GLDS(bg + (size_t)i * 64 * ldb, sB + i * 8192);
  }
  asm volatile("s_waitcnt vmcnt(0)" ::: "memory");
  __syncthreads();
  const int swz_r = (fr >> 1) & 7;
  const int aoff = (wm * MI * 16 + fr) * 128, boff = A_BYTES + (wn * NJ * 16 + fr) * 128;
  const int nk = K >> 6;
  for (int kt = 0; kt < nk; ++kt) {
    const int cur = kt & 1;
    if (kt + 1 < nk) {
#pragma unroll
      for (int i = 0; i < AR / 64; ++i) GLDS(ag + (size_t)i * 64 * lda + (size_t)(kt + 1) * kts, sA + (cur ^ 1) * STAGE + i * 8192);
#pragma unroll
      for (int i = 0; i < BR / 64; ++i) GLDS(bg + (size_t)i * 64 * ldb + (size_t)(kt + 1) * kts, sB + (cur ^ 1) * STAGE + i * 8192);
    }
    __builtin_amdgcn_sched_barrier(0);
    const char* cA = smem + cur * STAGE + aoff;
    const char* cB = smem + cur * STAGE + boff;
    bf16x8 af[2][MI], bfr[2][NJ];
#pragma unroll
    for (int ks = 0; ks < 2; ++ks) {
      const int ch = ((ks * 4 + fq) ^ swz_r) << 4;
#pragma unroll
      for (int j = 0; j < NJ; ++j) bfr[ks][j] = *(const bf16x8*)(cB + j * 2048 + ch);
#pragma unroll
      for (int i = 0; i < MI; ++i) af[ks][i] = *(const bf16x8*)(cA + i * 2048 + ch);
    }
#pragma unroll
    for (int ks = 0; ks < 2; ++ks)
#pragma unroll
      for (int i = 0; i < MI; ++i)
#pragma unroll
        for (int j = 0; j < NJ; ++j) {
          if (SWAP) acc[i][j] = __builtin_amdgcn_mfma_f32_16x16x32_bf16(bfr[ks][j], af[ks][i], acc[i][j], 0, 0, 0);
          else acc[i][j] = __builtin_amdgcn_mfma_f32_16x16x32_bf16(af[ks][i], bfr[ks][j], acc[i][j], 0, 0, 0);
        }
    __builtin_amdgcn_sched_group_barrier(0x100, 8, 0);
#pragma unroll
    for (int g = 0; g < 2 * (MI + NJ) - 8; ++g) {
      __builtin_amdgcn_sched_group_barrier(0x008, 2, 0);
      __builtin_amdgcn_sched_group_barrier(0x100, 1, 0);
    }
    __builtin_amdgcn_sched_group_barrier(0x008, 2 * MI * NJ - 2 * (2 * (MI + NJ) - 8), 0);
    __builtin_amdgcn_sched_barrier(0);
    asm volatile("s_waitcnt vmcnt(0)" ::: "memory");
    __builtin_amdgcn_s_barrier();
    asm volatile("" ::: "memory");
  }
#undef GLDS
}

template <int N> __device__ __forceinline__ void wait_vmcnt() {
  if (N == 0) asm volatile("s_waitcnt vmcnt(0)" ::: "memory");
  else if (N == 3) asm volatile("s_waitcnt vmcnt(3)" ::: "memory");
  else if (N == 4) asm volatile("s_waitcnt vmcnt(4)" ::: "memory");
  else if (N == 6) asm volatile("s_waitcnt vmcnt(6)" ::: "memory");
  else if (N == 8) asm volatile("s_waitcnt vmcnt(8)" ::: "memory");
  else asm volatile("s_waitcnt vmcnt(0)" ::: "memory");
}

template <int MI, int NJ, int WM, int WN, bool PERM_A, bool PERM_B>
__device__ __forceinline__ void gemm4_prologue(const u16* __restrict__ A, int lda, const u16* __restrict__ B, int ldb, char* smem) {
  constexpr int AR = WM * MI * 16, BR = WN * NJ * 16;
  constexpr int A_BYTES = AR * 64, STAGE = (AR + BR) * 64;
  constexpr int LA = AR / 128, LB = BR / 128;
  const int tid = otid512();
  const int lr = tid >> 2, lc = (tid & 3) ^ ((4 - ((lr >> 2) & 3)) & 3);
  const u16* ag = A + (size_t)(PERM_A ? perm64(lr) : lr) * lda + lc * 8;
  const u16* bg = B + (size_t)(PERM_B ? perm64(lr) : lr) * ldb + lc * 8;
  char* sA = smem + tid * 16;
  char* sB = smem + A_BYTES + tid * 16;
#pragma unroll
  for (int kt = 0; kt < 3; ++kt) {
#pragma unroll
    for (int i = 0; i < LA; ++i)
      __builtin_amdgcn_global_load_lds((const unsigned*)(ag + (size_t)i * 128 * lda + kt * 32), (unsigned*)(sA + kt * STAGE + i * 8192), 16, 0, 0);
#pragma unroll
    for (int i = 0; i < LB; ++i)
      __builtin_amdgcn_global_load_lds((const unsigned*)(bg + (size_t)i * 128 * ldb + kt * 32), (unsigned*)(sB + kt * STAGE + i * 8192), 16, 0, 0);
  }
}

template <int MI, int NJ, int WM, int WN, bool SWAP, bool PERM_A, bool PERM_B, bool SKIP_PRO = false>
__device__ __forceinline__ void gemm_mainloop(const u16* __restrict__ A, int lda, const u16* __restrict__ B, int ldb,
                                              int K, f32x4 (&acc)[MI][NJ], char* smem) {
  constexpr int AR = WM * MI * 16, BR = WN * NJ * 16;
  constexpr int A_BYTES = AR * 64, STAGE = (AR + BR) * 64;
  constexpr int LA = AR / 128, LB = BR / 128, NL = LA + LB;
  const int tid = otid512(), lane = tid & 63, wave = tid >> 6;
  const int wm = wave / WN, wn = wave % WN, fr = lane & 15, fq = lane >> 4;
  const int lr = tid >> 2, lc = (tid & 3) ^ ((4 - ((lr >> 2) & 3)) & 3);
  const u16* ag = A + (size_t)(PERM_A ? perm64(lr) : lr) * lda + lc * 8;
  const u16* bg = B + (size_t)(PERM_B ? perm64(lr) : lr) * ldb + lc * 8;
  char* sA = smem + tid * 16;
  char* sB = smem + A_BYTES + tid * 16;
#define GLDS(gp, lp) __builtin_amdgcn_global_load_lds((const unsigned*)(gp), (unsigned*)(lp), 16, 0, 0)
#define ISSUE_TILE(kt_, st_)                                                                         \
  {                                                                                                  \
    _Pragma("unroll") for (int i = 0; i < LA; ++i)                                                   \
        GLDS(ag + (size_t)i * 128 * lda + (kt_) * 32, sA + (st_) * STAGE + i * 8192);                \
    _Pragma("unroll") for (int i = 0; i < LB; ++i)                                                   \
        GLDS(bg + (size_t)i * 128 * ldb + (kt_) * 32, sB + (st_) * STAGE + i * 8192);                \
  }
  const int nk = K >> 5;
  if (!SKIP_PRO) {
    ISSUE_TILE(0, 0);
    ISSUE_TILE(1, 1);
    ISSUE_TILE(2, 2);
  }
  const int rch = (fq ^ ((4 - ((fr >> 2) & 3)) & 3)) << 4;
  const int aoff = (wm * MI * 16 + fr) * 64 + rch, boff = A_BYTES + (wn * NJ * 16 + fr) * 64 + rch;
  for (int kt = 0; kt < nk; ++kt) {
    if (kt + 2 < nk) wait_vmcnt<2 * NL>();
    else if (kt + 1 < nk) wait_vmcnt<NL>();
    else wait_vmcnt<0>();
    __builtin_amdgcn_s_barrier();
    asm volatile("" ::: "memory");
    if (kt + 3 < nk) ISSUE_TILE(kt + 3, (kt + 3) & 3);
    const char* cA = smem + (kt & 3) * STAGE + aoff;
    const char* cB = smem + (kt & 3) * STAGE + boff;
    bf16x8 af[MI], bfr[NJ];
#pragma unroll
    for (int j = 0; j < NJ; ++j) bfr[j] = *(const bf16x8*)(cB + j * 1024);
#pragma unroll
    for (int i = 0; i < MI; ++i) af[i] = *(const bf16x8*)(cA + i * 1024);
#pragma unroll
    for (int i = 0; i < MI; ++i)
#pragma unroll
      for (int j = 0; j < NJ; ++j) {
        if (SWAP) acc[i][j] = __builtin_amdgcn_mfma_f32_16x16x32_bf16(bfr[j], af[i], acc[i][j], 0, 0, 0);
        else acc[i][j] = __builtin_amdgcn_mfma_f32_16x16x32_bf16(af[i], bfr[j], acc[i][j], 0, 0, 0);
      }
  }
  __syncthreads();
#undef ISSUE_TILE
#undef GLDS
}

template <int MI, int NJ>
__device__ __forceinline__ void zero_acc(f32x4 (&acc)[MI][NJ]) {
#pragma unroll
  for (int i = 0; i < MI; ++i)
#pragma unroll
    for (int j = 0; j < NJ; ++j) acc[i][j] = f32x4{0.f, 0.f, 0.f, 0.f};
}

template <bool SKIP_FIRST = false>
__device__ __forceinline__ void gemm_8phase(const u16* __restrict__ X, const u16* __restrict__ Y, f32x4 (&acc)[2][2][4][2],
                                            char* smem) {
  const int tid = otid512(), lane = tid & 63, wid = tid >> 6;
  const int wr = __builtin_amdgcn_readfirstlane(wid >> 2), wc = wid & 3, fr = lane & 15, fq = lane >> 4;
  int offx[2], offy[2];
#pragma unroll
  for (int i = 0; i < 2; ++i) {
    const int b = tid * 16 + i * 8192;
    const int st = b >> 10, sb = b & 1023, swz = sb ^ (((sb >> 9) & 1) << 5);
    const int R = (st >> 1) * 16 + (swz >> 6), C = (st & 1) * 32 + ((swz & 63) >> 1);
    offx[i] = perm64(R) * 64 + C;
    offy[i] = R * 64 + C;
  }
  char* const sdst = smem + tid * 16;
  const int rb = (fr * 64 + fq * 16) ^ ((fr >> 3) << 5);
  const char* const sra = smem + wr * 8192 + rb;
  const char* const srb = smem + 65536 + wc * 4096 + rb;
#define HTB 16384
#define SAo(b, h) (((b) * 2 + (h)) * HTB)
#define SBo(b, h) (((b) * 2 + (h)) * HTB)
#define GLDS(gp, lp) __builtin_amdgcn_global_load_lds((const unsigned*)(gp), (unsigned*)(lp), 16, 0, 0)
#define STAGE_X(b, h, kt) { _Pragma("unroll") for (int _i = 0; _i < 2; ++_i) \
    GLDS(X + (size_t)(h) * 8192 + (size_t)(kt) * 16384 + offx[_i], sdst + SAo(b, h) + _i * 8192); }
#define STAGE_Y(b, h, kt) { _Pragma("unroll") for (int _i = 0; _i < 2; ++_i) \
    GLDS(Y + (size_t)(h) * 8192 + (size_t)(kt) * 16384 + offy[_i], sdst + 65536 + SBo(b, h) + _i * 8192); }
#define LDA(dst, b, h) { _Pragma("unroll") for (int m = 0; m < 4; ++m) _Pragma("unroll") for (int k = 0; k < 2; ++k) \
    dst[m][k] = *(const bf16x8*)(sra + SAo(b, h) + (m * 2 + k) * 1024); }
#define LDB(dst, b, h) { _Pragma("unroll") for (int n = 0; n < 2; ++n) _Pragma("unroll") for (int k = 0; k < 2; ++k) \
    dst[n][k] = *(const bf16x8*)(srb + SBo(b, h) + (n * 2 + k) * 1024); }
#define MMA(ai, bj, At_, Bt_) { __builtin_amdgcn_s_setprio(1); \
    _Pragma("unroll") for (int m = 0; m < 4; ++m) _Pragma("unroll") for (int n = 0; n < 2; ++n) _Pragma("unroll") for (int k = 0; k < 2; ++k) \
      acc[ai][bj][m][n] = __builtin_amdgcn_mfma_f32_16x16x32_bf16(At_[m][k], Bt_[n][k], acc[ai][bj][m][n], 0, 0, 0); \
    __builtin_amdgcn_s_setprio(0); }
#define WAIT_V(n) asm volatile("s_waitcnt vmcnt(" #n ")" ::: "memory")
#define WAIT_L(n) asm volatile("s_waitcnt lgkmcnt(" #n ")" ::: "memory")
#define BAR __builtin_amdgcn_s_barrier()
#define SCHED __builtin_amdgcn_sched_barrier(0)
  bf16x8 At[4][2], B0[2][2], B1[2][2];
  constexpr int nt = 16;
  if (!SKIP_FIRST) { STAGE_Y(0, 0, 0); STAGE_X(0, 0, 0); STAGE_Y(0, 1, 0); STAGE_X(0, 1, 0); }
  if (wr == 1) BAR;
  WAIT_V(4); BAR;
  STAGE_Y(1, 0, 1); STAGE_X(1, 0, 1); STAGE_Y(1, 1, 1);
  WAIT_V(6); BAR;
#pragma unroll 1
  for (int t = 0; t < nt - 2; t += 2) {
    LDB(B0, 0, 0); SCHED; LDA(At, 0, 0); STAGE_X(1, 1, t + 1);
    WAIT_L(8); BAR; WAIT_L(0); MMA(0, 0, At, B0); BAR; SCHED;
    LDB(B1, 0, 1); STAGE_Y(0, 0, t + 2);
    BAR; WAIT_L(0); MMA(0, 1, At, B1); BAR;
    LDA(At, 0, 1); STAGE_X(0, 0, t + 2);
    BAR; WAIT_L(0); MMA(1, 0, At, B0); BAR; SCHED;
    STAGE_Y(0, 1, t + 2);
    WAIT_V(6); BAR; MMA(1, 1, At, B1); BAR;
    LDB(B0, 1, 0); SCHED; LDA(At, 1, 0); STAGE_X(0, 1, t + 2);
    WAIT_L(8); BAR; WAIT_L(0); MMA(0, 0, At, B0); BAR; SCHED;
    LDB(B1, 1, 1); STAGE_Y(1, 0, t + 3);
    BAR; WAIT_L(0); MMA(0, 1, At, B1); BAR;
    LDA(At, 1, 1); STAGE_X(1, 0, t + 3);
    BAR; WAIT_L(0); MMA(1, 0, At, B0); BAR; SCHED;
    STAGE_Y(1, 1, t + 3);
    WAIT_V(6); BAR; MMA(1, 1, At, B1); BAR;
  }
  { LDB(B0, 0, 0); LDA(At, 0, 0); STAGE_X(1, 1, nt - 1);
    BAR; WAIT_L(0); MMA(0, 0, At, B0); BAR;
    LDB(B1, 0, 1); BAR; WAIT_L(0); MMA(0, 1, At, B1); BAR;
    LDA(At, 0, 1); WAIT_V(4); BAR; WAIT_L(0); MMA(1, 0, At, B0); MMA(1, 1, At, B1); BAR; }
  { LDB(B0, 1, 0); LDA(At, 1, 0); WAIT_V(2); BAR; WAIT_L(0); MMA(0, 0, At, B0); BAR;
    LDB(B1, 1, 1); WAIT_V(0); BAR; WAIT_L(0); MMA(0, 1, At, B1); BAR;
    LDA(At, 1, 1); BAR; WAIT_L(0); MMA(1, 0, At, B0); MMA(1, 1, At, B1); BAR; }
  if (wr == 0) BAR;
#undef HTB
#undef SAo
#undef SBo
#undef GLDS
#undef STAGE_X
#undef STAGE_Y
#undef LDA
#undef LDB
#undef MMA
#undef WAIT_V
#undef WAIT_L
#undef BAR
#undef SCHED
}

__device__ __forceinline__ void gemm_8phase_first(const u16* __restrict__ X, const u16* __restrict__ Y, char* smem) {
  const int tid = otid512();
  char* const sdst = smem + tid * 16;
#pragma unroll
  for (int h = 0; h < 2; ++h) {
#pragma unroll
    for (int s = 0; s < 2; ++s) {
#pragma unroll
      for (int i = 0; i < 2; ++i) {
        const int b = tid * 16 + i * 8192;
        const int st = b >> 10, sb = b & 1023, swz = sb ^ (((sb >> 9) & 1) << 5);
        const int R = (st >> 1) * 16 + (swz >> 6), C = (st & 1) * 32 + ((swz & 63) >> 1);
        const u16* g = (s == 0 ? Y + R * 64 : X + perm64(R) * 64) + C + (size_t)h * 8192;
        char* d = sdst + (s == 0 ? 65536 : 0) + h * 16384 + i * 8192;
        __builtin_amdgcn_global_load_lds((const unsigned*)g, (unsigned*)d, 16, 0, 0);
      }
    }
  }
}

__device__ void phaseA(const Params& p, int l, char* smem, int vid) {
  const int tid = otid512(), lane = tid & 63, wid = tid >> 6;
  const int wr = wid >> 2, wc = wid & 3, fr = lane & 15, fq = lane >> 4;
  const u16* W = p.wt_in + (size_t)l * 8192 * 1024;
  float* newk = p.out + 8388608;
  float* newv = p.out + 16777216;
#define TILE_OF(id_, m0_, n0_)                                                     \
  {                                                                                \
    const int xcd_ = (id_) & 7, jj_ = (id_) >> 3;                                  \
    m0_ = (xcd_ * 4 + (jj_ & 3)) * 256; n0_ = ((jj_ >> 5) * 8 + ((jj_ >> 2) & 7)) * 256; \
  }
#define FIRST_OF(m0_, n0_)                                                                        \
  {                                                                                               \
    if ((n0_) >= 1024 && (n0_) < 1536) gemm_8phase_first(p.xm + (size_t)(m0_) * 1024, W + (size_t)(n0_) * 1024, smem); \
    else gemm_8phase_first(W + (size_t)(n0_) * 1024, p.xm + (size_t)(m0_) * 1024, smem);          \
  }
  if (vid < 1024) { int m0f, n0f; TILE_OF(vid, m0f, n0f); FIRST_OF(m0f, n0f); }
  for (int id = vid; id < 1024; id += gridDim.x) {
    int m0, n0;
    TILE_OF(id, m0, n0);
    const int idn = id + gridDim.x;
    int m0n = 0, n0n = 0;
    if (idn < 1024) TILE_OF(idn, m0n, n0n);
    f32x4 acc[2][2][4][2];
#pragma unroll
    for (int a_ = 0; a_ < 2; ++a_)
#pragma unroll
      for (int b_ = 0; b_ < 2; ++b_)
#pragma unroll
        for (int m = 0; m < 4; ++m)
#pragma unroll
          for (int n = 0; n < 2; ++n) acc[a_][b_][m][n] = f32x4{0.f, 0.f, 0.f, 0.f};
    const u16* At_ = p.xm + (size_t)m0 * 1024;
    const u16* Bw = W + (size_t)n0 * 1024;
    const float* swp = p.sW + (size_t)(l * 3 + (m0 < 4096 ? 0 : 1 + ((m0 - 4096) >> 11))) * 8192;
    if (n0 >= 1024 && n0 < 1536) {
      gemm_8phase<true>(At_, Bw, acc, smem);
      if (idn < 1024) FIRST_OF(m0n, n0n);
#pragma unroll
      for (int ai = 0; ai < 2; ++ai) {
        const int tok0 = m0 + ai * 128 + wr * 64 + fq * 16;
        float rs[16];
#pragma unroll
        for (int q = 0; q < 4; ++q) {
          const float4 s4 = *(const float4*)(p.rowss + (size_t)l * 8192 + tok0 + q * 4);
          rs[q * 4 + 0] = rsqrtf(s4.x * (1.f / 1024.f) + 1e-6f); rs[q * 4 + 1] = rsqrtf(s4.y * (1.f / 1024.f) + 1e-6f);
          rs[q * 4 + 2] = rsqrtf(s4.z * (1.f / 1024.f) + 1e-6f); rs[q * 4 + 3] = rsqrtf(s4.w * (1.f / 1024.f) + 1e-6f);
        }
#pragma unroll
        for (int bj = 0; bj < 2; ++bj)
#pragma unroll
          for (int n = 0; n < 2; ++n) {
            const float sw = swp[n0 + bj * 128 + wc * 32 + n * 16 + fr];
#pragma unroll
            for (int m = 0; m < 4; ++m)
#pragma unroll
              for (int jj = 0; jj < 4; ++jj) acc[ai][bj][m][n][jj] = acc[ai][bj][m][n][jj] * rs[m * 4 + jj] + sw;
          }
      }
#pragma unroll
      for (int ai = 0; ai < 2; ++ai)
#pragma unroll
        for (int bj = 0; bj < 2; ++bj)
#pragma unroll
          for (int n = 0; n < 2; ++n) {
            const int tok0 = m0 + ai * 128 + wr * 64 + fq * 16;
            const int vc = n0 + bj * 128 + wc * 32 + n * 16 + fr - 1024;
            uint4 w0 = make_uint4(pack2(acc[ai][bj][0][n][0], acc[ai][bj][0][n][1]), pack2(acc[ai][bj][0][n][2], acc[ai][bj][0][n][3]),
                                  pack2(acc[ai][bj][1][n][0], acc[ai][bj][1][n][1]), pack2(acc[ai][bj][1][n][2], acc[ai][bj][1][n][3]));
            uint4 w1 = make_uint4(pack2(acc[ai][bj][2][n][0], acc[ai][bj][2][n][1]), pack2(acc[ai][bj][2][n][2], acc[ai][bj][2][n][3]),
                                  pack2(acc[ai][bj][3][n][0], acc[ai][bj][3][n][1]), pack2(acc[ai][bj][3][n][2], acc[ai][bj][3][n][3]));
            *(uint4*)(p.Vt + (size_t)vc * 8192 + tok0) = w0;
            *(uint4*)(p.Vt + (size_t)vc * 8192 + tok0 + 8) = w1;
            if (tok0 < 4096) {
#pragma unroll
              for (int m = 0; m < 4; ++m)
#pragma unroll
                for (int jj = 0; jj < 4; ++jj) {
                  const int t = tok0 + m * 4 + jj;
                  __builtin_nontemporal_store(acc[ai][bj][m][n][jj], &newv[((size_t)((t >> 8) * 4 + l) * 256 + (t & 255)) * 512 + vc]);
                }
            }
          }
    } else {
      gemm_8phase<true>(Bw, At_, acc, smem);
      if (idn < 1024) FIRST_OF(m0n, n0n);
#pragma unroll
      for (int ai = 0; ai < 2; ++ai) {
        const float* swc = swp + n0 + ai * 128 + wr * 64 + fq * 16;
        float4 sw4[4];
#pragma unroll
        for (int m = 0; m < 4; ++m) sw4[m] = *(const float4*)(swc + m * 4);
#pragma unroll
        for (int bj = 0; bj < 2; ++bj)
#pragma unroll
          for (int n = 0; n < 2; ++n) {
            const int t = m0 + bj * 128 + wc * 32 + n * 16 + fr;
            const float rs = rsqrtf(p.rowss[(size_t)l * 8192 + t] * (1.f / 1024.f) + 1e-6f);
#pragma unroll
            for (int m = 0; m < 4; ++m) {
              acc[ai][bj][m][n][0] = acc[ai][bj][m][n][0] * rs + sw4[m].x; acc[ai][bj][m][n][1] = acc[ai][bj][m][n][1] * rs + sw4[m].y;
              acc[ai][bj][m][n][2] = acc[ai][bj][m][n][2] * rs + sw4[m].z; acc[ai][bj][m][n][3] = acc[ai][bj][m][n][3] * rs + sw4[m].w;
            }
          }
      }
      const bool isK = (n0 >= 512 && n0 < 1024);
#pragma unroll
      for (int ai = 0; ai < 2; ++ai)
#pragma unroll
        for (int bj = 0; bj < 2; ++bj)
#pragma unroll
          for (int n = 0; n < 2; ++n) {
            const int t = m0 + bj * 128 + wc * 32 + n * 16 + fr;
            const int col = n0 + ai * 128 + wr * 64 + fq * 16;
            uint4 w0 = make_uint4(pack2(acc[ai][bj][0][n][0], acc[ai][bj][0][n][1]), pack2(acc[ai][bj][0][n][2], acc[ai][bj][0][n][3]),
                                  pack2(acc[ai][bj][1][n][0], acc[ai][bj][1][n][1]), pack2(acc[ai][bj][1][n][2], acc[ai][bj][1][n][3]));
            uint4 w1 = make_uint4(pack2(acc[ai][bj][2][n][0], acc[ai][bj][2][n][1]), pack2(acc[ai][bj][2][n][2], acc[ai][bj][2][n][3]),
                                  pack2(acc[ai][bj][3][n][0], acc[ai][bj][3][n][1]), pack2(acc[ai][bj][3][n][2], acc[ai][bj][3][n][3]));
            if (n0 >= 5120) {
              __builtin_nontemporal_store(u32x4{w0.x, w0.y, w0.z, w0.w}, (u32x4*)(p.P + (size_t)t * 8192 + col));
              __builtin_nontemporal_store(u32x4{w1.x, w1.y, w1.z, w1.w}, (u32x4*)(p.P + (size_t)t * 8192 + col + 8));
            } else {
              *(uint4*)(p.P + (size_t)t * 8192 + col) = w0;
              *(uint4*)(p.P + (size_t)t * 8192 + col + 8) = w1;
            }
            if (isK && t < 4096) {
              float* dst = newk + ((size_t)((t >> 8) * 4 + l) * 256 + (t & 255)) * 512 + (col - 512);
#pragma unroll
              for (int m = 0; m < 4; ++m)
                stnt4(dst + m * 4, acc[ai][bj][m][n][0], acc[ai][bj][m][n][1], acc[ai][bj][m][n][2], acc[ai][bj][m][n][3]);
            }
          }
    }
  }
}

__device__ __forceinline__ bf16x8 ld16(const u16* ptr) { return *(const bf16x8*)ptr; }

struct VbBar { unsigned* cnt; unsigned target; };
template <bool DRAIN_VM = true>
__device__ __forceinline__ void vb_barrier(VbBar& vb) {
  if (DRAIN_VM) asm volatile("s_waitcnt vmcnt(0) lgkmcnt(0)" ::: "memory");
  else asm volatile("s_waitcnt lgkmcnt(0)" ::: "memory");
  vb.target += 4;
  if ((threadIdx.x & 63) == 0) __hip_atomic_fetch_add(vb.cnt, 1u, __ATOMIC_RELAXED, __HIP_MEMORY_SCOPE_WORKGROUP);
  while (__hip_atomic_load(vb.cnt, __ATOMIC_RELAXED, __HIP_MEMORY_SCOPE_WORKGROUP) < vb.target) { }
  asm volatile("" ::: "memory");
}

template <> __device__ __forceinline__ void item_barrier<false>(VbBar*) { __syncthreads(); }
template <> __device__ __forceinline__ void item_barrier<true>(VbBar* vb) { vb_barrier(*vb); }

template <int NS, bool LOCAL>
__device__ __forceinline__ void attn_step(const char* kbuf, const char* vbuf, int ka0, int ka1, int va, const bf16x8& q0,
                                          const bf16x8& q1, f32x4 (&o)[4], float& m, float& lsum, const char* rpb_row,
                                          const int (&boff)[8], unsigned vmask) {
  f32x4 s[2 * NS];
#pragma unroll
  for (int t = 0; t < 2 * NS; ++t) {
    const bf16x8 a0 = *(const bf16x8*)(kbuf + ka0 + (t >> 1) * 4096 + (t & 1) * 512);
    const bf16x8 a1 = *(const bf16x8*)(kbuf + ka1 + (t >> 1) * 4096 + (t & 1) * 512);
    f32x4 z = f32x4{0.f, 0.f, 0.f, 0.f};
    z = __builtin_amdgcn_mfma_f32_16x16x32_bf16(a0, q0, z, 0, 0, 0);
    s[t] = __builtin_amdgcn_mfma_f32_16x16x32_bf16(a1, q1, z, 0, 0, 0);
  }
  bf16x8 vf[NS][4];
#pragma unroll
  for (int sl = 0; sl < NS; ++sl)
#pragma unroll
    for (int dt = 0; dt < 4; ++dt) vf[sl][dt] = *(const bf16x8*)(vbuf + ((va + dt * 2048) ^ (sl * 64)));
  float cmax = -1e30f;
#pragma unroll
  for (int t = 0; t < 2 * NS; ++t)
#pragma unroll
    for (int jj = 0; jj < 4; ++jj) {
      float v = s[t][jj] * 0.18033688f;
      if (LOCAL) {
        const int e8 = (t & 1) * 4 + jj;
        const float bias = *(const float*)(rpb_row + boff[e8]);
        v = ((vmask >> e8) & 1u) ? v + bias : -1e30f;
      }
      s[t][jj] = v;
      cmax = fmaxf(cmax, v);
    }
  cmax = xrow16_max(cmax);
  const float mnew = fmaxf(m, cmax);
  if (__builtin_amdgcn_ballot_w64(mnew > m) != 0ull) {
    const float alpha = __builtin_amdgcn_exp2f(m - mnew);
    lsum *= alpha;
#pragma unroll
    for (int dt = 0; dt < 4; ++dt) o[dt] *= alpha;
    m = mnew;
  }
#pragma unroll
  for (int t = 0; t < 2 * NS; ++t)
#pragma unroll
    for (int jj = 0; jj < 4; ++jj) {
      const float pv = __builtin_amdgcn_exp2f(s[t][jj] - m);
      lsum += pv;
      s[t][jj] = pv;
    }
#pragma unroll
  for (int sl = 0; sl < NS; ++sl) {
    u32x4 pw = {pack2(s[2 * sl][0], s[2 * sl][1]), pack2(s[2 * sl][2], s[2 * sl][3]),
                pack2(s[2 * sl + 1][0], s[2 * sl + 1][1]), pack2(s[2 * sl + 1][2], s[2 * sl + 1][3])};
    const bf16x8 pb = __builtin_bit_cast(bf16x8, pw);
#pragma unroll
    for (int dt = 0; dt < 4; ++dt) o[dt] = __builtin_amdgcn_mfma_f32_16x16x32_bf16(vf[sl][dt], pb, o[dt], 0, 0, 0);
  }
}

__device__ void attn_item(const Params& p, int l, int item, char* smem, VbBar& vb) {
  const int tid = otid(), lane = tid & 63, fr = lane & 15, fq = lane >> 4;
  const int wave = __builtin_amdgcn_readfirstlane(tid >> 6);
  const bool lat = item >= 512;
  int b, h, qtok0, r = 0, n = 0, row0 = 0, band0 = 0;
  if (!lat) {
    const int unit = item * 4 + wave;
    b = unit >> 7; h = (unit >> 4) & 7;
    qtok0 = b * 256 + (unit & 15) * 16;
  } else {
    const int u = (item - 512) * 4 + wave;
    b = u >> 10; r = (u >> 5) & 31; h = (u >> 2) & 7; n = u & 3;
    qtok0 = 4096 + b * 2048 + r * 64 + n * 16;
    row0 = min(max(r - 4, 0), 24);
    band0 = min(max(16 * n - 8, 0), 32);
  }
  float* rpb = (float*)(smem + 57344 + wave * 2048);
  if (lat) {
    const float* rg = p.na_rpb + (size_t)(l * 8 + h) * 15 * 31;
#pragma unroll
    for (int i = 0; i < 8; ++i) {
      const int idx = lane + 64 * i;
      if (idx < 465) rpb[idx] = rg[idx] * 1.44269504f;
    }
  }
  const u16* qp = p.P + (size_t)(qtok0 + fr) * 8192 + h * 64 + fq * 8;
  const bf16x8 q0 = ld16(qp), q1 = ld16(qp + 32);
  f32x4 o[4];
#pragma unroll
  for (int dt = 0; dt < 4; ++dt) o[dt] = f32x4{0.f, 0.f, 0.f, 0.f};
  float m = -1e30f, lsum = 0.f;
  const int qc = 16 * n + fr;
  const int wst = min(max(qc - 8, 0), 48);
  const int nch = lat ? 12 : 4;
  const int fk0 = ((fr >> 1) & 1) | (((fr >> 2) & 3) << 1);
  const int fkL = ((fr >> 1) & 1) | ((((band0 >> 3) + (fr >> 2)) & 3) << 1);
  const int krow = (fr >> 2) * 8 + (fr & 3);
  const int ka0_0 = krow * 128 + ((fq ^ fk0) << 4), ka1_0 = krow * 128 + (((4 + fq) ^ fk0) << 4);
  const int ka0_L = (band0 + krow) * 128 + ((fq ^ fkL) << 4), ka1_L = (band0 + krow) * 128 + (((4 + fq) ^ fkL) << 4);
  const int va_0 = fr * 128 + ((fq ^ ((fr >> 1) & 7)) << 4);
  const int va_L = fr * 128 + ((((band0 >> 3) + fq) ^ ((fr >> 1) & 7)) << 4);
  int boff[8];
  unsigned vmask = 0u;
#pragma unroll
  for (int e8 = 0; e8 < 8; ++e8) {
    const int kc = band0 + fq * 8 + e8;
    boff[e8] = (min(max(kc - qc, -15), 15) + 15) * 4;
    vmask |= ((kc >= wst) && (kc < wst + 16)) ? (1u << e8) : 0u;
  }
  const int lrow = tid >> 3, lpc = tid & 7;
  const int klc = lpc ^ (((lrow >> 1) & 1) | (((lrow >> 3) & 3) << 1));
  const int vlc = lpc ^ ((lrow >> 1) & 7);
#define GLDS(gp, lp) __builtin_amdgcn_global_load_lds((const unsigned*)(gp), (unsigned*)(lp), 16, 0, 0)
#define ISSUE_CHUNK(c)                                                                                           \
  {                                                                                                              \
    const u16 *kb_, *vb_; size_t ks_, vs_;                                                                       \
    if (!lat) {                                                                                                  \
      const size_t key0 = (size_t)b * 256 + (c) * 64;                                                            \
      kb_ = p.P + key0 * 8192 + 512 + h * 64; ks_ = 8192;                                                        \
      vb_ = p.Vt + (size_t)(h * 64) * 8192 + key0; vs_ = 8192;                                                   \
    } else if ((c) < 8) {                                                                                        \
      const size_t tok = 4096 + (size_t)b * 2048 + (row0 + (c)) * 64;                                            \
      kb_ = p.P + tok * 8192 + 512 + h * 64; ks_ = 8192;                                                         \
      vb_ = p.Vt + (size_t)(h * 64) * 8192 + tok; vs_ = 8192;                                                    \
    } else {                                                                                                     \
      kb_ = p.ckb + ((size_t)(b * 4 + l) * 256 + ((c) - 8) * 64) * 512 + h * 64; ks_ = 512;                      \
      vb_ = p.cvT + (size_t)((b * 4 + l) * 8 + h) * 64 * 256 + ((c) - 8) * 64; vs_ = 256;                        \
    }                                                                                                            \
    char* dst_ = smem + ((c) % 3) * 16384 + tid * 16;                                                            \
    GLDS(kb_ + (size_t)lrow * ks_ + klc * 8, dst_);                                                              \
    GLDS(kb_ + (size_t)(lrow + 32) * ks_ + klc * 8, dst_ + 4096);                                                \
    GLDS(vb_ + (size_t)lrow * vs_ + vlc * 8, dst_ + 8192);                                                       \
    GLDS(vb_ + (size_t)(lrow + 32) * vs_ + vlc * 8, dst_ + 12288);                                               \
  }
  ISSUE_CHUNK(0);
  ISSUE_CHUNK(1);
#pragma unroll 1
  for (int c = 0; c < nch; ++c) {
    if (c + 1 < nch) asm volatile("s_waitcnt vmcnt(4)" ::: "memory");
    else asm volatile("s_waitcnt vmcnt(0)" ::: "memory");
    vb_barrier<false>(vb);
    if (c + 2 < nch) ISSUE_CHUNK(c + 2);
    const char* kbuf = smem + (c % 3) * 16384;
    const char* vbuf = kbuf + 8192;
    if (lat && c < 8)
      attn_step<1, true>(kbuf, vbuf, ka0_L, ka1_L, va_L, q0, q1, o, m, lsum, (const char*)(rpb + (row0 + c - r + 7) * 31), boff, vmask);
    else
      attn_step<2, false>(kbuf, vbuf, ka0_0, ka1_0, va_0, q0, q1, o, m, lsum, (const char*)rpb, boff, vmask);
  }
#undef ISSUE_CHUNK
#undef GLDS
  lsum += __shfl_xor(lsum, 16);
  lsum += __shfl_xor(lsum, 32);
  const float inv = 1.f / lsum;
  const size_t t = qtok0 + fr;
#pragma unroll
  for (int dt = 0; dt < 4; ++dt) {
    int d0 = h * 64 + dt * 16 + fq * 4;
    uint2 g = *(const uint2*)(p.P + t * 8192 + 1536 + d0);
    float y0 = o[dt][0] * inv * silu(lo16(g.x)), y1 = o[dt][1] * inv * silu(hi16(g.x));
    float y2 = o[dt][2] * inv * silu(lo16(g.y)), y3 = o[dt][3] * inv * silu(hi16(g.y));
    *(uint2*)(p.Ana + t * 512 + d0) = make_uint2(pack2(y0, y1), pack2(y2, y3));
  }
  vb_barrier(vb);
}

template <int DIR>
__device__ __forceinline__ void lru_gates_scan(const Params& p, int l, int blk, int wave, int fr, int fq,
                                               const bf16x8 (&wr)[8], const bf16x8 (&wi)[8], const float (&pba)[4],
                                               const float (&pbx)[4], const float (&psp)[4], const u16* udb, const float* sud,
                                               float* stot, float (&acw)[4][4], float (&hw)[4][4]) {
  f32x4 ar[4], ai[4];
#pragma unroll
  for (int nt = 0; nt < 4; ++nt) { ar[nt] = f32x4{0.f, 0.f, 0.f, 0.f}; ai[nt] = f32x4{0.f, 0.f, 0.f, 0.f}; }
#pragma unroll
  for (int ks = 0; ks < 2; ++ks) {
    const bf16x8 af = *(const bf16x8*)(udb + (wave * 16 + fr) * 72 + ks * 32 + fq * 8);
#pragma unroll
    for (int nt = 0; nt < 4; ++nt) {
      ar[nt] = __builtin_amdgcn_mfma_f32_16x16x32_bf16(af, wr[ks * 4 + nt], ar[nt], 0, 0, 0);
      ai[nt] = __builtin_amdgcn_mfma_f32_16x16x32_bf16(af, wi[ks * 4 + nt], ai[nt], 0, 0, 0);
    }
  }
#pragma unroll
  for (int nt = 0; nt < 4; ++nt) {
    const int k = nt * 16 + fr;
    const float ba = pba[nt], bx = pbx[nt], sp = psp[nt];
    float av[4], bv[4];
#pragma unroll
    for (int jj = 0; jj < 4; ++jj) {
      const int t = wave * 16 + fq * 4 + jj;
      const float rg = sigm(ar[nt][jj] + ba), ig = sigm(ai[nt][jj] + bx);
      const float la = -rg * sp;
      const float a = __expf(la);
      const float ud = sud[t * 64 + k];
      const float x2 = 2.f * la;
      const float ser = -x2 * (1.f + x2 * (0.5f + x2 * (0.16666667f + x2 * (0.041666668f + x2 * (0.0083333338f + x2 * 0.0013888889f)))));
      const float om = x2 > -0.5f ? ser : 1.f - a * a;
      av[jj] = a;
      bv[jj] = __builtin_amdgcn_sqrtf(om) * (ig * ud);
    }
    float h = 0.f, ac = 1.f;
#pragma unroll
    for (int q = 0; q < 4; ++q) {
      const int jj = DIR ? 3 - q : q;
      h = av[jj] * h + bv[jj];
      ac *= av[jj];
      acw[nt][jj] = ac; hw[nt][jj] = h;
    }
    float gA[4], gH[4];
#pragma unroll
    for (int g = 0; g < 4; ++g) { gA[g] = __shfl(ac, fr + 16 * g); gH[g] = __shfl(h, fr + 16 * g); }
    float cA = 1.f, cH = 0.f, wA = 1.f, wH = 0.f;
#pragma unroll
    for (int q = 0; q < 4; ++q) {
      const int g = DIR ? 3 - q : q;
      const bool before = DIR ? (g > fq) : (g < fq);
      if (before) { cH = gA[g] * cH + gH[g]; cA *= gA[g]; }
      wH = gA[g] * wH + gH[g]; wA *= gA[g];
    }
#pragma unroll
    for (int jj = 0; jj < 4; ++jj) { hw[nt][jj] = hw[nt][jj] + acw[nt][jj] * cH; acw[nt][jj] *= cA; }
    if (fq == 0) { stot[((DIR * 4 + wave) * 64 + k) * 2] = wA; stot[((DIR * 4 + wave) * 64 + k) * 2 + 1] = wH; }
  }
}

template <int DIR>
__device__ __forceinline__ void lru_finish(const Params& p, int cs, int blk, int wave, int fr, int fq, const float* stot,
                                           float (&acw)[4][4], float (&hw)[4][4], u16* hst, u16* ast) {
#pragma unroll
  for (int nt = 0; nt < 4; ++nt) {
    const int k = nt * 16 + fr;
    float cA = 1.f, cH = 0.f, tA = 1.f, tH = 0.f;
#pragma unroll
    for (int q = 0; q < 4; ++q) {
      const int w2 = DIR ? 3 - q : q;
      const float A2 = stot[((DIR * 4 + w2) * 64 + k) * 2], H2 = stot[((DIR * 4 + w2) * 64 + k) * 2 + 1];
      const bool before = DIR ? (w2 > wave) : (w2 < wave);
      if (before) { cH = A2 * cH + H2; cA *= A2; }
      tH = A2 * tH + H2; tA *= A2;
    }
#pragma unroll
    for (int jj = 0; jj < 4; ++jj) {
      const int t = wave * 16 + fq * 4 + jj;
      hst[t * 64 + k] = (u16)f2bf(hw[nt][jj] + acw[nt][jj] * cH);
      ast[t * 64 + k] = (u16)f2bf(acw[nt][jj] * cA);
    }
    if (fq == 0 && nt == wave) {
      p.Atot[(size_t)(cs * 2 + DIR) * 512 + blk * 64 + k] = tA;
      p.Htot[(size_t)(cs * 2 + DIR) * 512 + blk * 64 + k] = tH;
    }
  }
}

__device__ void lru_unit2(const Params& p, int l, int unit, char* smem, VbBar& vb) {
  const int tid = otid(), lane = tid & 63, fr = lane & 15, fq = lane >> 4;
  const int wave = __builtin_amdgcn_readfirstlane(tid >> 6);
  const int blk = unit & 7, cs = unit >> 3;
  const int t0 = cs * 64;
  int seq_lo, seq_hi;
  if (cs < 64) { seq_lo = (cs >> 2) * 256; seq_hi = seq_lo + 256; }
  else { seq_lo = 4096 + ((cs - 64) >> 5) * 2048; seq_hi = seq_lo + 2048; }
  u16* uraw = (u16*)smem;
  u16* udb0 = (u16*)(smem + 8960);
  u16* udb1 = (u16*)(smem + 18176);
  float* sud0 = (float*)(smem + 27392);
  float* sud1 = (float*)(smem + 43776);
  float* stot = (float*)(smem + 60160);
  bf16x8 wr0[8], wi0[8];
  {
    const u16* wrp = p.wgT + (size_t)(((l * 2 + 0) * 2 + 0) * 8 + blk) * 4096 + fr * 64 + fq * 8;
    const u16* wip = p.wgT + (size_t)(((l * 2 + 0) * 2 + 1) * 8 + blk) * 4096 + fr * 64 + fq * 8;
#pragma unroll
    for (int ks = 0; ks < 2; ++ks)
#pragma unroll
      for (int nt = 0; nt < 4; ++nt) { wr0[ks * 4 + nt] = ld16(wrp + nt * 1024 + ks * 32); wi0[ks * 4 + nt] = ld16(wip + nt * 1024 + ks * 32); }
  }
  float pba0[4], pbx0[4], psp0[4], pba1[4], pbx1[4], psp1[4], cvw[10];
#pragma unroll
  for (int nt = 0; nt < 4; ++nt) {
    const int pi0 = (l * 2 + 0) * 512 + blk * 64 + nt * 16 + fr, pi1 = pi0 + 512;
    pba0[nt] = p.lru_ba[pi0]; pbx0[nt] = p.lru_bx[pi0]; psp0[nt] = p.sp8[pi0];
    pba1[nt] = p.lru_ba[pi1]; pbx1[nt] = p.lru_bx[pi1]; psp1[nt] = p.sp8[pi1];
  }
  {
    const int cw = blk * 64 + (tid & 63);
    const float* cf = p.lru_conv_w + (size_t)((l * 2 + 0) * 4) * 512 + cw;
    const float* cbk = p.lru_conv_w + (size_t)((l * 2 + 1) * 4) * 512 + cw;
    cvw[0] = cf[0]; cvw[1] = cf[512]; cvw[2] = cf[1024]; cvw[3] = cf[1536];
    cvw[4] = cbk[0]; cvw[5] = cbk[512]; cvw[6] = cbk[1024]; cvw[7] = cbk[1536];
    cvw[8] = p.lru_conv_b[(l * 2 + 0) * 512 + cw]; cvw[9] = p.lru_conv_b[(l * 2 + 1) * 512 + cw];
  }
#pragma unroll
  for (int i = 0; i < 3; ++i) {
    const int row = (tid >> 3) + i * 32, ch8 = tid & 7;
    if (row < 70) {
      const int t = t0 - 3 + row;
      uint4 v = make_uint4(0, 0, 0, 0);
      if (t >= seq_lo && t < seq_hi) v = *(const uint4*)(p.P + (size_t)t * 8192 + 2048 + blk * 64 + ch8 * 8);
      *(uint4*)(uraw + row * 64 + ch8 * 8) = v;
    }
  }
  vb_barrier(vb);
#pragma unroll
  for (int nt = 0; nt < 4; ++nt) {
    asm volatile("" : "+v"(pba0[nt]), "+v"(pbx0[nt]), "+v"(psp0[nt]), "+v"(pba1[nt]), "+v"(pbx1[nt]), "+v"(psp1[nt]));
  }
#pragma unroll
  for (int q = 0; q < 10; ++q) asm volatile("" : "+v"(cvw[q]));
  {
    const int ch = tid & 63, tg = tid >> 6;
    const float f0 = cvw[0], f1 = cvw[1], f2 = cvw[2], f3 = cvw[3];
    const float b0 = cvw[4], b1 = cvw[5], b2 = cvw[6], b3 = cvw[7];
    const float bf_ = cvw[8], bb_ = cvw[9];
    float uw[22];
#pragma unroll
    for (int q = 0; q < 22; ++q) uw[q] = bf2f(uraw[(tg * 16 + q) * 64 + ch]);
#pragma unroll
    for (int q = 0; q < 16; ++q) {
      const int t = tg * 16 + q;
      const float uf = bf_ + f0 * uw[q] + f1 * uw[q + 1] + f2 * uw[q + 2] + f3 * uw[q + 3];
      const float ub = bb_ + b0 * uw[q + 3] + b1 * uw[q + 4] + b2 * uw[q + 5] + b3 * uw[q + 6];
      sud0[t * 64 + ch] = uf; udb0[t * 72 + ch] = (u16)f2bf(uf);
      sud1[t * 64 + ch] = ub; udb1[t * 72 + ch] = (u16)f2bf(ub);
    }
  }
  vb_barrier(vb);
  bf16x8 wr1[8], wi1[8];
  {
    const u16* wrp = p.wgT + (size_t)(((l * 2 + 1) * 2 + 0) * 8 + blk) * 4096 + fr * 64 + fq * 8;
    const u16* wip = p.wgT + (size_t)(((l * 2 + 1) * 2 + 1) * 8 + blk) * 4096 + fr * 64 + fq * 8;
#pragma unroll
    for (int ks = 0; ks < 2; ++ks)
#pragma unroll
      for (int nt = 0; nt < 4; ++nt) { wr1[ks * 4 + nt] = ld16(wrp + nt * 1024 + ks * 32); wi1[ks * 4 + nt] = ld16(wip + nt * 1024 + ks * 32); }
  }
  float ac0[4][4], h0[4][4], ac1[4][4], h1[4][4];
  lru_gates_scan<0>(p, l, blk, wave, fr, fq, wr0, wi0, pba0, pbx0, psp0, udb0, sud0, stot, ac0, h0);
  lru_gates_scan<1>(p, l, blk, wave, fr, fq, wr1, wi1, pba1, pbx1, psp1, udb1, sud1, stot, ac1, h1);
  vb_barrier(vb);
  u16* hst0 = (u16*)sud0; u16* ast0 = hst0 + 4096;
  u16* hst1 = (u16*)sud1; u16* ast1 = hst1 + 4096;
  lru_finish<0>(p, cs, blk, wave, fr, fq, stot, ac0, h0, hst0, ast0);
  lru_finish<1>(p, cs, blk, wave, fr, fq, stot, ac1, h1, hst1, ast1);
  vb_barrier(vb);
#pragma unroll
  for (int i = 0; i < 2; ++i) {
    const int row = (tid >> 3) + i * 32, c8 = tid & 7;
    const size_t g0 = ((size_t)t0 + row) * 512 + blk * 64 + c8 * 8;
    const size_t g1 = ((size_t)8192 + t0 + row) * 512 + blk * 64 + c8 * 8;
    *(uint4*)(p.hloc + g0) = *(const uint4*)(hst0 + row * 64 + c8 * 8);
    *(uint4*)(p.acum + g0) = *(const uint4*)(ast0 + row * 64 + c8 * 8);
    *(uint4*)(p.hloc + g1) = *(const uint4*)(hst1 + row * 64 + c8 * 8);
    *(uint4*)(p.acum + g1) = *(const uint4*)(ast1 + row * 64 + c8 * 8);
  }
  vb_barrier(vb);
}

__device__ __forceinline__ void unpack8(uint4 v, float (&f)[8]) {
  f[0] = lo16(v.x); f[1] = hi16(v.x); f[2] = lo16(v.y); f[3] = hi16(v.y);
  f[4] = lo16(v.z); f[5] = hi16(v.z); f[6] = lo16(v.w); f[7] = hi16(v.w);
}

__device__ void conv_item(const Params& p, int l, int u) {
  const int tid = otid();
  const int cs = u >> 2, quarter = u & 3;
  int seq_lo, seq_hi;
  if (cs < 64) { seq_lo = (cs >> 2) * 256; seq_hi = seq_lo + 256; }
  else { seq_lo = 4096 + ((cs - 64) >> 5) * 2048; seq_hi = seq_lo + 2048; }
  const int c8 = tid & 15, ch0 = quarter * 128 + c8 * 8;
  float w0[8], w1[8], w2[8];
#pragma unroll
  for (int e = 0; e < 8; ++e) {
    w0[e] = p.conv_w[(l * 3 + 0) * 512 + ch0 + e]; w1[e] = p.conv_w[(l * 3 + 1) * 512 + ch0 + e];
    w2[e] = p.conv_w[(l * 3 + 2) * 512 + ch0 + e];
  }
#pragma unroll 2
  for (int i = 0; i < 4; ++i) {
    const int t = cs * 64 + (tid >> 4) + i * 16;
    const u16* pr = p.P + (size_t)t * 8192 + ch0;
    const uint4 z4 = make_uint4(0u, 0u, 0u, 0u);
    uint4 cb4 = *(const uint4*)(pr + 3072), gc4 = *(const uint4*)(pr + 4608);
    uint4 cc1 = *(const uint4*)(pr + 3584), chh1 = *(const uint4*)(pr + 4096);
    uint4 cc0 = z4, chh0 = z4, cc2 = z4, chh2 = z4;
    if (t - 1 >= seq_lo) { cc0 = *(const uint4*)(pr - 8192 + 3584); chh0 = *(const uint4*)(pr - 8192 + 4096); }
    if (t + 1 < seq_hi) { cc2 = *(const uint4*)(pr + 8192 + 3584); chh2 = *(const uint4*)(pr + 8192 + 4096); }
    float cbv[8], gc[8], a0[8], b0[8], a1[8], b1[8], a2[8], b2[8], oc[8];
    unpack8(cb4, cbv); unpack8(gc4, gc);
    unpack8(cc0, a0); unpack8(chh0, b0); unpack8(cc1, a1); unpack8(chh1, b1); unpack8(cc2, a2); unpack8(chh2, b2);
#pragma unroll
    for (int e = 0; e < 8; ++e) {
      const float conv = w0[e] * (a0[e] * b0[e]) + w1[e] * (a1[e] * b1[e]) + w2[e] * (a2[e] * b2[e]);
      oc[e] = cbv[e] * conv * silu(gc[e]);
    }
    *(uint4*)(p.Aconv + (size_t)t * 512 + ch0) = make_uint4(pack2(oc[0], oc[1]), pack2(oc[2], oc[3]), pack2(oc[4], oc[5]), pack2(oc[6], oc[7]));
  }
}

__device__ void phaseB(const Params& p, int l, char* smem, VbBar& vb) {
  const int half = __builtin_amdgcn_readfirstlane((int)(threadIdx.x >> 8));
  const int v = vbid();
  for (int k = 0; k < 2560; k += NVB) {
    int it = v + k;
    if (it < 2048 && half) it = (it + 1024) & 2047;
    if (it < 1024) attn_item(p, l, it, smem, vb);
    else if (it < 2048) lru_unit2(p, l, it - 1024, smem, vb);
    else conv_item(p, l, it - 2048);
  }
  if (l < 3) {
    for (int it = v; it < 1344; it += NVB) weight_unit<true>(p, l + 1, it, (float*)smem, &vb);
  }
}

__device__ void phaseB2(const Params& p, int l, char* smem) {
  const int tid = otid();
  float* scar = (float*)smem;
  float* new_state = p.out + 25165824;
  for (int u = vbid(); u < 512; u += NVB) {
    const int cs = u >> 2, quarter = u & 3;
    int first, c, nch, b, seq_lo, seq_hi;
    const bool lat = cs >= 64;
    if (!lat) { b = cs >> 2; c = cs & 3; nch = 4; first = b * 4; seq_lo = b * 256; seq_hi = seq_lo + 256; }
    else { b = (cs - 64) >> 5; c = (cs - 64) & 31; nch = 32; first = 64 + b * 32; seq_lo = 4096 + b * 2048; seq_hi = seq_lo + 2048; }
    {
      const int dir = tid >> 7, ch = quarter * 128 + (tid & 127);
      float carry = lat ? p.state_lru[(size_t)((b * 4 + l) * 2 + dir) * 512 + ch] : 0.f;
      const int nprev = dir ? (nch - 1 - c) : c;
      const int start = dir ? (nch - 1) : 0, step = dir ? -1 : 1;
      if (!lat) {
        float A_[3], H_[3];
#pragma unroll
        for (int s = 0; s < 3; ++s) {
          const int cc = min(max(start + step * s, 0), 3);
          const size_t ix = (size_t)((first + cc) * 2 + dir) * 512 + ch;
          A_[s] = p.Atot[ix]; H_[s] = p.Htot[ix];
        }
#pragma unroll
        for (int s = 0; s < 3; ++s) if (s < nprev) carry = A_[s] * carry + H_[s];
        const bool last = dir ? (c == 0) : (c == 3);
        if (last) {
          const size_t ix = (size_t)(cs * 2 + dir) * 512 + ch;
          new_state[(size_t)((b * 4 + l) * 2 + dir) * 512 + ch] = p.Atot[ix] * carry + p.Htot[ix];
        }
      } else {
        float A_[31], H_[31];
#pragma unroll
        for (int s = 0; s < 31; ++s) {
          const int cc = min(max(start + step * s, 0), 31);
          const size_t ix = (size_t)((first + cc) * 2 + dir) * 512 + ch;
          A_[s] = p.Atot[ix]; H_[s] = p.Htot[ix];
        }
#pragma unroll
        for (int s = 0; s < 31; ++s) if (s < nprev) carry = A_[s] * carry + H_[s];
      }
      scar[tid] = carry;
    }
    __syncthreads();
    {
      const int c8 = tid & 15, ch0 = quarter * 128 + c8 * 8;
      float cf[8], cb[8];
#pragma unroll
      for (int e = 0; e < 8; ++e) { cf[e] = scar[c8 * 8 + e]; cb[e] = scar[128 + c8 * 8 + e]; }
#pragma unroll 2
      for (int i = 0; i < 4; ++i) {
        const int t = cs * 64 + (tid >> 4) + i * 16;
        const u16* pr = p.P + (size_t)t * 8192 + ch0;
        uint4 hf4 = ldnt16(p.hloc + (size_t)t * 512 + ch0), af4 = ldnt16(p.acum + (size_t)t * 512 + ch0);
        uint4 hb4 = ldnt16(p.hloc + ((size_t)8192 + t) * 512 + ch0), ab4 = ldnt16(p.acum + ((size_t)8192 + t) * 512 + ch0);
        uint4 gl4 = *(const uint4*)(pr + 2560);
        float hf[8], af[8], hb[8], ab[8], gl[8], ol[8];
        unpack8(hf4, hf); unpack8(af4, af); unpack8(hb4, hb); unpack8(ab4, ab); unpack8(gl4, gl);
#pragma unroll
        for (int e = 0; e < 8; ++e) {
          float h = (hf[e] + af[e] * cf[e]) + (hb[e] + ab[e] * cb[e]);
          ol[e] = h * silu(gl[e]);
        }
        *(uint4*)(p.Alru + (size_t)t * 512 + ch0) = make_uint4(pack2(ol[0], ol[1]), pack2(ol[2], ol[3]), pack2(ol[4], ol[5]), pack2(ol[6], ol[7]));
      }
    }
    __syncthreads();
  }
  if (l < 3) {
    for (int it = vbid(); it < 512; it += NVB) sw_item<false>(p, l + 1, it, smem, nullptr);
  }
}

__device__ void phaseC1(const Params& p, int l, char* smem, int vid) {
  const int tid = otid512(), lane = tid & 63, wave = tid >> 6;
  const int wm = wave >> 1, wn = wave & 1, fr = lane & 15, fq = lane >> 4;
  for (int id = vid; id < 256; id += gridDim.x) {
    const int xcd = id & 7, j_ = id >> 3;
    const int mt = xcd * 4 + (j_ >> 3), nt = j_ & 7;
    const int m0 = mt * 256, n0 = nt * 128;
    f32x4 tot[4][4];
    zero_acc<4, 4>(tot);
    gemm4_prologue<4, 4, 4, 2, false, true>(p.Ana + (size_t)m0 * 512, 512, p.wt_br + (size_t)(l * 3) * 1024 * 512 + (size_t)n0 * 512, 512, smem);
#pragma unroll 1
    for (int br = 0; br < 3; ++br) {
      f32x4 acc[4][4];
      zero_acc<4, 4>(acc);
      const u16* A = p.Ana + (size_t)br * 8192 * 512 + (size_t)m0 * 512;
      const u16* B = p.wt_br + (size_t)(l * 3 + br) * 1024 * 512 + (size_t)n0 * 512;
      uint4 gpre[4][2];
#pragma unroll
      for (int i = 0; i < 4; ++i) {
        const int t = m0 + wm * 64 + i * 16 + fr;
        const int col = n0 + wn * 64 + fq * 16;
        const u16* gp = p.P + (size_t)t * 8192 + 5120 + br * 1024 + col;
        gpre[i][0] = ldnt16(gp); gpre[i][1] = ldnt16(gp + 8);
      }
      __builtin_amdgcn_sched_barrier(0);
      gemm_mainloop<4, 4, 4, 2, true, false, true, true>(A, 512, B, 512, 512, acc, smem);
      if (br < 2)
        gemm4_prologue<4, 4, 4, 2, false, true>(A + (size_t)8192 * 512, 512, B + (size_t)1024 * 512, 512, smem);
#pragma unroll
      for (int i = 0; i < 4; ++i) {
        const uint4 g0 = gpre[i][0], g1 = gpre[i][1];
        tot[i][0][0] += sigm(lo16(g0.x)) * acc[i][0][0]; tot[i][0][1] += sigm(hi16(g0.x)) * acc[i][0][1];
        tot[i][0][2] += sigm(lo16(g0.y)) * acc[i][0][2]; tot[i][0][3] += sigm(hi16(g0.y)) * acc[i][0][3];
        tot[i][1][0] += sigm(lo16(g0.z)) * acc[i][1][0]; tot[i][1][1] += sigm(hi16(g0.z)) * acc[i][1][1];
        tot[i][1][2] += sigm(lo16(g0.w)) * acc[i][1][2]; tot[i][1][3] += sigm(hi16(g0.w)) * acc[i][1][3];
        tot[i][2][0] += sigm(lo16(g1.x)) * acc[i][2][0]; tot[i][2][1] += sigm(hi16(g1.x)) * acc[i][2][1];
        tot[i][2][2] += sigm(lo16(g1.y)) * acc[i][2][2]; tot[i][2][3] += sigm(hi16(g1.y)) * acc[i][2][3];
        tot[i][3][0] += sigm(lo16(g1.z)) * acc[i][3][0]; tot[i][3][1] += sigm(hi16(g1.z)) * acc[i][3][1];
        tot[i][3][2] += sigm(lo16(g1.w)) * acc[i][3][2]; tot[i][3][3] += sigm(hi16(g1.w)) * acc[i][3][3];
      }
    }
#pragma unroll
    for (int i = 0; i < 4; ++i) {
      const int t = m0 + wm * 64 + i * 16 + fr;
      const int col = n0 + wn * 64 + fq * 16;
      uint4 w0 = make_uint4(pack2(tot[i][0][0], tot[i][0][1]), pack2(tot[i][0][2], tot[i][0][3]),
                            pack2(tot[i][1][0], tot[i][1][1]), pack2(tot[i][1][2], tot[i][1][3]));
      uint4 w1 = make_uint4(pack2(tot[i][2][0], tot[i][2][1]), pack2(tot[i][2][2], tot[i][2][3]),
                            pack2(tot[i][3][0], tot[i][3][1]), pack2(tot[i][3][2], tot[i][3][3]));
      *(uint4*)(p.merged + (size_t)t * 1024 + col) = w0;
      *(uint4*)(p.merged + (size_t)t * 1024 + col + 8) = w1;
    }
  }
}

__device__ void phaseC2(const Params& p, int l, char* smem, int vid) {
  const int tid = otid512(), lane = tid & 63, wave = tid >> 6;
  const int wm = wave >> 1, wn = wave & 1, fr = lane & 15, fq = lane >> 4;
  for (int id = vid; id < 256; id += gridDim.x) {
    const int xcd = id & 7, j_ = id >> 3;
    const int mt = xcd * 4 + (j_ >> 3), nt = j_ & 7;
    const int m0 = mt * 256, n0 = nt * 128;
    f32x4 acc[4][4];
    zero_acc<4, 4>(acc);
    const int cid = m0 < 4096 ? 0 : 1 + ((m0 - 4096) >> 11);
    const int col = n0 + wn * 64 + fq * 16;
    float4 gpre[4], xpre[4][4];
    {
      const float* gt = p.mod + (size_t)(l * 3 + cid) * 3072 + 2048 + col;
#pragma unroll
      for (int j = 0; j < 4; ++j) gpre[j] = *(const float4*)(gt + j * 4);
#pragma unroll
      for (int i = 0; i < 4; ++i) {
        const float* xr = xrow(p, l, m0 + wm * 64 + i * 16 + fr) + col;
#pragma unroll
        for (int j = 0; j < 4; ++j) xpre[i][j] = *(const float4*)(xr + j * 4);
      }
    }
    __builtin_amdgcn_sched_barrier(0);
    gemm_mainloop<4, 4, 4, 2, true, false, true>(p.merged + (size_t)m0 * 1024, 1024,
                                                 p.wt_out + (size_t)l * 1024 * 1024 + (size_t)n0 * 1024, 1024, 1024, acc, smem);
#pragma unroll
    for (int i = 0; i < 4; ++i) {
      float* xr = p.xbuf + (size_t)(m0 + wm * 64 + i * 16 + fr) * 1024 + col;
#pragma unroll
      for (int j = 0; j < 4; ++j) {
        const float4 g4 = gpre[j], xo = xpre[i][j];
        const float4 xn = make_float4(xo.x + g4.x * acc[i][j][0], xo.y + g4.y * acc[i][j][1],
                                      xo.z + g4.z * acc[i][j][2], xo.w + g4.w * acc[i][j][3]);
        *(float4*)(xr + j * 4) = xn;
        acc[i][j] = f32x4{xn.x, xn.y, xn.z, xn.w};
      }
    }
    if (l < 3) {
      const float* gn = p.norm_g + (l + 1) * 1024 + col;
      const float* scn = p.mod + (size_t)((l + 1) * 3 + cid) * 3072 + 1024 + col;
      float gs[16];
#pragma unroll
      for (int j = 0; j < 4; ++j) {
        const float4 g_ = *(const float4*)(gn + j * 4), s_ = *(const float4*)(scn + j * 4);
        gs[j * 4 + 0] = g_.x * (1.f + s_.x); gs[j * 4 + 1] = g_.y * (1.f + s_.y);
        gs[j * 4 + 2] = g_.z * (1.f + s_.z); gs[j * 4 + 3] = g_.w * (1.f + s_.w);
      }
#pragma unroll
      for (int i = 0; i < 4; ++i) {
        const int t = m0 + wm * 64 + i * 16 + fr;
        float ss = 0.f;
#pragma unroll
        for (int j = 0; j < 4; ++j)
#pragma unroll
          for (int e = 0; e < 4; ++e) ss += acc[i][j][e] * acc[i][j][e];
        ss += __shfl_xor(ss, 16);
        ss += __shfl_xor(ss, 32);
        if (fq == 0) atomicAdd(p.rowss + (size_t)(l + 1) * 8192 + t, ss);
        uint4 w0 = make_uint4(pack2(acc[i][0][0] * gs[0], acc[i][0][1] * gs[1]), pack2(acc[i][0][2] * gs[2], acc[i][0][3] * gs[3]),
                              pack2(acc[i][1][0] * gs[4], acc[i][1][1] * gs[5]), pack2(acc[i][1][2] * gs[6], acc[i][1][3] * gs[7]));
        uint4 w1 = make_uint4(pack2(acc[i][2][0] * gs[8], acc[i][2][1] * gs[9]), pack2(acc[i][2][2] * gs[10], acc[i][2][3] * gs[11]),
                              pack2(acc[i][3][0] * gs[12], acc[i][3][1] * gs[13]), pack2(acc[i][3][2] * gs[14], acc[i][3][3] * gs[15]));
        *(uint4*)(p.xm + blk1024(t, col)) = w0;
        *(uint4*)(p.xm + blk1024(t, col + 8)) = w1;
      }
    }
  }
}

#define XB_TMO      128
#define XB_XCNT(j)  (256  + 64 * (j))
#define XB_XSUB(j)  (1280 + 64 * (j))
#define XB_XGEN(j)  (2304 + 64 * (j))
#define XB_TOP      3328
#define XB_TOPGEN   3392
#define XCD_BAR_WORDS 3456
#define XB_SPIN_CAP (1u << 18)
#define LAS __attribute__((address_space(3)))
__device__ __forceinline__ unsigned xb_ld(unsigned* p) { return __hip_atomic_load(p, __ATOMIC_RELAXED, __HIP_MEMORY_SCOPE_AGENT); }
__device__ __forceinline__ unsigned xb_add(unsigned* p, unsigned v) { return __hip_atomic_fetch_add(p, v, __ATOMIC_RELAXED, __HIP_MEMORY_SCOPE_AGENT); }
__device__ __forceinline__ unsigned xb_xcc_id() { return (unsigned)__builtin_amdgcn_s_getreg((3 << 11) | 20) & 0xFu; }
#define XB_SPIN(cond, bar) do { unsigned _sp = 0; while (cond) { __builtin_amdgcn_s_sleep(1); \
    if ((++_sp & 255u) == 0u) { if (xb_ld(&(bar)[XB_TMO])) break; if (_sp > XB_SPIN_CAP) { atomicAdd(&(bar)[XB_TMO], 1u); break; } } } } while (0)
struct XcdBarrier { unsigned* bar; unsigned x; unsigned rank; volatile LAS unsigned* st; };
__device__ __forceinline__ XcdBarrier xcd_barrier_post(unsigned* bar, volatile LAS unsigned* st) {
  XcdBarrier b; b.bar = bar; b.x = xb_xcc_id(); b.st = st; b.rank = 0u;
  if (threadIdx.x == 0) b.rank = xb_add(&bar[XB_XCNT(b.x)], 1u);
  return b;
}
__device__ __forceinline__ void xcd_barrier_complete(unsigned* bar, unsigned x, unsigned& nloc, unsigned& nx) {
  const unsigned G = gridDim.x * gridDim.y * gridDim.z;
  unsigned sum, cnt, mine, sp = 0u;
  for (;;) {
    sum = 0u; cnt = 0u; mine = 0u;
#pragma unroll
    for (unsigned j = 0; j < 16; ++j) { const unsigned c = xb_ld(&bar[XB_XCNT(j)]); sum += c; cnt += (c > 0u) ? 1u : 0u; mine = (j == x) ? c : mine; }
    if (sum == G) break;
    __builtin_amdgcn_s_sleep(1);
    if ((++sp & 255u) == 0u) { if (xb_ld(&bar[XB_TMO])) break; if (sp > XB_SPIN_CAP) { atomicAdd(&bar[XB_TMO], 1u); break; } }
  }
  nloc = mine > 0u ? mine : 1u; nx = cnt > 0u ? cnt : 1u;
}
__device__ __forceinline__ void xcd_barrier(const XcdBarrier& b) {
  asm volatile("s_waitcnt vmcnt(0)" ::: "memory");
  __syncthreads();
  if (threadIdx.x == 0) {
    unsigned* bar = b.bar;
    __builtin_amdgcn_s_waitcnt(0);
    unsigned nloc = b.st[0], nx = b.st[1];
    if (nloc == 0u) { xcd_barrier_complete(bar, b.x, nloc, nx); b.st[0] = nloc; b.st[1] = nx; }
    const unsigned old = xb_add(&bar[XB_XSUB(b.x)], 1u);
    const unsigned gen = old / nloc;
    if (old + 1u == (gen + 1u) * nloc) {
      __builtin_amdgcn_fence(__ATOMIC_RELEASE, "agent");
      asm volatile("s_waitcnt vmcnt(0)" ::: "memory");
      const unsigned og = xb_add(&bar[XB_TOP], 1u);
      const unsigned tg = og / nx;
      if (og + 1u == (tg + 1u) * nx) xb_add(&bar[XB_TOPGEN], 1u);
      else XB_SPIN(xb_ld(&bar[XB_TOPGEN]) == tg, bar);
      __builtin_amdgcn_fence(__ATOMIC_ACQUIRE, "agent");
      xb_add(&bar[XB_XGEN(b.x)], 1u);
      asm volatile("s_waitcnt vmcnt(0)" ::: "memory");
    } else {
      XB_SPIN(xb_ld(&bar[XB_XGEN(b.x)]) == gen, bar);
      __builtin_amdgcn_fence(__ATOMIC_ACQUIRE, "agent");
      asm volatile("s_waitcnt vmcnt(0)" ::: "memory");
    }
  }
  __syncthreads();
}

__global__ void __launch_bounds__(NTHREADS) mega(Params p_arg) {
  const Params& p = *(const Params*)__builtin_amdgcn_kernarg_segment_ptr();
  extern __shared__ __attribute__((aligned(16))) char dsm[];
  char* smem = dsm;
  char* hsm = dsm + __builtin_amdgcn_readfirstlane((int)(threadIdx.x >> 8)) * 65536;
  cg::grid_group grid = cg::this_grid();
  if (threadIdx.x < 16) ((unsigned*)(dsm + SMEM_BYTES))[threadIdx.x] = 0u;
  __syncthreads();
  VbBar vbb;
  vbb.cnt = (unsigned*)(dsm + SMEM_BYTES + 16 + __builtin_amdgcn_readfirstlane((int)(threadIdx.x >> 8)) * 16);
  vbb.target = 0u;
  XcdBarrier xb = xcd_barrier_post(p.bar, (volatile LAS unsigned*)(dsm + SMEM_BYTES));
  const int lo = p.phase_lo, hi = p.phase_hi;
  if (hi > 1000) grid.sync();
#define GRID_SYNC() xcd_barrier(xb)
#define RUN_PHASE(PH, CALL) { const int ph_ = (PH); if (ph_ >= lo && ph_ < hi) { CALL; if (ph_ + 1 < hi) GRID_SYNC(); } }
  RUN_PHASE(0, phase0(p, hsm));
  int vid = blockIdx.x;
  {
    unsigned* st2 = (unsigned*)(dsm + SMEM_BYTES + 48);
    if (threadIdx.x == 0) {
      bool ok = (gridDim.x & 7) == 0 && xb.x < 8u;
      for (int j = 0; j < 8; ++j) ok = ok && (xb_ld(&p.bar[XB_XCNT(j)]) == gridDim.x / 8);
      ok = ok && xb.rank < gridDim.x / 8;
      st2[0] = ok ? (xb.x + 8u * xb.rank) : blockIdx.x;
    }
    __syncthreads();
    vid = __builtin_amdgcn_readfirstlane((int)st2[0]);
  }
#pragma unroll 1
  for (int l = 0; l < 4; ++l) {
    if (l == 0) RUN_PHASE(1, phaseN0(p, hsm));
    RUN_PHASE(2 + l * 6, phaseA(p, l, smem, vid));
    RUN_PHASE(3 + l * 6, phaseB(p, l, hsm, vbb));

    RUN_PHASE(4 + l * 6, phaseB2(p, l, hsm));
    RUN_PHASE(5 + l * 6, phaseC1(p, l, smem, vid));
    RUN_PHASE(6 + l * 6, phaseC2(p, l, smem, vid));
  }
  RUN_PHASE(25, phaseF(p));
}

extern "C" void kernel_launch(void* const* d_in, const int* in_sizes, int n_in, void* d_out, int out_size, void* d_ws,
                              size_t ws_size, hipStream_t stream) {
  static int grid_blocks = 0;
  if (!grid_blocks) {
    int dev = 0, cus = 0, per_cu = 0;
    hipGetDevice(&dev);
    hipDeviceGetAttribute(&cus, hipDeviceAttributeMultiprocessorCount, dev);
    hipFuncSetAttribute((const void*)mega, hipFuncAttributeMaxDynamicSharedMemorySize, DYN_LDS);
    hipOccupancyMaxActiveBlocksPerMultiprocessor(&per_cu, mega, NTHREADS, DYN_LDS);
    if (per_cu > 1) per_cu = 1;
    if (per_cu < 1) per_cu = 1;
    grid_blocks = cus * per_cu;
  }
  Params p;
  memset(&p, 0, sizeof(p));
  const float** fp = (const float**)&p;
  for (int i = 0; i < 25; ++i) fp[i] = (const float*)d_in[i];
  p.out = (float*)d_out;
  char* w = (char*)d_ws;
  size_t off = 0;
  auto take = [&](size_t bytes) { char* r = w + off; off += (bytes + 255) & ~(size_t)255; return r; };
  p.wt_in = (u16*)take((size_t)4 * 8192 * 1024 * 2);
  p.wt_br = (u16*)take((size_t)4 * 3 * 1024 * 512 * 2);
  p.wt_out = (u16*)take((size_t)4 * 1024 * 1024 * 2);
  p.wgT = (u16*)take((size_t)128 * 4096 * 2);
  p.ckb = (u16*)take((size_t)2 * 4 * 256 * 512 * 2);
  p.cvT = (u16*)take((size_t)2 * 4 * 256 * 512 * 2);
  p.xm = (u16*)take((size_t)8192 * 1024 * 2);
  p.P = (u16*)take((size_t)8192 * 8192 * 2);
  p.Vt = (u16*)take((size_t)512 * 8192 * 2);
  p.Ana = (u16*)take((size_t)8192 * 512 * 2);
  p.Alru = (u16*)take((size_t)8192 * 512 * 2);
  p.Aconv = (u16*)take((size_t)8192 * 512 * 2);
  p.merged = (u16*)take((size_t)8192 * 1024 * 2);
  p.hloc = (u16*)take((size_t)2 * 8192 * 512 * 2);
  p.acum = (u16*)take((size_t)2 * 8192 * 512 * 2);
  p.mod = (float*)take((size_t)4 * 3 * 3072 * 4);
  p.xbuf = (float*)take((size_t)8192 * 1024 * 4);
  p.Atot = (float*)take((size_t)128 * 2 * 512 * 4);
  p.Htot = (float*)take((size_t)128 * 2 * 512 * 4);
  p.sp8 = (float*)take((size_t)4096 * 4);
  p.rowss = (float*)take((size_t)4 * 8192 * 4);
  p.sW = (float*)take((size_t)4 * 3 * 8192 * 4);
  p.bar = (unsigned*)take((size_t)XCD_BAR_WORDS * 4);
  if (off > ws_size) { fprintf(stderr, "workspace too small: need %zu have %zu\n", off, ws_size); return; }
#ifdef MULTI_LAUNCH
  for (int ph = 0; ph < 26; ++ph) {
    p.phase_lo = ph; p.phase_hi = ph + 1;
    hipLaunchKernelGGL(mega, dim3(grid_blocks), dim3(NTHREADS), DYN_LDS, stream, p);
  }
#else
  p.phase_lo = 0; p.phase_hi = 26;
  hipMemsetAsync(p.bar, 0, (size_t)XCD_BAR_WORDS * 4, stream);
  void* args[] = {&p};
  hipError_t e = hipLaunchCooperativeKernel((void*)mega, dim3(grid_blocks), dim3(NTHREADS), args, DYN_LDS, stream);
  if (e != hipSuccess) fprintf(stderr, "cooperative launch failed: %s (grid %d)\n", hipGetErrorString(e), grid_blocks);
#endif
}
```

```cpp
#include <hip/hip_runtime.h>
#include <hip/hip_cooperative_groups.h>
#include <cstdio>
#include <cstring>
namespace cg = cooperative_groups;

typedef unsigned short u16;
using bf16x8 = __attribute__((ext_vector_type(8))) short;
using f32x4 = __attribute__((ext_vector_type(4))) float;
using u32x4 = __attribute__((ext_vector_type(4))) unsigned;

#define NTHREADS 512
#define SMEM_BYTES 131072
#define DYN_LDS (SMEM_BYTES + 64)

struct Params {
  const float *x_prompt, *x_sample, *cache_k, *cache_v, *state_lru, *c, *c_ctx, *norm_g, *w_mod, *b_mod,
      *w_in, *na_rpb, *lru_conv_w, *lru_conv_b, *lru_wa, *lru_ba, *lru_wx, *lru_bx, *lru_lam, *conv_w,
      *w_br_na, *w_br_lru, *w_br_conv, *w_out, *final_g;
  float* out;
  u16 *wt_in, *wt_br, *wt_out, *wgT, *ckb, *cvT, *xm, *P, *Vt, *Ana, *Alru, *Aconv, *merged, *hloc, *acum;
  float *mod, *xbuf, *Atot, *Htot, *sp8, *rowss, *sW;
  unsigned* bar;
  int phase_lo, phase_hi;
};

__device__ __forceinline__ int otid() { int t = threadIdx.x & 255; asm volatile("" : "+v"(t)); return t; }
__device__ __forceinline__ int otid512() { int t = threadIdx.x; asm volatile("" : "+v"(t)); return t; }
__device__ __forceinline__ int vbid() { return blockIdx.x * 2 + __builtin_amdgcn_readfirstlane((int)(threadIdx.x >> 8)); }
#define NVB ((int)gridDim.x * 2)
__device__ __forceinline__ unsigned f2bf(float f) {
  unsigned r;
  asm("v_cvt_pk_bf16_f32 %0, %1, %1" : "=v"(r) : "v"(f));
  return r & 0xffffu;
}
__device__ __forceinline__ float bf2f(unsigned h) { return __uint_as_float(h << 16); }
__device__ __forceinline__ unsigned pack2(float a, float b) {
  unsigned r;
  asm("v_cvt_pk_bf16_f32 %0, %1, %2" : "=v"(r) : "v"(a), "v"(b));
  return r;
}
__device__ __forceinline__ float sigm(float x) { return __builtin_amdgcn_rcpf(1.f + __expf(-x)); }
__device__ __forceinline__ float silu(float x) { return x * __builtin_amdgcn_rcpf(1.f + __expf(-x)); }
__device__ __forceinline__ float lo16(unsigned w) { return __uint_as_float(w << 16); }
__device__ __forceinline__ float hi16(unsigned w) { return __uint_as_float(w & 0xffff0000u); }

__device__ __forceinline__ size_t blk1024(int row, int k) {
  return ((size_t)(row >> 8) * 16 + (k >> 6)) * 16384 + (size_t)(row & 255) * 64 + (k & 63);
}
struct VbBar;
template <bool VB> __device__ __forceinline__ void item_barrier(VbBar* vb);
template <bool VB>
__device__ void transpose_unit(const float* __restrict__ src, int N, u16* __restrict__ dst, int K, int k0, int n0,
                               float* sm, VbBar* vb, bool blocked = false) {
  const int tid = otid();
  float4 v[8];
#pragma unroll
  for (int i = 0; i < 4; ++i) {
    const int r = (tid >> 4) + i * 16, c4 = (tid & 15) * 4;
    { const f32x4 t_ = __builtin_nontemporal_load((const f32x4*)(src + (size_t)(k0 + r) * N + n0 + c4)); v[i] = make_float4(t_[0], t_[1], t_[2], t_[3]); }
    { const f32x4 t_ = __builtin_nontemporal_load((const f32x4*)(src + (size_t)(k0 + r) * N + n0 + 64 + c4)); v[4 + i] = make_float4(t_[0], t_[1], t_[2], t_[3]); }
  }
#pragma unroll
  for (int i = 0; i < 4; ++i) {
    const int r = (tid >> 4) + i * 16, c4 = (tid & 15) * 4;
    float* s0 = sm + r * 65 + c4;
    float* s1 = sm + 4160 + r * 65 + c4;
    s0[0] = v[i].x; s0[1] = v[i].y; s0[2] = v[i].z; s0[3] = v[i].w;
    s1[0] = v[4 + i].x; s1[1] = v[4 + i].y; s1[2] = v[4 + i].z; s1[3] = v[4 + i].w;
  }
  item_barrier<VB>(vb);
  const int n = tid >> 2, kq = (tid & 3) * 16;
#pragma unroll
  for (int h = 0; h < 2; ++h) {
    const float* sh = sm + h * 4160;
    unsigned w[8];
#pragma unroll
    for (int kk = 0; kk < 8; ++kk) w[kk] = pack2(sh[(kq + 2 * kk) * 65 + n], sh[(kq + 2 * kk + 1) * 65 + n]);
    const int nn = n0 + h * 64 + n;
    uint4* d = (uint4*)(blocked ? dst + blk1024(nn, k0 + kq) : dst + (size_t)nn * K + k0 + kq);
    d[0] = make_uint4(w[0], w[1], w[2], w[3]);
    d[1] = make_uint4(w[4], w[5], w[6], w[7]);
  }
  item_barrier<VB>(vb);
}

template <bool VB>
__device__ void weight_unit(const Params& p, int l, int idx, float* sm, VbBar* vb) {
  if (idx < 1024) {
    const int kt = idx >> 6, nt = (idx & 63) * 2;
    transpose_unit<VB>(p.w_in + (size_t)l * 1024 * 8192, 8192, p.wt_in + (size_t)l * 8192 * 1024, 1024, kt * 64, nt * 64, sm, vb, true);
  } else if (idx < 1216) {
    const int r = idx - 1024, br = r >> 6, q = r & 63, kt = q >> 3, nt = (q & 7) * 2;
    u16* dst = p.wt_br + (size_t)(l * 3 + br) * 1024 * 512;
    if (br == 0) transpose_unit<VB>(p.w_br_na + (size_t)l * 512 * 1024, 1024, dst, 512, kt * 64, nt * 64, sm, vb);
    else if (br == 1) transpose_unit<VB>(p.w_br_lru + (size_t)l * 512 * 1024, 1024, dst, 512, kt * 64, nt * 64, sm, vb);
    else transpose_unit<VB>(p.w_br_conv + (size_t)l * 512 * 1024, 1024, dst, 512, kt * 64, nt * 64, sm, vb);
  } else {
    const int r = idx - 1216, kt = r >> 3, nt = (r & 7) * 2;
    transpose_unit<VB>(p.w_out + (size_t)l * 1024 * 1024, 1024, p.wt_out + (size_t)l * 1024 * 1024, 1024, kt * 64, nt * 64, sm, vb);
  }
}

__device__ void phase0(const Params& p, char* smem) {
  float* sm = (float*)smem;
  const int tid = otid();
  const int NU = 384 + 1344 + 512 + 512 + 128;
  for (int u = vbid(); u < NU; u += NVB) {
    int v = u;
    if (v < 384) {
      int l = v / 96, cgp = v % 96;
      int c = cgp * 32 + (tid & 31), kg = tid >> 5;
      for (int k = tid; k < 1024; k += 256) {
        sm[k] = silu(p.c_ctx[k]); sm[1024 + k] = silu(p.c[k]); sm[2048 + k] = silu(p.c[1024 + k]);
      }
      __syncthreads();
      float a0 = 0.f, a1 = 0.f, a2 = 0.f;
      const float* w = p.w_mod + (size_t)l * 1024 * 3072 + c;
#pragma unroll 1
      for (int kb = kg * 128; kb < kg * 128 + 128; kb += 16) {
        float wv[16];
#pragma unroll
        for (int j = 0; j < 16; ++j) wv[j] = __builtin_nontemporal_load(w + (size_t)(kb + j) * 3072);
#pragma unroll
        for (int j = 0; j < 16; ++j) { a0 += sm[kb + j] * wv[j]; a1 += sm[1024 + kb + j] * wv[j]; a2 += sm[2048 + kb + j] * wv[j]; }
      }
      __syncthreads();
      sm[(kg * 3 + 0) * 32 + (tid & 31)] = a0;
      sm[(kg * 3 + 1) * 32 + (tid & 31)] = a1;
      sm[(kg * 3 + 2) * 32 + (tid & 31)] = a2;
      __syncthreads();
      if (tid < 96) {
        int cond = tid >> 5, cc = tid & 31;
        float s = p.b_mod[l * 3072 + cgp * 32 + cc];
#pragma unroll
        for (int g = 0; g < 8; ++g) s += sm[(g * 3 + cond) * 32 + cc];
        p.mod[(size_t)(l * 3 + cond) * 3072 + cgp * 32 + cc] = s;
      }
      __syncthreads();
      continue;
    }
    v -= 384;
    if (v < 1344) { weight_unit<false>(p, 0, v, sm, nullptr); continue; }
    v -= 1344;
    if (v < 512) {
      size_t idx = ((size_t)v * 256 + tid) * 8;
      float4 a = *(const float4*)(p.cache_k + idx), b = *(const float4*)(p.cache_k + idx + 4);
      *(uint4*)(p.ckb + idx) = make_uint4(pack2(a.x, a.y), pack2(a.z, a.w), pack2(b.x, b.y), pack2(b.z, b.w));
      continue;
    }
    v -= 512;
    if (v < 512) {
      int g = v * 256 + tid;
      int d = g & 63, h = (g >> 6) & 7, kg = (g >> 9) & 31, bl = g >> 14;
      float f[8];
#pragma unroll
      for (int j = 0; j < 8; ++j) f[j] = p.cache_v[((size_t)(bl * 256 + kg * 8 + j) * 8 + h) * 64 + d];
      *(uint4*)(p.cvT + ((size_t)(bl * 8 + h) * 64 + d) * 256 + kg * 8) =
          make_uint4(pack2(f[0], f[1]), pack2(f[2], f[3]), pack2(f[4], f[5]), pack2(f[6], f[7]));
      continue;
    }
    v -= 512;
    {
      int blk = v & 7, gate = (v >> 3) & 1, dir = (v >> 4) & 1, l = v >> 5;
      if (tid < 192) p.rowss[8192 + v * 192 + tid] = 0.f;
      if (tid < 32) {
        const int i = v * 32 + tid;
        p.sp8[i] = 8.f * log1pf(expf(-p.lru_lam[i]));
      }
      const size_t so = (size_t)((l * 2 + dir) * 8 + blk) * 4096;
      u16* dst = p.wgT + (size_t)v * 4096;
      for (int idx = tid; idx < 4096; idx += 256) {
        int k = idx >> 6, j = idx & 63;
        float wv;
        if (gate) wv = p.lru_wx[so + j * 64 + k]; else wv = p.lru_wa[so + j * 64 + k];
        dst[idx] = (u16)f2bf(wv);
      }
    }
  }
}

__device__ __forceinline__ const float* xrow(const Params& p, int l, int t) {
  if (l == 0) {
    const float* a = p.x_prompt;
    const float* b = p.x_sample;
    asm volatile("" : "+s"(a));
    asm volatile("" : "+s"(b));
    return t < 4096 ? a + (size_t)t * 1024 : b + (size_t)(t - 4096) * 1024;
  }
  return p.xbuf + (size_t)t * 1024;
}
__device__ __forceinline__ float xrow16_max(float x) {
  auto s = __builtin_amdgcn_permlane16_swap(__float_as_uint(x), __float_as_uint(x), false, false);
  x = fmaxf(__uint_as_float(s[0]), __uint_as_float(s[1]));
  auto t = __builtin_amdgcn_permlane32_swap(__float_as_uint(x), __float_as_uint(x), false, false);
  return fmaxf(__uint_as_float(t[0]), __uint_as_float(t[1]));
}
__device__ __forceinline__ uint4 ldnt16(const u16* ptr) {
  const u32x4 t = __builtin_nontemporal_load((const u32x4*)ptr);
  return make_uint4(t[0], t[1], t[2], t[3]);
}
__device__ __forceinline__ void stnt4(float* ptr, float a, float b, float c, float d) {
  __builtin_nontemporal_store(f32x4{a, b, c, d}, (f32x4*)ptr);
}
__device__ __forceinline__ float wave_sum(float v) {
#pragma unroll
  for (int o = 32; o >= 1; o >>= 1) v += __shfl_xor(v, o);
  return v;
}

template <bool VB>
__device__ void sw_item(const Params& p, int l, int ng, char* smem, VbBar* vb) {
  const int tid = otid();
  float* sm = (float*)smem;
  const int n = ng * 16 + (tid & 15), kp = tid >> 4;
  for (int i = tid; i < 3072; i += 256) sm[i] = p.mod[(size_t)(l * 3 + (i >> 10)) * 3072 + (i & 1023)];
  item_barrier<VB>(vb);
  const u16* wp = p.wt_in + (size_t)l * 8192 * 1024 + blk1024(n, kp * 64);
  float a0 = 0.f, a1 = 0.f, a2 = 0.f;
#pragma unroll
  for (int j = 0; j < 8; ++j) {
    const uint4 wv = *(const uint4*)(wp + j * 8);
    float w[8];
    w[0] = lo16(wv.x); w[1] = hi16(wv.x); w[2] = lo16(wv.y); w[3] = hi16(wv.y);
    w[4] = lo16(wv.z); w[5] = hi16(wv.z); w[6] = lo16(wv.w); w[7] = hi16(wv.w);
#pragma unroll
    for (int e = 0; e < 8; ++e) {
      const int k = kp * 64 + j * 8 + e;
      a0 += sm[k] * w[e]; a1 += sm[1024 + k] * w[e]; a2 += sm[2048 + k] * w[e];
    }
  }
  item_barrier<VB>(vb);
  sm[(kp * 3 + 0) * 16 + (tid & 15)] = a0;
  sm[(kp * 3 + 1) * 16 + (tid & 15)] = a1;
  sm[(kp * 3 + 2) * 16 + (tid & 15)] = a2;
  item_barrier<VB>(vb);
  if (tid < 48) {
    const int cond = tid >> 4, nl = tid & 15;
    float s = 0.f;
#pragma unroll
    for (int q = 0; q < 16; ++q) s += sm[(q * 3 + cond) * 16 + nl];
    p.sW[(size_t)(l * 3 + cond) * 8192 + ng * 16 + nl] = s;
  }
  item_barrier<VB>(vb);
}

__device__ void phaseN0(const Params& p, char* smem) {
  const int tid = otid(), lane = tid & 63, wave = tid >> 6;
  const float* g = p.norm_g;
  for (int t = vbid() * 4 + wave; t < 8192; t += NVB * 4) {
    const float* x = xrow(p, 0, t);
    float4 v[4];
    float ss = 0.f;
#pragma unroll
    for (int i = 0; i < 4; ++i) {
      v[i] = *(const float4*)(x + i * 256 + lane * 4);
      ss += v[i].x * v[i].x + v[i].y * v[i].y + v[i].z * v[i].z + v[i].w * v[i].w;
    }
    ss = wave_sum(ss);
    if (lane == 0) p.rowss[t] = ss;
    const int cid = t < 4096 ? 0 : 1 + ((t - 4096) >> 11);
    const float* md = p.mod + (size_t)cid * 3072;
#pragma unroll
    for (int i = 0; i < 4; ++i) {
      const int c = i * 256 + lane * 4;
      const float4 gg = *(const float4*)(g + c), sc = *(const float4*)(md + 1024 + c);
      *(uint2*)(p.xm + blk1024(t, c)) = make_uint2(pack2(v[i].x * gg.x * (1.f + sc.x), v[i].y * gg.y * (1.f + sc.y)),
                                                   pack2(v[i].z * gg.z * (1.f + sc.z), v[i].w * gg.w * (1.f + sc.w)));
    }
  }
  for (int it = vbid(); it < 512; it += NVB) sw_item<false>(p, 0, it, smem, nullptr);
}

__device__ void phaseF(const Params& p) {
  const int lane = otid() & 63, wave = otid() >> 6;
  for (int t = vbid() * 4 + wave; t < 8192; t += NVB * 4) {
    const float* x = p.xbuf + (size_t)t * 1024;
    float4 v[4];
    float ss = 0.f;
#pragma unroll
    for (int i = 0; i < 4; ++i) {
      v[i] = *(const float4*)(x + i * 256 + lane * 4);
      ss += v[i].x * v[i].x + v[i].y * v[i].y + v[i].z * v[i].z + v[i].w * v[i].w;
    }
    ss = wave_sum(ss);
    float rstd = rsqrtf(ss * (1.f / 1024.f) + 1e-6f);
#pragma unroll
    for (int i = 0; i < 4; ++i) {
      int c = i * 256 + lane * 4;
      float4 gg = *(const float4*)(p.final_g + c);
      stnt4(p.out + (size_t)t * 1024 + c, v[i].x * rstd * gg.x, v[i].y * rstd * gg.y, v[i].z * rstd * gg.z, v[i].w * rstd * gg.w);
    }
  }
}

__device__ __forceinline__ int perm64(int r) { return (r & 0x43) | ((r & 0x30) >> 2) | ((r & 0x0c) << 2); }

template <int MI, int NJ, int WM, int WN, bool PERM_A, bool PERM_B>
__device__ __forceinline__ void gemm64_prologue(const u16* __restrict__ A, int lda, const u16* __restrict__ B, int ldb, char* smem) {
  constexpr int AR = WM * MI * 16, BR = WN * NJ * 16;
  constexpr int A_BYTES = AR * 128;
  const int tid = otid512();
  const int lr = tid >> 3, lc = (tid & 7) ^ ((lr >> 1) & 7);
  const u16* ag = A + (size_t)(PERM_A ? perm64(lr) : lr) * lda + lc * 8;
  const u16* bg = B + (size_t)(PERM_B ? perm64(lr) : lr) * ldb + lc * 8;
  char* sA = smem + tid * 16;
  char* sB = smem + A_BYTES + tid * 16;
#pragma unroll
  for (int i = 0; i < AR / 64; ++i) __builtin_amdgcn_global_load_lds((const unsigned*)(ag + (size_t)i * 64 * lda), (unsigned*)(sA + i * 8192), 16, 0, 0);
#pragma unroll
  for (int i = 0; i < BR / 64; ++i) __builtin_amdgcn_global_load_lds((const unsigned*)(bg + (size_t)i * 64 * ldb), (unsigned*)(sB + i * 8192), 16, 0, 0);
}

template <int MI, int NJ, int WM, int WN, bool SWAP, bool PERM_A, bool PERM_B, bool SKIP_PRO = false>
__device__ __forceinline__ void gemm_mainloop64(const u16* __restrict__ A, int lda, const u16* __restrict__ B, int ldb,
                                              int K, f32x4 (&acc)[MI][NJ], char* smem, int kts = 64) {
  constexpr int AR = WM * MI * 16, BR = WN * NJ * 16;
  constexpr int A_BYTES = AR * 128, STAGE = (AR + BR) * 128;
  const int tid = otid512(), lane = tid & 63, wave = tid >> 6;
  const int wm = wave / WN, wn = wave % WN, fr = lane & 15, fq = lane >> 4;
  const int lr = tid >> 3, lc = (tid & 7) ^ ((lr >> 1) & 7);
  const u16* ag = A + (size_t)(PERM_A ? perm64(lr) : lr) * lda + lc * 8;
  const u16* bg = B + (size_t)(PERM_B ? perm64(lr) : lr) * ldb + lc * 8;
  char* sA = smem + tid * 16;
  char* sB = smem + A_BYTES + tid * 16;
#define GLDS(gp, lp) __builtin_amdgcn_global_load_lds((const unsigned*)(gp), (unsigned*)(lp), 16, 0, 0)
  if (!SKIP_PRO) {
#pragma unroll
    for (int i = 0; i < AR / 64; ++i) GLDS(ag + (size_t)i * 64 * lda, sA + i * 8192);
#pragma unroll
    for (int i = 0; i < BR / 64; ++i) GLDS(bg + (size_t)i * 64 * ldb, sB + i * 8192);
  }
  asm volatile("s_waitcnt vmcnt(0)" ::: "memory");
  __syncthreads();
  const int swz_r = (fr >> 1) & 7;
  const int aoff = (wm * MI * 16 + fr) * 128, boff = A_BYTES + (wn * NJ * 16 + fr) * 128;
  const int nk = K >> 6;
  for (int kt = 0; kt < nk; ++kt) {
    const int cur = kt & 1;
    if (kt + 1 < nk) {
#pragma unroll
      for (int i = 0; i < AR / 64; ++i) GLDS(ag + (size_t)i * 64 * lda + (size_t)(kt + 1) * kts, sA + (cur ^ 1) * STAGE + i * 8192);
#pragma unroll
      for (int i = 0; i < BR / 64; ++i) GLDS(bg + (size_t)i * 64 * ldb + (size_t)(kt + 1) * kts, sB + (cur ^ 1) * STAGE + i * 8192);
    }
    __builtin_amdgcn_sched_barrier(0);
    const char* cA = smem + cur * STAGE + aoff;
    const char* cB = smem + cur * STAGE + boff;
    bf16x8 af[2][MI], bfr[2][NJ];
#pragma unroll
    for (int ks = 0; ks < 2; ++ks) {
      const int ch = ((ks * 4 + fq) ^ swz_r) << 4;
#pragma unroll
      for (int j = 0; j < NJ; ++j) bfr[ks][j] = *(const bf16x8*)(cB + j * 2048 + ch);
#pragma unroll
      for (int i = 0; i < MI; ++i) af[ks][i] = *(const bf16x8*)(cA + i * 2048 + ch);
    }
#pragma unroll
    for (int ks = 0; ks < 2; ++ks)
#pragma unroll
      for (int i = 0; i < MI; ++i)
#pragma unroll
        for (int j = 0; j < NJ; ++j) {
          if (SWAP) acc[i][j] = __builtin_amdgcn_mfma_f32_16x16x32_bf16(bfr[ks][j], af[ks][i], acc[i][j], 0, 0, 0);
          else acc[i][j] = __builtin_amdgcn_mfma_f32_16x16x32_bf16(af[ks][i], bfr[ks][j], acc[i][j], 0, 0, 0);
        }
    __builtin_amdgcn_sched_group_barrier(0x100, 8, 0);
#pragma unroll
    for (int g = 0; g < 2 * (MI + NJ) - 8; ++g) {
      __builtin_amdgcn_sched_group_barrier(0x008, 2, 0);
      __builtin_amdgcn_sched_group_barrier(0x100, 1, 0);
    }
    __builtin_amdgcn_sched_group_barrier(0x008, 2 * MI * NJ - 2 * (2 * (MI + NJ) - 8), 0);
    __builtin_amdgcn_sched_barrier(0);
    asm volatile("s_waitcnt vmcnt(0)" ::: "memory");
    __builtin_amdgcn_s_barrier();
    asm volatile("" ::: "memory");
  }
#undef GLDS
}

template <int N> __device__ __forceinline__ void wait_vmcnt() {
  if (N == 0) asm volatile("s_waitcnt vmcnt(0)" ::: "memory");
  else if (N == 3) asm volatile("s_waitcnt vmcnt(3)" ::: "memory");
  else if (N == 4) asm volatile("s_waitcnt vmcnt(4)" ::: "memory");
  else if (N == 6) asm volatile("s_waitcnt vmcnt(6)" ::: "memory");
  else if (N == 8) asm volatile("s_waitcnt vmcnt(8)" ::: "memory");
  else asm volatile("s_waitcnt vmcnt(0)" ::: "memory");
}

template <int MI, int NJ, int WM, int WN, bool PERM_A, bool PERM_B>
__device__ __forceinline__ void gemm4_prologue(const u16* __restrict__ A, int lda, const u16* __restrict__ B, int ldb, char* smem) {
  constexpr int AR = WM * MI * 16, BR = WN * NJ * 16;
  constexpr int A_BYTES = AR * 64, STAGE = (AR + BR) * 64;
  constexpr int LA = AR / 128, LB = BR / 128;
  const int tid = otid512();
  const int lr = tid >> 2, lc = (tid & 3) ^ ((4 - ((lr >> 2) & 3)) & 3);
  const u16* ag = A + (size_t)(PERM_A ? perm64(lr) : lr) * lda + lc * 8;
  const u16* bg = B + (size_t)(PERM_B ? perm64(lr) : lr) * ldb + lc * 8;
  char* sA = smem + tid * 16;
  char* sB = smem + A_BYTES + tid * 16;
#pragma unroll
  for (int kt = 0; kt < 3; ++kt) {
#pragma unroll
    for (int i = 0; i < LA; ++i)
      __builtin_amdgcn_global_load_lds((const unsigned*)(ag + (size_t)i * 128 * lda + kt * 32), (unsigned*)(sA + kt * STAGE + i * 8192), 16, 0, 0);
#pragma unroll
    for (int i = 0; i < LB; ++i)
      __builtin_amdgcn_global_load_lds((const unsigned*)(bg + (size_t)i * 128 * ldb + kt * 32), (unsigned*)(sB + kt * STAGE + i * 8192), 16, 0, 0);
  }
}

template <int MI, int NJ, int WM, int WN, bool SWAP, bool PERM_A, bool PERM_B, bool SKIP_PRO = false>
__device__ __forceinline__ void gemm_mainloop(const u16* __restrict__ A, int lda, const u16* __restrict__ B, int ldb,
                                              int K, f32x4 (&acc)[MI][NJ], char* smem) {
  constexpr int AR = WM * MI * 16, BR = WN * NJ * 16;
  constexpr int A_BYTES = AR * 64, STAGE = (AR + BR) * 64;
  constexpr int LA = AR / 128, LB = BR / 128, NL = LA + LB;
  const int tid = otid512(), lane = tid & 63, wave = tid >> 6;
  const int wm = wave / WN, wn = wave % WN, fr = lane & 15, fq = lane >> 4;
  const int lr = tid >> 2, lc = (tid & 3) ^ ((4 - ((lr >> 2) & 3)) & 3);
  const u16* ag = A + (size_t)(PERM_A ? perm64(lr) : lr) * lda + lc * 8;
  const u16* bg = B + (size_t)(PERM_B ? perm64(lr) : lr) * ldb + lc * 8;
  char* sA = smem + tid * 16;
  char* sB = smem + A_BYTES + tid * 16;
#define GLDS(gp, lp) __builtin_amdgcn_global_load_lds((const unsigned*)(gp), (unsigned*)(lp), 16, 0, 0)
#define ISSUE_TILE(kt_, st_)                                                                         \
  {                                                                                                  \
    _Pragma("unroll") for (int i = 0; i < LA; ++i)                                                   \
        GLDS(ag + (size_t)i * 128 * lda + (kt_) * 32, sA + (st_) * STAGE + i * 8192);                \
    _Pragma("unroll") for (int i = 0; i < LB; ++i)                                                   \
        GLDS(bg + (size_t)i * 128 * ldb + (kt_) * 32, sB + (st_) * STAGE + i * 8192);                \
  }
  const int nk = K >> 5;
  if (!SKIP_PRO) {
    ISSUE_TILE(0, 0);
    ISSUE_TILE(1, 1);
    ISSUE_TILE(2, 2);
  }
  const int rch = (fq ^ ((4 - ((fr >> 2) & 3)) & 3)) << 4;
  const int aoff = (wm * MI * 16 + fr) * 64 + rch, boff = A_BYTES + (wn * NJ * 16 + fr) * 64 + rch;
  for (int kt = 0; kt < nk; ++kt) {
    if (kt + 2 < nk) wait_vmcnt<2 * NL>();
    else if (kt + 1 < nk) wait_vmcnt<NL>();
    else wait_vmcnt<0>();
    __builtin_amdgcn_s_barrier();
    asm volatile("" ::: "memory");
    if (kt + 3 < nk) ISSUE_TILE(kt + 3, (kt + 3) & 3);
    const char* cA = smem + (kt & 3) * STAGE + aoff;
    const char* cB = smem + (kt & 3) * STAGE + boff;
    bf16x8 af[MI], bfr[NJ];
#pragma unroll
    for (int j = 0; j < NJ; ++j) bfr[j] = *(const bf16x8*)(cB + j * 1024);
#pragma unroll
    for (int i = 0; i < MI; ++i) af[i] = *(const bf16x8*)(cA + i * 1024);
#pragma unroll
    for (int i = 0; i < MI; ++i)
#pragma unroll
      for (int j = 0; j < NJ; ++j) {
        if (SWAP) acc[i][j] = __builtin_amdgcn_mfma_f32_16x16x32_bf16(bfr[j], af[i], acc[i][j], 0, 0, 0);
        else acc[i][j] = __builtin_amdgcn_mfma_f32_16x16x32_bf16(af[i], bfr[j], acc[i][j], 0, 0, 0);
      }
  }
  __syncthreads();
#undef ISSUE_TILE
#undef GLDS
}

template <int MI, int NJ>
__device__ __forceinline__ void zero_acc(f32x4 (&acc)[MI][NJ]) {
#pragma unroll
  for (int i = 0; i < MI; ++i)
#pragma unroll
    for (int j = 0; j < NJ; ++j) acc[i][j] = f32x4{0.f, 0.f, 0.f, 0.f};
}

template <bool SKIP_FIRST = false>
__device__ __forceinline__ void gemm_8phase(const u16* __restrict__ X, const u16* __restrict__ Y, f32x4 (&acc)[2][2][4][2],
                                            char* smem) {
  const int tid = otid512(), lane = tid & 63, wid = tid >> 6;
  const int wr = __builtin_amdgcn_readfirstlane(wid >> 2), wc = wid & 3, fr = lane & 15, fq = lane >> 4;
  int offx[2], offy[2];
#pragma unroll
  for (int i = 0; i < 2; ++i) {
    const int b = tid * 16 + i * 8192;
    const int st = b >> 10, sb = b & 1023, swz = sb ^ (((sb >> 9) & 1) << 5);
    const int R = (st >> 1) * 16 + (swz >> 6), C = (st & 1) * 32 + ((swz & 63) >> 1);
    offx[i] = perm64(R) * 64 + C;
    offy[i] = R * 64 + C;
  }
  char* const sdst = smem + tid * 16;
  const int rb = (fr * 64 + fq * 16) ^ ((fr >> 3) << 5);
  const char* const sra = smem + wr * 8192 + rb;
  const char* const srb = smem + 65536 + wc * 4096 + rb;
#define HTB 16384
#define SAo(b, h) (((b) * 2 + (h)) * HTB)
#define SBo(b, h) (((b) * 2 + (h)) * HTB)
#define GLDS(gp, lp) __builtin_amdgcn_global_load_lds((const unsigned*)(gp), (unsigned*)(lp), 16, 0, 0)
#define STAGE_X(b, h, kt) { _Pragma("unroll") for (int _i = 0; _i < 2; ++_i) \
    GLDS(X + (size_t)(h) * 8192 + (size_t)(kt) * 16384 + offx[_i], sdst + SAo(b, h) + _i * 8192); }
#define STAGE_Y(b, h, kt) { _Pragma("unroll") for (int _i = 0; _i < 2; ++_i) \
    GLDS(Y + (size_t)(h) * 8192 + (size_t)(kt) * 16384 + offy[_i], sdst + 65536 + SBo(b, h) + _i * 8192); }
#define LDA(dst, b, h) { _Pragma("unroll") for (int m = 0; m < 4; ++m) _Pragma("unroll") for (int k = 0; k < 2; ++k) \
    dst[m][k] = *(const bf16x8*)(sra + SAo(b, h) + (m * 2 + k) * 1024); }
#define LDB(dst, b, h) { _Pragma("unroll") for (int n = 0; n < 2; ++n) _Pragma("unroll") for (int k = 0; k < 2; ++k) \
    dst[n][k] = *(const bf16x8*)(srb + SBo(b, h) + (n * 2 + k) * 1024); }
#define MMA(ai, bj, At_, Bt_) { __builtin_amdgcn_s_setprio(1); \
    _Pragma("unroll") for (int m = 0; m < 4; ++m) _Pragma("unroll") for (int n = 0; n < 2; ++n) _Pragma("unroll") for (int k = 0; k < 2; ++k) \
      acc[ai][bj][m][n] = __builtin_amdgcn_mfma_f32_16x16x32_bf16(At_[m][k], Bt_[n][k], acc[ai][bj][m][n], 0, 0, 0); \
    __builtin_amdgcn_s_setprio(0); }
#define WAIT_V(n) asm volatile("s_waitcnt vmcnt(" #n ")" ::: "memory")
#define WAIT_L(n) asm volatile("s_waitcnt lgkmcnt(" #n ")" ::: "memory")
#define BAR __builtin_amdgcn_s_barrier()
#define SCHED __builtin_amdgcn_sched_barrier(0)
  bf16x8 At[4][2], B0[2][2], B1[2][2];
  constexpr int nt = 16;
  if (!SKIP_FIRST) { STAGE_Y(0, 0, 0); STAGE_X(0, 0, 0); STAGE_Y(0, 1, 0); STAGE_X(0, 1, 0); }
  if (wr == 1) BAR;
  WAIT_V(4); BAR;
  STAGE_Y(1, 0, 1); STAGE_X(1, 0, 1); STAGE_Y(1, 1, 1);
  WAIT_V(6); BAR;
#pragma unroll 1
  for (int t = 0; t < nt - 2; t += 2) {
    LDB(B0, 0, 0); SCHED; LDA(At, 0, 0); STAGE_X(1, 1, t + 1);
    WAIT_L(8); BAR; WAIT_L(0); MMA(0, 0, At, B0); BAR; SCHED;
    LDB(B1, 0, 1); STAGE_Y(0, 0, t + 2);
    BAR; WAIT_L(0); MMA(0, 1, At, B1); BAR;
    LDA(At, 0, 1); STAGE_X(0, 0, t + 2);
    BAR; WAIT_L(0); MMA(1, 0, At, B0); BAR; SCHED;
    STAGE_Y(0, 1, t + 2);
    WAIT_V(6); BAR; MMA(1, 1, At, B1); BAR;
    LDB(B0, 1, 0); SCHED; LDA(At, 1, 0); STAGE_X(0, 1, t + 2);
    WAIT_L(8); BAR; WAIT_L(0); MMA(0, 0, At, B0); BAR; SCHED;
    LDB(B1, 1, 1); STAGE_Y(1, 0, t + 3);
    BAR; WAIT_L(0); MMA(0, 1, At, B1); BAR;
    LDA(At, 1, 1); STAGE_X(1, 0, t + 3);
    BAR; WAIT_L(0); MMA(1, 0, At, B0); BAR; SCHED;
    STAGE_Y(1, 1, t + 3);
    WAIT_V(6); BAR; MMA(1, 1, At, B1); BAR;
  }
  { LDB(B0, 0, 0); LDA(At, 0, 0); STAGE_X(1, 1, nt - 1);
    BAR; WAIT_L(0); MMA(0, 0, At, B0); BAR;
    LDB(B1, 0, 1); BAR; WAIT_L(0); MMA(0, 1, At, B1); BAR;
    LDA(At, 0, 1); WAIT_V(4); BAR; WAIT_L(0); MMA(1, 0, At, B0); MMA(1, 1, At, B1); BAR; }
  { LDB(B0, 1, 0); LDA(At, 1, 0); WAIT_V(2); BAR; WAIT_L(0); MMA(0, 0, At, B0); BAR;
    LDB(B1, 1, 1); WAIT_V(0); BAR; WAIT_L(0); MMA(0, 1, At, B1); BAR;
    LDA(At, 1, 1); BAR; WAIT_L(0); MMA(1, 0, At, B0); MMA(1, 1, At, B1); BAR; }
  if (wr == 0) BAR;
#undef HTB
#undef SAo
#undef SBo
#undef GLDS
#undef STAGE_X
#undef STAGE_Y
#undef LDA
#undef LDB
#undef MMA
#undef WAIT_V
#undef WAIT_L
#undef BAR
#undef SCHED
}

__device__ __forceinline__ void gemm_8phase_first(const u16* __restrict__ X, const u16* __restrict__ Y, char* smem) {
  const int tid = otid512();
  char* const sdst = smem + tid * 16;
#pragma unroll
  for (int h = 0; h < 2; ++h) {
#pragma unroll
    for (int s = 0; s < 2; ++s) {
#pragma unroll
      for (int i = 0; i < 2; ++i) {
        const int b = tid * 16 + i * 8192;
        const int st = b >> 10, sb = b & 1023, swz = sb ^ (((sb >> 9) & 1) << 5);
        const int R = (st >> 1) * 16 + (swz >> 6), C = (st & 1) * 32 + ((swz & 63) >> 1);
        const u16* g = (s == 0 ? Y + R * 64 : X + perm64(R) * 64) + C + (size_t)h * 8192;
        char* d = sdst + (s == 0 ? 65536 : 0) + h * 16384 + i * 8192;
        __builtin_amdgcn_global_load_lds((const unsigned*)g, (unsigned*)d, 16, 0, 0);
      }
    }
  }
}

__device__ void phaseA(const Params& p, int l, char* smem, int vid) {
  const int tid = otid512(), lane = tid & 63, wid = tid >> 6;
  const int wr = wid >> 2, wc = wid & 3, fr = lane & 15, fq = lane >> 4;
  const u16* W = p.wt_in + (size_t)l * 8192 * 1024;
  float* newk = p.out + 8388608;
  float* newv = p.out + 16777216;
#define TILE_OF(id_, m0_, n0_)                                                     \
  {                                                                                \
    const int xcd_ = (id_) & 7, jj_ = (id_) >> 3;                                  \
    m0_ = (xcd_ * 4 + (jj_ & 3)) * 256; n0_ = ((jj_ >> 5) * 8 + ((jj_ >> 2) & 7)) * 256; \
  }
#define FIRST_OF(m0_, n0_)                                                                        \
  {                                                                                               \
    if ((n0_) >= 1024 && (n0_) < 1536) gemm_8phase_first(p.xm + (size_t)(m0_) * 1024, W + (size_t)(n0_) * 1024, smem); \
    else gemm_8phase_first(W + (size_t)(n0_) * 1024, p.xm + (size_t)(m0_) * 1024, smem);          \
  }
  if (vid < 1024) { int m0f, n0f; TILE_OF(vid, m0f, n0f); FIRST_OF(m0f, n0f); }
  for (int id = vid; id < 1024; id += gridDim.x) {
    int m0, n0;
    TILE_OF(id, m0, n0);
    const int idn = id + gridDim.x;
    int m0n = 0, n0n = 0;
    if (idn < 1024) TILE_OF(idn, m0n, n0n);
    f32x4 acc[2][2][4][2];
#pragma unroll
    for (int a_ = 0; a_ < 2; ++a_)
#pragma unroll
      for (int b_ = 0; b_ < 2; ++b_)
#pragma unroll
        for (int m = 0; m < 4; ++m)
#pragma unroll
          for (int n = 0; n < 2; ++n) acc[a_][b_][m][n] = f32x4{0.f, 0.f, 0.f, 0.f};
    const u16* At_ = p.xm + (size_t)m0 * 1024;
    const u16* Bw = W + (size_t)n0 * 1024;
    const float* swp = p.sW + (size_t)(l * 3 + (m0 < 4096 ? 0 : 1 + ((m0 - 4096) >> 11))) * 8192;
    if (n0 >= 1024 && n0 < 1536) {
      gemm_8phase<true>(At_, Bw, acc, smem);
      if (idn < 1024) FIRST_OF(m0n, n0n);
#pragma unroll
      for (int ai = 0; ai < 2; ++ai) {
        const int tok0 = m0 + ai * 128 + wr * 64 + fq * 16;
        float rs[16];
#pragma unroll
        for (int q = 0; q < 4; ++q) {
          const float4 s4 = *(const float4*)(p.rowss + (size_t)l * 8192 + tok0 + q * 4);
          rs[q * 4 + 0] = rsqrtf(s4.x * (1.f / 1024.f) + 1e-6f); rs[q * 4 + 1] = rsqrtf(s4.y * (1.f / 1024.f) + 1e-6f);
          rs[q * 4 + 2] = rsqrtf(s4.z * (1.f / 1024.f) + 1e-6f); rs[q * 4 + 3] = rsqrtf(s4.w * (1.f / 1024.f) + 1e-6f);
        }
#pragma unroll
        for (int bj = 0; bj < 2; ++bj)
#pragma unroll
          for (int n = 0; n < 2; ++n) {
            const float sw = swp[n0 + bj * 128 + wc * 32 + n * 16 + fr];
#pragma unroll
            for (int m = 0; m < 4; ++m)
#pragma unroll
              for (int jj = 0; jj < 4; ++jj) acc[ai][bj][m][n][jj] = acc[ai][bj][m][n][jj] * rs[m * 4 + jj] + sw;
          }
      }
#pragma unroll
      for (int ai = 0; ai < 2; ++ai)
#pragma unroll
        for (int bj = 0; bj < 2; ++bj)
#pragma unroll
          for (int n = 0; n < 2; ++n) {
            const int tok0 = m0 + ai * 128 + wr * 64 + fq * 16;
            const int vc = n0 + bj * 128 + wc * 32 + n * 16 + fr - 1024;
            uint4 w0 = make_uint4(pack2(acc[ai][bj][0][n][0], acc[ai][bj][0][n][1]), pack2(acc[ai][bj][0][n][2], acc[ai][bj][0][n][3]),
                                  pack2(acc[ai][bj][1][n][0], acc[ai][bj][1][n][1]), pack2(acc[ai][bj][1][n][2], acc[ai][bj][1][n][3]));
            uint4 w1 = make_uint4(pack2(acc[ai][bj][2][n][0], acc[ai][bj][2][n][1]), pack2(acc[ai][bj][2][n][2], acc[ai][bj][2][n][3]),
                                  pack2(acc[ai][bj][3][n][0], acc[ai][bj][3][n][1]), pack2(acc[ai][bj][3][n][2], acc[ai][bj][3][n][3]));
            *(uint4*)(p.Vt + (size_t)vc * 8192 + tok0) = w0;
            *(uint4*)(p.Vt + (size_t)vc * 8192 + tok0 + 8) = w1;
            if (tok0 < 4096) {
#pragma unroll
              for (int m = 0; m < 4; ++m)
#pragma unroll
                for (int jj = 0; jj < 4; ++jj) {
                  const int t = tok0 + m * 4 + jj;
                  __builtin_nontemporal_store(acc[ai][bj][m][n][jj], &newv[((size_t)((t >> 8) * 4 + l) * 256 + (t & 255)) * 512 + vc]);
                }
            }
          }
    } else {
      gemm_8phase<true>(Bw, At_, acc, smem);
      if (idn < 1024) FIRST_OF(m0n, n0n);
#pragma unroll
      for (int ai = 0; ai < 2; ++ai) {
        const float* swc = swp + n0 + ai * 128 + wr * 64 + fq * 16;
        float4 sw4[4];
#pragma unroll
        for (int m = 0; m < 4; ++m) sw4[m] = *(const float4*)(swc + m * 4);
#pragma unroll
        for (int bj = 0; bj < 2; ++bj)
#pragma unroll
          for (int n = 0; n < 2; ++n) {
            const int t = m0 + bj * 128 + wc * 32 + n * 16 + fr;
            const float rs = rsqrtf(p.rowss[(size_t)l * 8192 + t] * (1.f / 1024.f) + 1e-6f);
#pragma unroll
            for (int m = 0; m < 4; ++m) {
              acc[ai][bj][m][n][0] = acc[ai][bj][m][n][0] * rs + sw4[m].x; acc[ai][bj][m][n][1] = acc[ai][bj][m][n][1] * rs + sw4[m].y;
              acc[ai][bj][m][n][2] = acc[ai][bj][m][n][2] * rs + sw4[m].z; acc[ai][bj][m][n][3] = acc[ai][bj][m][n][3] * rs + sw4[m].w;
            }
          }
      }
      const bool isK = (n0 >= 512 && n0 < 1024);
#pragma unroll
      for (int ai = 0; ai < 2; ++ai)
#pragma unroll
        for (int bj = 0; bj < 2; ++bj)
#pragma unroll
          for (int n = 0; n < 2; ++n) {
            const int t = m0 + bj * 128 + wc * 32 + n * 16 + fr;
            const int col = n0 + ai * 128 + wr * 64 + fq * 16;
            uint4 w0 = make_uint4(pack2(acc[ai][bj][0][n][0], acc[ai][bj][0][n][1]), pack2(acc[ai][bj][0][n][2], acc[ai][bj][0][n][3]),
                                  pack2(acc[ai][bj][1][n][0], acc[ai][bj][1][n][1]), pack2(acc[ai][bj][1][n][2], acc[ai][bj][1][n][3]));
            uint4 w1 = make_uint4(pack2(acc[ai][bj][2][n][0], acc[ai][bj][2][n][1]), pack2(acc[ai][bj][2][n][2], acc[ai][bj][2][n][3]),
                                  pack2(acc[ai][bj][3][n][0], acc[ai][bj][3][n][1]), pack2(acc[ai][bj][3][n][2], acc[ai][bj][3][n][3]));
            if (n0 >= 5120) {
              __builtin_nontemporal_store(u32x4{w0.x, w0.y, w0.z, w0.w}, (u32x4*)(p.P + (size_t)t * 8192 + col));
              __builtin_nontemporal_store(u32x4{w1.x, w1.y, w1.z, w1.w}, (u32x4*)(p.P + (size_t)t * 8192 + col + 8));
            } else {
              *(uint4*)(p.P + (size_t)t * 8192 + col) = w0;
              *(uint4*)(p.P + (size_t)t * 8192 + col + 8) = w1;
            }
            if (isK && t < 4096) {
              float* dst = newk + ((size_t)((t >> 8) * 4 + l) * 256 + (t & 255)) * 512 + (col - 512);
#pragma unroll
              for (int m = 0; m < 4; ++m)
                stnt4(dst + m * 4, acc[ai][bj][m][n][0], acc[ai][bj][m][n][1], acc[ai][bj][m][n][2], acc[ai][bj][m][n][3]);
            }
          }
    }
  }
}

__device__ __forceinline__ bf16x8 ld16(const u16* ptr) { return *(const bf16x8*)ptr; }

struct VbBar { unsigned* cnt; unsigned target; };
template <bool DRAIN_VM = true>
__device__ __forceinline__ void vb_barrier(VbBar& vb) {
  if (DRAIN_VM) asm volatile("s_waitcnt vmcnt(0) lgkmcnt(0)" ::: "memory");
  else asm volatile("s_waitcnt lgkmcnt(0)" ::: "memory");
  vb.target += 4;
  if ((threadIdx.x & 63) == 0) __hip_atomic_fetch_add(vb.cnt, 1u, __ATOMIC_RELAXED, __HIP_MEMORY_SCOPE_WORKGROUP);
  while (__hip_atomic_load(vb.cnt, __ATOMIC_RELAXED, __HIP_MEMORY_SCOPE_WORKGROUP) < vb.target) __builtin_amdgcn_s_sleep(1);
  asm volatile("" ::: "memory");
}

template <> __device__ __forceinline__ void item_barrier<false>(VbBar*) { __syncthreads(); }
template <> __device__ __forceinline__ void item_barrier<true>(VbBar* vb) { vb_barrier(*vb); }

template <int NS, bool LOCAL>
__device__ __forceinline__ void attn_step(const char* kbuf, const char* vbuf, int ka0, int ka1, int va, const bf16x8& q0,
                                          const bf16x8& q1, f32x4 (&o)[4], float& m, float& lsum, const char* rpb_row,
                                          const int (&boff)[8], unsigned vmask) {
  f32x4 s[2 * NS];
#pragma unroll
  for (int t = 0; t < 2 * NS; ++t) {
    const bf16x8 a0 = *(const bf16x8*)(kbuf + ka0 + (t >> 1) * 4096 + (t & 1) * 512);
    const bf16x8 a1 = *(const bf16x8*)(kbuf + ka1 + (t >> 1) * 4096 + (t & 1) * 512);
    f32x4 z = f32x4{0.f, 0.f, 0.f, 0.f};
    z = __builtin_amdgcn_mfma_f32_16x16x32_bf16(a0, q0, z, 0, 0, 0);
    s[t] = __builtin_amdgcn_mfma_f32_16x16x32_bf16(a1, q1, z, 0, 0, 0);
  }
  bf16x8 vf[NS][4];
#pragma unroll
  for (int sl = 0; sl < NS; ++sl)
#pragma unroll
    for (int dt = 0; dt < 4; ++dt) vf[sl][dt] = *(const bf16x8*)(vbuf + ((va + dt * 2048) ^ (sl * 64)));
  float cmax = -1e30f;
#pragma unroll
  for (int t = 0; t < 2 * NS; ++t)
#pragma unroll
    for (int jj = 0; jj < 4; ++jj) {
      float v = s[t][jj] * 0.18033688f;
      if (LOCAL) {
        const int e8 = (t & 1) * 4 + jj;
        const float bias = *(const float*)(rpb_row + boff[e8]);
        v = ((vmask >> e8) & 1u) ? v + bias : -1e30f;
      }
      s[t][jj] = v;
      cmax = fmaxf(cmax, v);
    }
  cmax = xrow16_max(cmax);
  const float mnew = fmaxf(m, cmax);
  if (__builtin_amdgcn_ballot_w64(mnew > m) != 0ull) {
    const float alpha = __builtin_amdgcn_exp2f(m - mnew);
    lsum *= alpha;
#pragma unroll
    for (int dt = 0; dt < 4; ++dt) o[dt] *= alpha;
    m = mnew;
  }
#pragma unroll
  for (int t = 0; t < 2 * NS; ++t)
#pragma unroll
    for (int jj = 0; jj < 4; ++jj) {
      const float pv = __builtin_amdgcn_exp2f(s[t][jj] - m);
      lsum += pv;
      s[t][jj] = pv;
    }
#pragma unroll
  for (int sl = 0; sl < NS; ++sl) {
    u32x4 pw = {pack2(s[2 * sl][0], s[2 * sl][1]), pack2(s[2 * sl][2], s[2 * sl][3]),
                pack2(s[2 * sl + 1][0], s[2 * sl + 1][1]), pack2(s[2 * sl + 1][2], s[2 * sl + 1][3])};
    const bf16x8 pb = __builtin_bit_cast(bf16x8, pw);
#pragma unroll
    for (int dt = 0; dt < 4; ++dt) o[dt] = __builtin_amdgcn_mfma_f32_16x16x32_bf16(vf[sl][dt], pb, o[dt], 0, 0, 0);
  }
}

__device__ void attn_item(const Params& p, int l, int item, char* smem, VbBar& vb) {
  const int tid = otid(), lane = tid & 63, fr = lane & 15, fq = lane >> 4;
  const int wave = __builtin_amdgcn_readfirstlane(tid >> 6);
  const bool lat = item >= 512;
  int b, h, qtok0, r = 0, n = 0, row0 = 0, band0 = 0;
  if (!lat) {
    const int unit = item * 4 + wave;
    b = unit >> 7; h = (unit >> 4) & 7;
    qtok0 = b * 256 + (unit & 15) * 16;
  } else {
    const int u = (item - 512) * 4 + wave;
    b = u >> 10; r = (u >> 5) & 31; h = (u >> 2) & 7; n = u & 3;
    qtok0 = 4096 + b * 2048 + r * 64 + n * 16;
    row0 = min(max(r - 4, 0), 24);
    band0 = min(max(16 * n - 8, 0), 32);
  }
  float* rpb = (float*)(smem + 57344 + wave * 2048);
  if (lat) {
    const float* rg = p.na_rpb + (size_t)(l * 8 + h) * 15 * 31;
#pragma unroll
    for (int i = 0; i < 8; ++i) {
      const int idx = lane + 64 * i;
      if (idx < 465) rpb[idx] = rg[idx] * 1.44269504f;
    }
  }
  const u16* qp = p.P + (size_t)(qtok0 + fr) * 8192 + h * 64 + fq * 8;
  const bf16x8 q0 = ld16(qp), q1 = ld16(qp + 32);
  f32x4 o[4];
#pragma unroll
  for (int dt = 0; dt < 4; ++dt) o[dt] = f32x4{0.f, 0.f, 0.f, 0.f};
  float m = -1e30f, lsum = 0.f;
  const int qc = 16 * n + fr;
  const int wst = min(max(qc - 8, 0), 48);
  const int nch = lat ? 12 : 4;
  const int fk0 = ((fr >> 1) & 1) | (((fr >> 2) & 3) << 1);
  const int fkL = ((fr >> 1) & 1) | ((((band0 >> 3) + (fr >> 2)) & 3) << 1);
  const int krow = (fr >> 2) * 8 + (fr & 3);
  const int ka0_0 = krow * 128 + ((fq ^ fk0) << 4), ka1_0 = krow * 128 + (((4 + fq) ^ fk0) << 4);
  const int ka0_L = (band0 + krow) * 128 + ((fq ^ fkL) << 4), ka1_L = (band0 + krow) * 128 + (((4 + fq) ^ fkL) << 4);
  const int va_0 = fr * 128 + ((fq ^ ((fr >> 1) & 7)) << 4);
  const int va_L = fr * 128 + ((((band0 >> 3) + fq) ^ ((fr >> 1) & 7)) << 4);
  int boff[8];
  unsigned vmask = 0u;
#pragma unroll
  for (int e8 = 0; e8 < 8; ++e8) {
    const int kc = band0 + fq * 8 + e8;
    boff[e8] = (min(max(kc - qc, -15), 15) + 15) * 4;
    vmask |= ((kc >= wst) && (kc < wst + 16)) ? (1u << e8) : 0u;
  }
  const int lrow = tid >> 3, lpc = tid & 7;
  const int klc = lpc ^ (((lrow >> 1) & 1) | (((lrow >> 3) & 3) << 1));
  const int vlc = lpc ^ ((lrow >> 1) & 7);
#define GLDS(gp, lp) __builtin_amdgcn_global_load_lds((const unsigned*)(gp), (unsigned*)(lp), 16, 0, 0)
#define ISSUE_CHUNK(c)                                                                                           \
  {                                                                                                              \
    const u16 *kb_, *vb_; size_t ks_, vs_;                                                                       \
    if (!lat) {                                                                                                  \
      const size_t key0 = (size_t)b * 256 + (c) * 64;                                                            \
      kb_ = p.P + key0 * 8192 + 512 + h * 64; ks_ = 8192;                                                        \
      vb_ = p.Vt + (size_t)(h * 64) * 8192 + key0; vs_ = 8192;                                                   \
    } else if ((c) < 8) {                                                                                        \
      const size_t tok = 4096 + (size_t)b * 2048 + (row0 + (c)) * 64;                                            \
      kb_ = p.P + tok * 8192 + 512 + h * 64; ks_ = 8192;                                                         \
      vb_ = p.Vt + (size_t)(h * 64) * 8192 + tok; vs_ = 8192;                                                    \
    } else {                                                                                                     \
      kb_ = p.ckb + ((size_t)(b * 4 + l) * 256 + ((c) - 8) * 64) * 512 + h * 64; ks_ = 512;                      \
      vb_ = p.cvT + (size_t)((b * 4 + l) * 8 + h) * 64 * 256 + ((c) - 8) * 64; vs_ = 256;                        \
    }                                                                                                            \
    char* dst_ = smem + ((c) % 3) * 16384 + tid * 16;                                                            \
    GLDS(kb_ + (size_t)lrow * ks_ + klc * 8, dst_);                                                              \
    GLDS(kb_ + (size_t)(lrow + 32) * ks_ + klc * 8, dst_ + 4096);                                                \
    GLDS(vb_ + (size_t)lrow * vs_ + vlc * 8, dst_ + 8192);                                                       \
    GLDS(vb_ + (size_t)(lrow + 32) * vs_ + vlc * 8, dst_ + 12288);                                               \
  }
  ISSUE_CHUNK(0);
  ISSUE_CHUNK(1);
#pragma unroll 1
  for (int c = 0; c < nch; ++c) {
    if (c + 1 < nch) asm volatile("s_waitcnt vmcnt(4)" ::: "memory");
    else asm volatile("s_waitcnt vmcnt(0)" ::: "memory");
    vb_barrier<false>(vb);
    if (c + 2 < nch) ISSUE_CHUNK(c + 2);
    const char* kbuf = smem + (c % 3) * 16384;
    const char* vbuf = kbuf + 8192;
    if (lat && c < 8)
      attn_step<1, true>(kbuf, vbuf, ka0_L, ka1_L, va_L, q0, q1, o, m, lsum, (const char*)(rpb + (row0 + c - r + 7) * 31), boff, vmask);
    else
      attn_step<2, false>(kbuf, vbuf, ka0_0, ka1_0, va_0, q0, q1, o, m, lsum, (const char*)rpb, boff, vmask);
  }
#undef ISSUE_CHUNK
#undef GLDS
  lsum += __shfl_xor(lsum, 16);
  lsum += __shfl_xor(lsum, 32);
  const float inv = 1.f / lsum;
  const size_t t = qtok0 + fr;
#pragma unroll
  for (int dt = 0; dt < 4; ++dt) {
    int d0 = h * 64 + dt * 16 + fq * 4;
    uint2 g = *(const uint2*)(p.P + t * 8192 + 1536 + d0);
    float y0 = o[dt][0] * inv * silu(lo16(g.x)), y1 = o[dt][1] * inv * silu(hi16(g.x));
    float y2 = o[dt][2] * inv * silu(lo16(g.y)), y3 = o[dt][3] * inv * silu(hi16(g.y));
    *(uint2*)(p.Ana + t * 512 + d0) = make_uint2(pack2(y0, y1), pack2(y2, y3));
  }
  vb_barrier(vb);
}

template <int DIR>
__device__ __forceinline__ void lru_gates_scan(const Params& p, int l, int blk, int wave, int fr, int fq,
                                               const bf16x8 (&wr)[8], const bf16x8 (&wi)[8], const float (&pba)[4],
                                               const float (&pbx)[4], const float (&psp)[4], const u16* udb, const float* sud,
                                               float* stot, float (&acw)[4][4], float (&hw)[4][4]) {
  f32x4 ar[4], ai[4];
#pragma unroll
  for (int nt = 0; nt < 4; ++nt) { ar[nt] = f32x4{0.f, 0.f, 0.f, 0.f}; ai[nt] = f32x4{0.f, 0.f, 0.f, 0.f}; }
#pragma unroll
  for (int ks = 0; ks < 2; ++ks) {
    const bf16x8 af = *(const bf16x8*)(udb + (wave * 16 + fr) * 72 + ks * 32 + fq * 8);
#pragma unroll
    for (int nt = 0; nt < 4; ++nt) {
      ar[nt] = __builtin_amdgcn_mfma_f32_16x16x32_bf16(af, wr[ks * 4 + nt], ar[nt], 0, 0, 0);
      ai[nt] = __builtin_amdgcn_mfma_f32_16x16x32_bf16(af, wi[ks * 4 + nt], ai[nt], 0, 0, 0);
    }
  }
#pragma unroll
  for (int nt = 0; nt < 4; ++nt) {
    const int k = nt * 16 + fr;
    const float ba = pba[nt], bx = pbx[nt], sp = psp[nt];
    float av[4], bv[4];
#pragma unroll
    for (int jj = 0; jj < 4; ++jj) {
      const int t = wave * 16 + fq * 4 + jj;
      const float rg = sigm(ar[nt][jj] + ba), ig = sigm(ai[nt][jj] + bx);
      const float la = -rg * sp;
      const float a = __expf(la);
      const float ud = sud[t * 64 + k];
      const float x2 = 2.f * la;
      const float ser = -x2 * (1.f + x2 * (0.5f + x2 * (0.16666667f + x2 * (0.041666668f + x2 * (0.0083333338f + x2 * 0.0013888889f)))));
      const float om = x2 > -0.5f ? ser : 1.f - a * a;
      av[jj] = a;
      bv[jj] = __builtin_amdgcn_sqrtf(om) * (ig * ud);
    }
    float h = 0.f, ac = 1.f;
#pragma unroll
    for (int q = 0; q < 4; ++q) {
      const int jj = DIR ? 3 - q : q;
      h = av[jj] * h + bv[jj];
      ac *= av[jj];
      acw[nt][jj] = ac; hw[nt][jj] = h;
    }
    float gA[4], gH[4];
#pragma unroll
    for (int g = 0; g < 4; ++g) { gA[g] = __shfl(ac, fr + 16 * g); gH[g] = __shfl(h, fr + 16 * g); }
    float cA = 1.f, cH = 0.f, wA = 1.f, wH = 0.f;
#pragma unroll
    for (int q = 0; q < 4; ++q) {
      const int g = DIR ? 3 - q : q;
      const bool before = DIR ? (g > fq) : (g < fq);
      if (before) { cH = gA[g] * cH + gH[g]; cA *= gA[g]; }
      wH = gA[g] * wH + gH[g]; wA *= gA[g];
    }
#pragma unroll
    for (int jj = 0; jj < 4; ++jj) { hw[nt][jj] = hw[nt][jj] + acw[nt][jj] * cH; acw[nt][jj] *= cA; }
    if (fq == 0) { stot[((DIR * 4 + wave) * 64 + k) * 2] = wA; stot[((DIR * 4 + wave) * 64 + k) * 2 + 1] = wH; }
  }
}

template <int DIR>
__device__ __forceinline__ void lru_finish(const Params& p, int cs, int blk, int wave, int fr, int fq, const float* stot,
                                           float (&acw)[4][4], float (&hw)[4][4], u16* hst, u16* ast) {
#pragma unroll
  for (int nt = 0; nt < 4; ++nt) {
    const int k = nt * 16 + fr;
    float cA = 1.f, cH = 0.f, tA = 1.f, tH = 0.f;
#pragma unroll
    for (int q = 0; q < 4; ++q) {
      const int w2 = DIR ? 3 - q : q;
      const float A2 = stot[((DIR * 4 + w2) * 64 + k) * 2], H2 = stot[((DIR * 4 + w2) * 64 + k) * 2 + 1];
      const bool before = DIR ? (w2 > wave) : (w2 < wave);
      if (before) { cH = A2 * cH + H2; cA *= A2; }
      tH = A2 * tH + H2; tA *= A2;
    }
#pragma unroll
    for (int jj = 0; jj < 4; ++jj) {
      const int t = wave * 16 + fq * 4 + jj;
      hst[t * 64 + k] = (u16)f2bf(hw[nt][jj] + acw[nt][jj] * cH);
      ast[t * 64 + k] = (u16)f2bf(acw[nt][jj] * cA);
    }
    if (fq == 0 && nt == wave) {
      p.Atot[(size_t)(cs * 2 + DIR) * 512 + blk * 64 + k] = tA;
      p.Htot[(size_t)(cs * 2 + DIR) * 512 + blk * 64 + k] = tH;
    }
  }
}

__device__ void lru_unit2(const Params& p, int l, int unit, char* smem, VbBar& vb) {
  const int tid = otid(), lane = tid & 63, fr = lane & 15, fq = lane >> 4;
  const int wave = __builtin_amdgcn_readfirstlane(tid >> 6);
  const int blk = unit & 7, cs = unit >> 3;
  const int t0 = cs * 64;
  int seq_lo, seq_hi;
  if (cs < 64) { seq_lo = (cs >> 2) * 256; seq_hi = seq_lo + 256; }
  else { seq_lo = 4096 + ((cs - 64) >> 5) * 2048; seq_hi = seq_lo + 2048; }
  u16* uraw = (u16*)smem;
  u16* udb0 = (u16*)(smem + 8960);
  u16* udb1 = (u16*)(smem + 18176);
  float* sud0 = (float*)(smem + 27392);
  float* sud1 = (float*)(smem + 43776);
  float* stot = (float*)(smem + 60160);
  bf16x8 wr0[8], wi0[8];
  {
    const u16* wrp = p.wgT + (size_t)(((l * 2 + 0) * 2 + 0) * 8 + blk) * 4096 + fr * 64 + fq * 8;
    const u16* wip = p.wgT + (size_t)(((l * 2 + 0) * 2 + 1) * 8 + blk) * 4096 + fr * 64 + fq * 8;
#pragma unroll
    for (int ks = 0; ks < 2; ++ks)
#pragma unroll
      for (int nt = 0; nt < 4; ++nt) { wr0[ks * 4 + nt] = ld16(wrp + nt * 1024 + ks * 32); wi0[ks * 4 + nt] = ld16(wip + nt * 1024 + ks * 32); }
  }
  float pba0[4], pbx0[4], psp0[4], pba1[4], pbx1[4], psp1[4], cvw[10];
#pragma unroll
  for (int nt = 0; nt < 4; ++nt) {
    const int pi0 = (l * 2 + 0) * 512 + blk * 64 + nt * 16 + fr, pi1 = pi0 + 512;
    pba0[nt] = p.lru_ba[pi0]; pbx0[nt] = p.lru_bx[pi0]; psp0[nt] = p.sp8[pi0];
    pba1[nt] = p.lru_ba[pi1]; pbx1[nt] = p.lru_bx[pi1]; psp1[nt] = p.sp8[pi1];
  }
  {
    const int cw = blk * 64 + (tid & 63);
    const float* cf = p.lru_conv_w + (size_t)((l * 2 + 0) * 4) * 512 + cw;
    const float* cbk = p.lru_conv_w + (size_t)((l * 2 + 1) * 4) * 512 + cw;
    cvw[0] = cf[0]; cvw[1] = cf[512]; cvw[2] = cf[1024]; cvw[3] = cf[1536];
    cvw[4] = cbk[0]; cvw[5] = cbk[512]; cvw[6] = cbk[1024]; cvw[7] = cbk[1536];
    cvw[8] = p.lru_conv_b[(l * 2 + 0) * 512 + cw]; cvw[9] = p.lru_conv_b[(l * 2 + 1) * 512 + cw];
  }
#pragma unroll
  for (int i = 0; i < 3; ++i) {
    const int row = (tid >> 3) + i * 32, ch8 = tid & 7;
    if (row < 70) {
      const int t = t0 - 3 + row;
      uint4 v = make_uint4(0, 0, 0, 0);
      if (t >= seq_lo && t < seq_hi) v = *(const uint4*)(p.P + (size_t)t * 8192 + 2048 + blk * 64 + ch8 * 8);
      *(uint4*)(uraw + row * 64 + ch8 * 8) = v;
    }
  }
  vb_barrier(vb);
#pragma unroll
  for (int nt = 0; nt < 4; ++nt) {
    asm volatile("" : "+v"(pba0[nt]), "+v"(pbx0[nt]), "+v"(psp0[nt]), "+v"(pba1[nt]), "+v"(pbx1[nt]), "+v"(psp1[nt]));
  }
#pragma unroll
  for (int q = 0; q < 10; ++q) asm volatile("" : "+v"(cvw[q]));
  {
    const int ch = tid & 63, tg = tid >> 6;
    const float f0 = cvw[0], f1 = cvw[1], f2 = cvw[2], f3 = cvw[3];
    const float b0 = cvw[4], b1 = cvw[5], b2 = cvw[6], b3 = cvw[7];
    const float bf_ = cvw[8], bb_ = cvw[9];
    float uw[22];
#pragma unroll
    for (int q = 0; q < 22; ++q) uw[q] = bf2f(uraw[(tg * 16 + q) * 64 + ch]);
#pragma unroll
    for (int q = 0; q < 16; ++q) {
      const int t = tg * 16 + q;
      const float uf = bf_ + f0 * uw[q] + f1 * uw[q + 1] + f2 * uw[q + 2] + f3 * uw[q + 3];
      const float ub = bb_ + b0 * uw[q + 3] + b1 * uw[q + 4] + b2 * uw[q + 5] + b3 * uw[q + 6];
      sud0[t * 64 + ch] = uf; udb0[t * 72 + ch] = (u16)f2bf(uf);
      sud1[t * 64 + ch] = ub; udb1[t * 72 + ch] = (u16)f2bf(ub);
    }
  }
  vb_barrier(vb);
  bf16x8 wr1[8], wi1[8];
  {
    const u16* wrp = p.wgT + (size_t)(((l * 2 + 1) * 2 + 0) * 8 + blk) * 4096 + fr * 64 + fq * 8;
    const u16* wip = p.wgT + (size_t)(((l * 2 + 1) * 2 + 1) * 8 + blk) * 4096 + fr * 64 + fq * 8;
#pragma unroll
    for (int ks = 0; ks < 2; ++ks)
#pragma unroll
      for (int nt = 0; nt < 4; ++nt) { wr1[ks * 4 + nt] = ld16(wrp + nt * 1024 + ks * 32); wi1[ks * 4 + nt] = ld16(wip + nt * 1024 + ks * 32); }
  }
  float ac0[4][4], h0[4][4], ac1[4][4], h1[4][4];
  lru_gates_scan<0>(p, l, blk, wave, fr, fq, wr0, wi0, pba0, pbx0, psp0, udb0, sud0, stot, ac0, h0);
  lru_gates_scan<1>(p, l, blk, wave, fr, fq, wr1, wi1, pba1, pbx1, psp1, udb1, sud1, stot, ac1, h1);
  vb_barrier(vb);
  u16* hst0 = (u16*)sud0; u16* ast0 = hst0 + 4096;
  u16* hst1 = (u16*)sud1; u16* ast1 = hst1 + 4096;
  lru_finish<0>(p, cs, blk, wave, fr, fq, stot, ac0, h0, hst0, ast0);
  lru_finish<1>(p, cs, blk, wave, fr, fq, stot, ac1, h1, hst1, ast1);
  vb_barrier(vb);
#pragma unroll
  for (int i = 0; i < 2; ++i) {
    const int row = (tid >> 3) + i * 32, c8 = tid & 7;
    const size_t g0 = ((size_t)t0 + row) * 512 + blk * 64 + c8 * 8;
    const size_t g1 = ((size_t)8192 + t0 + row) * 512 + blk * 64 + c8 * 8;
    *(uint4*)(p.hloc + g0) = *(const uint4*)(hst0 + row * 64 + c8 * 8);
    *(uint4*)(p.acum + g0) = *(const uint4*)(ast0 + row * 64 + c8 * 8);
    *(uint4*)(p.hloc + g1) = *(const uint4*)(hst1 + row * 64 + c8 * 8);
    *(uint4*)(p.acum + g1) = *(const uint4*)(ast1 + row * 64 + c8 * 8);
  }
  vb_barrier(vb);
}

__device__ __forceinline__ void unpack8(uint4 v, float (&f)[8]) {
  f[0] = lo16(v.x); f[1] = hi16(v.x); f[2] = lo16(v.y); f[3] = hi16(v.y);
  f[4] = lo16(v.z); f[5] = hi16(v.z); f[6] = lo16(v.w); f[7] = hi16(v.w);
}

__device__ void conv_item(const Params& p, int l, int u) {
  const int tid = otid();
  const int cs = u >> 2, quarter = u & 3;
  int seq_lo, seq_hi;
  if (cs < 64) { seq_lo = (cs >> 2) * 256; seq_hi = seq_lo + 256; }
  else { seq_lo = 4096 + ((cs - 64) >> 5) * 2048; seq_hi = seq_lo + 2048; }
  const int c8 = tid & 15, ch0 = quarter * 128 + c8 * 8;
  float w0[8], w1[8], w2[8];
#pragma unroll
  for (int e = 0; e < 8; ++e) {
    w0[e] = p.conv_w[(l * 3 + 0) * 512 + ch0 + e]; w1[e] = p.conv_w[(l * 3 + 1) * 512 + ch0 + e];
    w2[e] = p.conv_w[(l * 3 + 2) * 512 + ch0 + e];
  }
#pragma unroll 2
  for (int i = 0; i < 4; ++i) {
    const int t = cs * 64 + (tid >> 4) + i * 16;
    const u16* pr = p.P + (size_t)t * 8192 + ch0;
    const uint4 z4 = make_uint4(0u, 0u, 0u, 0u);
    uint4 cb4 = *(const uint4*)(pr + 3072), gc4 = *(const uint4*)(pr + 4608);
    uint4 cc1 = *(const uint4*)(pr + 3584), chh1 = *(const uint4*)(pr + 4096);
    uint4 cc0 = z4, chh0 = z4, cc2 = z4, chh2 = z4;
    if (t - 1 >= seq_lo) { cc0 = *(const uint4*)(pr - 8192 + 3584); chh0 = *(const uint4*)(pr - 8192 + 4096); }
    if (t + 1 < seq_hi) { cc2 = *(const uint4*)(pr + 8192 + 3584); chh2 = *(const uint4*)(pr + 8192 + 4096); }
    float cbv[8], gc[8], a0[8], b0[8], a1[8], b1[8], a2[8], b2[8], oc[8];
    unpack8(cb4, cbv); unpack8(gc4, gc);
    unpack8(cc0, a0); unpack8(chh0, b0); unpack8(cc1, a1); unpack8(chh1, b1); unpack8(cc2, a2); unpack8(chh2, b2);
#pragma unroll
    for (int e = 0; e < 8; ++e) {
      const float conv = w0[e] * (a0[e] * b0[e]) + w1[e] * (a1[e] * b1[e]) + w2[e] * (a2[e] * b2[e]);
      oc[e] = cbv[e] * conv * silu(gc[e]);
    }
    *(uint4*)(p.Aconv + (size_t)t * 512 + ch0) = make_uint4(pack2(oc[0], oc[1]), pack2(oc[2], oc[3]), pack2(oc[4], oc[5]), pack2(oc[6], oc[7]));
  }
}

__device__ void phaseB(const Params& p, int l, char* smem, VbBar& vb) {
  const int half = __builtin_amdgcn_readfirstlane((int)(threadIdx.x >> 8));
  const int v = vbid();
  for (int k = 0; k < 2560; k += NVB) {
    int it = v + k;
    if (it < 2048 && half) it = (it + 1024) & 2047;
    if (it < 1024) attn_item(p, l, it, smem, vb);
    else if (it < 2048) lru_unit2(p, l, it - 1024, smem, vb);
    else conv_item(p, l, it - 2048);
  }
  if (l < 3) {
    for (int it = v; it < 1344; it += NVB) weight_unit<true>(p, l + 1, it, (float*)smem, &vb);
  }
}

__device__ void phaseB2(const Params& p, int l, char* smem) {
  const int tid = otid();
  float* scar = (float*)smem;
  float* new_state = p.out + 25165824;
  for (int u = vbid(); u < 512; u += NVB) {
    const int cs = u >> 2, quarter = u & 3;
    int first, c, nch, b, seq_lo, seq_hi;
    const bool lat = cs >= 64;
    if (!lat) { b = cs >> 2; c = cs & 3; nch = 4; first = b * 4; seq_lo = b * 256; seq_hi = seq_lo + 256; }
    else { b = (cs - 64) >> 5; c = (cs - 64) & 31; nch = 32; first = 64 + b * 32; seq_lo = 4096 + b * 2048; seq_hi = seq_lo + 2048; }
    {
      const int dir = tid >> 7, ch = quarter * 128 + (tid & 127);
      float carry = lat ? p.state_lru[(size_t)((b * 4 + l) * 2 + dir) * 512 + ch] : 0.f;
      const int nprev = dir ? (nch - 1 - c) : c;
      const int start = dir ? (nch - 1) : 0, step = dir ? -1 : 1;
      if (!lat) {
        float A_[3], H_[3];
#pragma unroll
        for (int s = 0; s < 3; ++s) {
          const int cc = min(max(start + step * s, 0), 3);
          const size_t ix = (size_t)((first + cc) * 2 + dir) * 512 + ch;
          A_[s] = p.Atot[ix]; H_[s] = p.Htot[ix];
        }
#pragma unroll
        for (int s = 0; s < 3; ++s) if (s < nprev) carry = A_[s] * carry + H_[s];
        const bool last = dir ? (c == 0) : (c == 3);
        if (last) {
          const size_t ix = (size_t)(cs * 2 + dir) * 512 + ch;
          new_state[(size_t)((b * 4 + l) * 2 + dir) * 512 + ch] = p.Atot[ix] * carry + p.Htot[ix];
        }
      } else {
        float A_[31], H_[31];
#pragma unroll
        for (int s = 0; s < 31; ++s) {
          const int cc = min(max(start + step * s, 0), 31);
          const size_t ix = (size_t)((first + cc) * 2 + dir) * 512 + ch;
          A_[s] = p.Atot[ix]; H_[s] = p.Htot[ix];
        }
#pragma unroll
        for (int s = 0; s < 31; ++s) if (s < nprev) carry = A_[s] * carry + H_[s];
      }
      scar[tid] = carry;
    }
    __syncthreads();
    {
      const int c8 = tid & 15, ch0 = quarter * 128 + c8 * 8;
      float cf[8], cb[8];
#pragma unroll
      for (int e = 0; e < 8; ++e) { cf[e] = scar[c8 * 8 + e]; cb[e] = scar[128 + c8 * 8 + e]; }
#pragma unroll 2
      for (int i = 0; i < 4; ++i) {
        const int t = cs * 64 + (tid >> 4) + i * 16;
        const u16* pr = p.P + (size_t)t * 8192 + ch0;
        uint4 hf4 = ldnt16(p.hloc + (size_t)t * 512 + ch0), af4 = ldnt16(p.acum + (size_t)t * 512 + ch0);
        uint4 hb4 = ldnt16(p.hloc + ((size_t)8192 + t) * 512 + ch0), ab4 = ldnt16(p.acum + ((size_t)8192 + t) * 512 + ch0);
        uint4 gl4 = *(const uint4*)(pr + 2560);
        float hf[8], af[8], hb[8], ab[8], gl[8], ol[8];
        unpack8(hf4, hf); unpack8(af4, af); unpack8(hb4, hb); unpack8(ab4, ab); unpack8(gl4, gl);
#pragma unroll
        for (int e = 0; e < 8; ++e) {
          float h = (hf[e] + af[e] * cf[e]) + (hb[e] + ab[e] * cb[e]);
          ol[e] = h * silu(gl[e]);
        }
        *(uint4*)(p.Alru + (size_t)t * 512 + ch0) = make_uint4(pack2(ol[0], ol[1]), pack2(ol[2], ol[3]), pack2(ol[4], ol[5]), pack2(ol[6], ol[7]));
      }
    }
    __syncthreads();
  }
  if (l < 3) {
    for (int it = vbid(); it < 512; it += NVB) sw_item<false>(p, l + 1, it, smem, nullptr);
  }
}

__device__ void phaseC1(const Params& p, int l, char* smem, int vid) {
  const int tid = otid512(), lane = tid & 63, wave = tid >> 6;
  const int wm = wave >> 1, wn = wave & 1, fr = lane & 15, fq = lane >> 4;
  for (int id = vid; id < 256; id += gridDim.x) {
    const int xcd = id & 7, j_ = id >> 3;
    const int mt = xcd * 4 + (j_ >> 3), nt = j_ & 7;
    const int m0 = mt * 256, n0 = nt * 128;
    f32x4 tot[4][4];
    zero_acc<4, 4>(tot);
    gemm4_prologue<4, 4, 4, 2, false, true>(p.Ana + (size_t)m0 * 512, 512, p.wt_br + (size_t)(l * 3) * 1024 * 512 + (size_t)n0 * 512, 512, smem);
#pragma unroll 1
    for (int br = 0; br < 3; ++br) {
      f32x4 acc[4][4];
      zero_acc<4, 4>(acc);
      const u16* A = p.Ana + (size_t)br * 8192 * 512 + (size_t)m0 * 512;
      const u16* B = p.wt_br + (size_t)(l * 3 + br) * 1024 * 512 + (size_t)n0 * 512;
      uint4 gpre[4][2];
#pragma unroll
      for (int i = 0; i < 4; ++i) {
        const int t = m0 + wm * 64 + i * 16 + fr;
        const int col = n0 + wn * 64 + fq * 16;
        const u16* gp = p.P + (size_t)t * 8192 + 5120 + br * 1024 + col;
        gpre[i][0] = ldnt16(gp); gpre[i][1] = ldnt16(gp + 8);
      }
      __builtin_amdgcn_sched_barrier(0);
      gemm_mainloop<4, 4, 4, 2, true, false, true, true>(A, 512, B, 512, 512, acc, smem);
      if (br < 2)
        gemm4_prologue<4, 4, 4, 2, false, true>(A + (size_t)8192 * 512, 512, B + (size_t)1024 * 512, 512, smem);
#pragma unroll
      for (int i = 0; i < 4; ++i) {
        const uint4 g0 = gpre[i][0], g1 = gpre[i][1];
        tot[i][0][0] += sigm(lo16(g0.x)) * acc[i][0][0]; tot[i][0][1] += sigm(hi16(g0.x)) * acc[i][0][1];
        tot[i][0][2] += sigm(lo16(g0.y)) * acc[i][0][2]; tot[i][0][3] += sigm(hi16(g0.y)) * acc[i][0][3];
        tot[i][1][0] += sigm(lo16(g0.z)) * acc[i][1][0]; tot[i][1][1] += sigm(hi16(g0.z)) * acc[i][1][1];
        tot[i][1][2] += sigm(lo16(g0.w)) * acc[i][1][2]; tot[i][1][3] += sigm(hi16(g0.w)) * acc[i][1][3];
        tot[i][2][0] += sigm(lo16(g1.x)) * acc[i][2][0]; tot[i][2][1] += sigm(hi16(g1.x)) * acc[i][2][1];
        tot[i][2][2] += sigm(lo16(g1.y)) * acc[i][2][2]; tot[i][2][3] += sigm(hi16(g1.y)) * acc[i][2][3];
        tot[i][3][0] += sigm(lo16(g1.z)) * acc[i][3][0]; tot[i][3][1] += sigm(hi16(g1.z)) * acc[i][3][1];
        tot[i][3][2] += sigm(lo16(g1.w)) * acc[i][3][2]; tot[i][3][3] += sigm(hi16(g1.w)) * acc[i][3][3];
      }
    }
#pragma unroll
    for (int i = 0; i < 4; ++i) {
      const int t = m0 + wm * 64 + i * 16 + fr;
      const int col = n0 + wn * 64 + fq * 16;
      uint4 w0 = make_uint4(pack2(tot[i][0][0], tot[i][0][1]), pack2(tot[i][0][2], tot[i][0][3]),
                            pack2(tot[i][1][0], tot[i][1][1]), pack2(tot[i][1][2], tot[i][1][3]));
      uint4 w1 = make_uint4(pack2(tot[i][2][0], tot[i][2][1]), pack2(tot[i][2][2], tot[i][2][3]),
                            pack2(tot[i][3][0], tot[i][3][1]), pack2(tot[i][3][2], tot[i][3][3]));
      *(uint4*)(p.merged + (size_t)t * 1024 + col) = w0;
      *(uint4*)(p.merged + (size_t)t * 1024 + col + 8) = w1;
    }
  }
}

__device__ void phaseC2(const Params& p, int l, char* smem, int vid) {
  const int tid = otid512(), lane = tid & 63, wave = tid >> 6;
  const int wm = wave >> 1, wn = wave & 1, fr = lane & 15, fq = lane >> 4;
  for (int id = vid; id < 256; id += gridDim.x) {
    const int xcd = id & 7, j_ = id >> 3;
    const int mt = xcd * 4 + (j_ >> 3), nt = j_ & 7;
    const int m0 = mt * 256, n0 = nt * 128;
    f32x4 acc[4][4];
    zero_acc<4, 4>(acc);
    const int cid = m0 < 4096 ? 0 : 1 + ((m0 - 4096) >> 11);
    const int col = n0 + wn * 64 + fq * 16;
    float4 gpre[4], xpre[4][4];
    {
      const float* gt = p.mod + (size_t)(l * 3 + cid) * 3072 + 2048 + col;
#pragma unroll
      for (int j = 0; j < 4; ++j) gpre[j] = *(const float4*)(gt + j * 4);
#pragma unroll
      for (int i = 0; i < 4; ++i) {
        const float* xr = xrow(p, l, m0 + wm * 64 + i * 16 + fr) + col;
#pragma unroll
        for (int j = 0; j < 4; ++j) xpre[i][j] = *(const float4*)(xr + j * 4);
      }
    }
    __builtin_amdgcn_sched_barrier(0);
    gemm_mainloop<4, 4, 4, 2, true, false, true>(p.merged + (size_t)m0 * 1024, 1024,
                                                 p.wt_out + (size_t)l * 1024 * 1024 + (size_t)n0 * 1024, 1024, 1024, acc, smem);
#pragma unroll
    for (int i = 0; i < 4; ++i) {
      float* xr = p.xbuf + (size_t)(m0 + wm * 64 + i * 16 + fr) * 1024 + col;
#pragma unroll
      for (int j = 0; j < 4; ++j) {
        const float4 g4 = gpre[j], xo = xpre[i][j];
        const float4 xn = make_float4(xo.x + g4.x * acc[i][j][0], xo.y + g4.y * acc[i][j][1],
                                      xo.z + g4.z * acc[i][j][2], xo.w + g4.w * acc[i][j][3]);
        *(float4*)(xr + j * 4) = xn;
        acc[i][j] = f32x4{xn.x, xn.y, xn.z, xn.w};
      }
    }
    if (l < 3) {
      const float* gn = p.norm_g + (l + 1) * 1024 + col;
      const float* scn = p.mod + (size_t)((l + 1) * 3 + cid) * 3072 + 1024 + col;
      float gs[16];
#pragma unroll
      for (int j = 0; j < 4; ++j) {
        const float4 g_ = *(const float4*)(gn + j * 4), s_ = *(const float4*)(scn + j * 4);
        gs[j * 4 + 0] = g_.x * (1.f + s_.x); gs[j * 4 + 1] = g_.y * (1.f + s_.y);
        gs[j * 4 + 2] = g_.z * (1.f + s_.z); gs[j * 4 + 3] = g_.w * (1.f + s_.w);
      }
#pragma unroll
      for (int i = 0; i < 4; ++i) {
        const int t = m0 + wm * 64 + i * 16 + fr;
        float ss = 0.f;
#pragma unroll
        for (int j = 0; j < 4; ++j)
#pragma unroll
          for (int e = 0; e < 4; ++e) ss += acc[i][j][e] * acc[i][j][e];
        ss += __shfl_xor(ss, 16);
        ss += __shfl_xor(ss, 32);
        if (fq == 0) atomicAdd(p.rowss + (size_t)(l + 1) * 8192 + t, ss);
        uint4 w0 = make_uint4(pack2(acc[i][0][0] * gs[0], acc[i][0][1] * gs[1]), pack2(acc[i][0][2] * gs[2], acc[i][0][3] * gs[3]),
                              pack2(acc[i][1][0] * gs[4], acc[i][1][1] * gs[5]), pack2(acc[i][1][2] * gs[6], acc[i][1][3] * gs[7]));
        uint4 w1 = make_uint4(pack2(acc[i][2][0] * gs[8], acc[i][2][1] * gs[9]), pack2(acc[i][2][2] * gs[10], acc[i][2][3] * gs[11]),
                              pack2(acc[i][3][0] * gs[12], acc[i][3][1] * gs[13]), pack2(acc[i][3][2] * gs[14], acc[i][3][3] * gs[15]));
        *(uint4*)(p.xm + blk1024(t, col)) = w0;
        *(uint4*)(p.xm + blk1024(t, col + 8)) = w1;
      }
    }
  }
}

#define XB_TMO      128
#define XB_XCNT(j)  (256  + 64 * (j))
#define XB_XSUB(j)  (1280 + 64 * (j))
#define XB_XGEN(j)  (2304 + 64 * (j))
#define XB_TOP      3328
#define XB_TOPGEN   3392
#define XCD_BAR_WORDS 3456
#define XB_SPIN_CAP (1u << 18)
#define LAS __attribute__((address_space(3)))
__device__ __forceinline__ unsigned xb_ld(unsigned* p) { return __hip_atomic_load(p, __ATOMIC_RELAXED, __HIP_MEMORY_SCOPE_AGENT); }
__device__ __forceinline__ unsigned xb_add(unsigned* p, unsigned v) { return __hip_atomic_fetch_add(p, v, __ATOMIC_RELAXED, __HIP_MEMORY_SCOPE_AGENT); }
__device__ __forceinline__ unsigned xb_xcc_id() { return (unsigned)__builtin_amdgcn_s_getreg((3 << 11) | 20) & 0xFu; }
#define XB_SPIN(cond, bar) do { unsigned _sp = 0; while (cond) { __builtin_amdgcn_s_sleep(1); \
    if ((++_sp & 255u) == 0u) { if (xb_ld(&(bar)[XB_TMO])) break; if (_sp > XB_SPIN_CAP) { atomicAdd(&(bar)[XB_TMO], 1u); break; } } } } while (0)
struct XcdBarrier { unsigned* bar; unsigned x; unsigned rank; volatile LAS unsigned* st; };
__device__ __forceinline__ XcdBarrier xcd_barrier_post(unsigned* bar, volatile LAS unsigned* st) {
  XcdBarrier b; b.bar = bar; b.x = xb_xcc_id(); b.st = st; b.rank = 0u;
  if (threadIdx.x == 0) b.rank = xb_add(&bar[XB_XCNT(b.x)], 1u);
  return b;
}
__device__ __forceinline__ void xcd_barrier_complete(unsigned* bar, unsigned x, unsigned& nloc, unsigned& nx) {
  const unsigned G = gridDim.x * gridDim.y * gridDim.z;
  unsigned sum, cnt, mine, sp = 0u;
  for (;;) {
    sum = 0u; cnt = 0u; mine = 0u;
#pragma unroll
    for (unsigned j = 0; j < 16; ++j) { const unsigned c = xb_ld(&bar[XB_XCNT(j)]); sum += c; cnt += (c > 0u) ? 1u : 0u; mine = (j == x) ? c : mine; }
    if (sum == G) break;
    __builtin_amdgcn_s_sleep(1);
    if ((++sp & 255u) == 0u) { if (xb_ld(&bar[XB_TMO])) break; if (sp > XB_SPIN_CAP) { atomicAdd(&bar[XB_TMO], 1u); break; } }
  }
  nloc = mine > 0u ? mine : 1u; nx = cnt > 0u ? cnt : 1u;
}
__device__ __forceinline__ void xcd_barrier(const XcdBarrier& b) {
  asm volatile("s_waitcnt vmcnt(0)" ::: "memory");
  __syncthreads();
  if (threadIdx.x == 0) {
    unsigned* bar = b.bar;
    __builtin_amdgcn_s_waitcnt(0);
    unsigned nloc = b.st[0], nx = b.st[1];
    if (nloc == 0u) { xcd_barrier_complete(bar, b.x, nloc, nx); b.st[0] = nloc; b.st[1] = nx; }
    const unsigned old = xb_add(&bar[XB_XSUB(b.x)], 1u);
    const unsigned gen = old / nloc;
    if (old + 1u == (gen + 1u) * nloc) {
      __builtin_amdgcn_fence(__ATOMIC_RELEASE, "agent");
      asm volatile("s_waitcnt vmcnt(0)" ::: "memory");
      const unsigned og = xb_add(&bar[XB_TOP], 1u);
      const unsigned tg = og / nx;
      if (og + 1u == (tg + 1u) * nx) xb_add(&bar[XB_TOPGEN], 1u);
      else XB_SPIN(xb_ld(&bar[XB_TOPGEN]) == tg, bar);
      __builtin_amdgcn_fence(__ATOMIC_ACQUIRE, "agent");
      xb_add(&bar[XB_XGEN(b.x)], 1u);
      asm volatile("s_waitcnt vmcnt(0)" ::: "memory");
    } else {
      XB_SPIN(xb_ld(&bar[XB_XGEN(b.x)]) == gen, bar);
      __builtin_amdgcn_fence(__ATOMIC_ACQUIRE, "agent");
      asm volatile("s_waitcnt vmcnt(0)" ::: "memory");
    }
  }
  __syncthreads();
}

__global__ void __launch_bounds__(NTHREADS) __attribute__((amdgpu_waves_per_eu(2, 2))) mega(Params p_arg) {
  const Params& p = *(const Params*)__builtin_amdgcn_kernarg_segment_ptr();
  extern __shared__ __attribute__((aligned(16))) char dsm[];
  char* smem = dsm;
  char* hsm = dsm + __builtin_amdgcn_readfirstlane((int)(threadIdx.x >> 8)) * 65536;
  cg::grid_group grid = cg::this_grid();
  if (threadIdx.x < 16) ((unsigned*)(dsm + SMEM_BYTES))[threadIdx.x] = 0u;
  __syncthreads();
  VbBar vbb;
  vbb.cnt = (unsigned*)(dsm + SMEM_BYTES + 16 + __builtin_amdgcn_readfirstlane((int)(threadIdx.x >> 8)) * 16);
  vbb.target = 0u;
  XcdBarrier xb = xcd_barrier_post(p.bar, (volatile LAS unsigned*)(dsm + SMEM_BYTES));
  const int lo = p.phase_lo, hi = p.phase_hi;
  if (hi > 1000) grid.sync();
#define GRID_SYNC() xcd_barrier(xb)
#define RUN_PHASE(PH, CALL) { const int ph_ = (PH); if (ph_ >= lo && ph_ < hi) { CALL; if (ph_ + 1 < hi) GRID_SYNC(); } }
  RUN_PHASE(0, phase0(p, hsm));
  int vid = blockIdx.x;
  {
    unsigned* st2 = (unsigned*)(dsm + SMEM_BYTES + 48);
    if (threadIdx.x == 0) {
      bool ok = (gridDim.x & 7) == 0 && xb.x < 8u;
      for (int j = 0; j < 8; ++j) ok = ok && (xb_ld(&p.bar[XB_XCNT(j)]) == gridDim.x / 8);
      ok = ok && xb.rank < gridDim.x / 8;
      st2[0] = ok ? (xb.x + 8u * xb.rank) : blockIdx.x;
    }
    __syncthreads();
    vid = __builtin_amdgcn_readfirstlane((int)st2[0]);
  }
#pragma unroll 1
  for (int l = 0; l < 4; ++l) {
    if (l == 0) RUN_PHASE(1, phaseN0(p, hsm));
    RUN_PHASE(2 + l * 6, phaseA(p, l, smem, vid));
    RUN_PHASE(3 + l * 6, phaseB(p, l, hsm, vbb));

    RUN_PHASE(4 + l * 6, phaseB2(p, l, hsm));
    RUN_PHASE(5 + l * 6, phaseC1(p, l, smem, vid));
    RUN_PHASE(6 + l * 6, phaseC2(p, l, smem, vid));
  }
  RUN_PHASE(25, phaseF(p));
}

extern "C" void kernel_launch(void* const* d_in, const int* in_sizes, int n_in, void* d_out, int out_size, void* d_ws,
                              size_t ws_size, hipStream_t stream) {
  static int grid_blocks = 0;
  if (!grid_blocks) {
    int dev = 0, cus = 0, per_cu = 0;
    hipGetDevice(&dev);
    hipDeviceGetAttribute(&cus, hipDeviceAttributeMultiprocessorCount, dev);
    hipFuncSetAttribute((const void*)mega, hipFuncAttributeMaxDynamicSharedMemorySize, DYN_LDS);
    hipOccupancyMaxActiveBlocksPerMultiprocessor(&per_cu, mega, NTHREADS, DYN_LDS);
    if (per_cu > 1) per_cu = 1;
    if (per_cu < 1) per_cu = 1;
    grid_blocks = cus * per_cu;
  }
  Params p;
  memset(&p, 0, sizeof(p));
  const float** fp = (const float**)&p;
  for (int i = 0; i < 25; ++i) fp[i] = (const float*)d_in[i];
  p.out = (float*)d_out;
  char* w = (char*)d_ws;
  size_t off = 0;
  auto take = [&](size_t bytes) { char* r = w + off; off += (bytes + 255) & ~(size_t)255; return r; };
  p.wt_in = (u16*)take((size_t)4 * 8192 * 1024 * 2);
  p.wt_br = (u16*)take((size_t)4 * 3 * 1024 * 512 * 2);
  p.wt_out = (u16*)take((size_t)4 * 1024 * 1024 * 2);
  p.wgT = (u16*)take((size_t)128 * 4096 * 2);
  p.ckb = (u16*)take((size_t)2 * 4 * 256 * 512 * 2);
  p.cvT = (u16*)take((size_t)2 * 4 * 256 * 512 * 2);
  p.xm = (u16*)take((size_t)8192 * 1024 * 2);
  p.P = (u16*)take((size_t)8192 * 8192 * 2);
  p.Vt = (u16*)take((size_t)512 * 8192 * 2);
  p.Ana = (u16*)take((size_t)8192 * 512 * 2);
  p.Alru = (u16*)take((size_t)8192 * 512 * 2);
  p.Aconv = (u16*)take((size_t)8192 * 512 * 2);
  p.merged = (u16*)take((size_t)8192 * 1024 * 2);
  p.hloc = (u16*)take((size_t)2 * 8192 * 512 * 2);
  p.acum = (u16*)take((size_t)2 * 8192 * 512 * 2);
  p.mod = (float*)take((size_t)4 * 3 * 3072 * 4);
  p.xbuf = (float*)take((size_t)8192 * 1024 * 4);
  p.Atot = (float*)take((size_t)128 * 2 * 512 * 4);
  p.Htot = (float*)take((size_t)128 * 2 * 512 * 4);
  p.sp8 = (float*)take((size_t)4096 * 4);
  p.rowss = (float*)take((size_t)4 * 8192 * 4);
  p.sW = (float*)take((size_t)4 * 3 * 8192 * 4);
  p.bar = (unsigned*)take((size_t)XCD_BAR_WORDS * 4);
  if (off > ws_size) { fprintf(stderr, "workspace too small: need %zu have %zu\n", off, ws_size); return; }
#ifdef MULTI_LAUNCH
  for (int ph = 0; ph < 26; ++ph) {
    p.phase_lo = ph; p.phase_hi = ph + 1;
    hipLaunchKernelGGL(mega, dim3(grid_blocks), dim3(NTHREADS), DYN_LDS, stream, p);
  }
#else
  p.phase_lo = 0; p.phase_hi = 26;
  hipMemsetAsync(p.bar, 0, (size_t)XCD_BAR_WORDS * 4, stream);
  void* args[] = {&p};
  hipError_t e = hipLaunchCooperativeKernel((void*)mega, dim3(grid_blocks), dim3(NTHREADS), args, DYN_LDS, stream);
  if (e != hipSuccess) fprintf(stderr, "cooperative launch failed: %s (grid %d)\n", hipGetErrorString(e), grid_blocks);
#endif
}
```
